# Optimizing an MI355X kernel written in HIP

```python
import jax, jax.numpy as jnp
from jax import lax
import numpy as np

D_MODEL = 1024
BATCH = 2
SEQ = 16384
DEPTH = 4

GRID_W = 64
CTX_LEN = 256
HEAD_DIM = 64
ROPE_THETA = 10000.0
Q_BLOCK = 128
RMS_EPS = 1e-6
H_A = 8
NOPE_A = 64
ROPE_A = 32
V_A = 64
Q_LORA = 384
KV_LORA = 256
H_B = 8
KV_B = 2
G_B = H_B // KV_B
AB_IN = Q_LORA + KV_LORA + ROPE_A + H_B * HEAD_DIM + 2 * KV_B * HEAD_DIM
AB_OUT = H_A * V_A + H_B * HEAD_DIM
H_C = 16
WIN_R = 8
WIN_C = 16
C_WIDTH = H_C * HEAD_DIM
N_GROUPS = 4
EXPERTS_PER_GROUP = 8
N_EXPERTS = N_GROUPS * EXPERTS_PER_GROUP
TOP_K = 2
D_EXPERT = 512
MOE_BLOCK = 128
N_EVEN = (DEPTH + 1) // 2
N_ODD = DEPTH // 2

kernel_name = "hybrid_mla_gqa_natten_hmoe_prefix_dit"


def rmsnorm(x, g):
    xf = x.astype(jnp.float32)
    y = xf * lax.rsqrt(jnp.mean(xf * xf, axis=-1, keepdims=True) + RMS_EPS)
    return (y * g.astype(jnp.float32)).astype(x.dtype)


def modulate(x, g, shift, scale):
    return rmsnorm(x, g) * (1 + scale) + shift


def axial_rope_table(rows, cols, rot_dim):
    n = rot_dim // 4
    inv = ROPE_THETA ** (-jnp.arange(n, dtype=jnp.float32) / n)
    ang = jnp.concatenate([rows[:, None] * inv, cols[:, None] * inv], axis=-1)
    return jnp.cos(ang), jnp.sin(ang)


def apply_rope(x, rope):
    cos, sin = rope
    cos = cos.astype(x.dtype)
    sin = sin.astype(x.dtype)
    x1 = x[..., 0::2]
    x2 = x[..., 1::2]
    return jnp.stack([x1 * cos - x2 * sin, x1 * sin + x2 * cos], axis=-1).reshape(x.shape)


def heads_to_tokens(o):
    b, h, t, d = o.shape
    return o.transpose(0, 2, 1, 3).reshape(b, t, h * d)


def attend(q, k, v):
    s = jnp.einsum('bhgqd,bhkd->bhgqk', q, k, preferred_element_type=jnp.float32)
    p = jax.nn.softmax(s, axis=-1).astype(v.dtype)
    return jnp.einsum('bhgqk,bhkd->bhgqd', p, v)


def prefix_attention(q, k_lat, v_lat, k_ctx, v_ctx):
    b, hk, g, s, d = q.shape
    nb = s // Q_BLOCK
    k_all = jnp.concatenate([k_ctx, k_lat], axis=2)
    v_all = jnp.concatenate([v_ctx, v_lat], axis=2)
    qb = q.reshape(b, hk, g, nb, Q_BLOCK, d).transpose(3, 0, 1, 2, 4, 5)
    o = lax.map(lambda qblk: attend(qblk, k_all, v_all), qb)
    return o.transpose(1, 2, 3, 0, 4, 5).reshape(b, hk, g, s, v_all.shape[-1])


def mixer_ab(h_ctx, h_lat, rope_a, rope_b, w_in, w_out, q_norm, w_q_up, kv_norm, w_kv_up, gq_norm, gk_norm, need_ctx):
    def project(h, ra, rb):
        bsz, t, _ = h.shape
        p = h @ w_in
        o0 = Q_LORA
        o1 = o0 + KV_LORA
        o2 = o1 + ROPE_A
        o3 = o2 + H_B * HEAD_DIM
        o4 = o3 + KV_B * HEAD_DIM
        cq, ckv, kr = p[..., :o0], p[..., o0:o1], p[..., o1:o2]
        gq, gk, gv = p[..., o2:o3], p[..., o3:o4], p[..., o4:]
        qa = (rmsnorm(cq, q_norm) @ w_q_up).reshape(bsz, t, H_A, NOPE_A + ROPE_A).transpose(0, 2, 1, 3)
        kva = (rmsnorm(ckv, kv_norm) @ w_kv_up).reshape(bsz, t, H_A, NOPE_A + V_A).transpose(0, 2, 1, 3)
        q_nope, q_rope = qa[..., :NOPE_A], qa[..., NOPE_A:]
        k_nope, va = kva[..., :NOPE_A], kva[..., NOPE_A:]
        k_rope = kr[:, None]
        if ra is not None:
            q_rope = apply_rope(q_rope, ra)
            k_rope = apply_rope(k_rope, ra)
        qa = jnp.concatenate([q_nope, q_rope], axis=-1) * ((NOPE_A + ROPE_A) ** -0.5)
        ka = jnp.concatenate([k_nope, jnp.broadcast_to(k_rope, (bsz, H_A, t, ROPE_A))], axis=-1)
        qb = rmsnorm(gq.reshape(bsz, t, H_B, HEAD_DIM).transpose(0, 2, 1, 3), gq_norm)
        kb = rmsnorm(gk.reshape(bsz, t, KV_B, HEAD_DIM).transpose(0, 2, 1, 3), gk_norm)
        vb = gv.reshape(bsz, t, KV_B, HEAD_DIM).transpose(0, 2, 1, 3)
        if rb is not None:
            qb = apply_rope(qb, rb)
            kb = apply_rope(kb, rb)
        qb = qb.reshape(bsz, KV_B, G_B, t, HEAD_DIM) * (HEAD_DIM ** -0.5)
        return qa[:, :, None], ka, va, qb, kb, vb

    qa_l, ka_l, va_l, qb_l, kb_l, vb_l = project(h_lat, rope_a, rope_b)
    qa_c, ka_c, va_c, qb_c, kb_c, vb_c = project(h_ctx, None, None)
    bsz, s = h_lat.shape[0], h_lat.shape[1]
    oa = prefix_attention(qa_l, ka_l, va_l, ka_c, va_c).reshape(bsz, H_A, s, V_A)
    ob = prefix_attention(qb_l, kb_l, vb_l, kb_c, vb_c).reshape(bsz, H_B, s, HEAD_DIM)
    out_lat = jnp.concatenate([heads_to_tokens(oa), heads_to_tokens(ob)], axis=-1) @ w_out
    out_ctx = None
    if need_ctx:
        t = h_ctx.shape[1]
        oa_c = attend(qa_c, ka_c, va_c).reshape(bsz, H_A, t, V_A)
        ob_c = attend(qb_c, kb_c, vb_c).reshape(bsz, H_B, t, HEAD_DIM)
        out_ctx = jnp.concatenate([heads_to_tokens(oa_c), heads_to_tokens(ob_c)], axis=-1) @ w_out
    return out_ctx, out_lat


def mixer_na(h_ctx, h_lat, nbr_idx, rel_idx, w_in, w_out, rpb, need_ctx):
    def project(h):
        bsz, t, _ = h.shape
        p = (h @ w_in).reshape(bsz, t, 3, H_C, HEAD_DIM).transpose(2, 0, 3, 1, 4)
        return p[0] * (HEAD_DIM ** -0.5), p[1], p[2]

    q_l, k_l, v_l = project(h_lat)
    q_c, k_c, v_c = project(h_ctx)
    bsz, s = h_lat.shape[0], h_lat.shape[1]
    nk = nbr_idx.shape[1]
    nb = s // Q_BLOCK
    rpb_flat = rpb.reshape(H_C, -1)
    qb = q_l.reshape(bsz, H_C, nb, Q_BLOCK, HEAD_DIM).transpose(2, 0, 1, 3, 4)
    idx_b = nbr_idx.reshape(nb, Q_BLOCK, nk)
    rel_b = rel_idx.reshape(nb, Q_BLOCK, nk)

    def one_block(args):
        qblk, ib, rb = args
        kg = jnp.take(k_l, ib, axis=2)
        vg = jnp.take(v_l, ib, axis=2)
        s_n = jnp.einsum('bhqd,bhqnd->bhqn', qblk, kg, preferred_element_type=jnp.float32) + rpb_flat[:, rb].astype(jnp.float32)
        s_c = jnp.einsum('bhqd,bhcd->bhqc', qblk, k_c, preferred_element_type=jnp.float32)
        p = jax.nn.softmax(jnp.concatenate([s_n, s_c], axis=-1), axis=-1).astype(v_l.dtype)
        return jnp.einsum('bhqn,bhqnd->bhqd', p[..., :nk], vg) + jnp.einsum('bhqc,bhcd->bhqd', p[..., nk:], v_c)

    o = lax.map(one_block, (qb, idx_b, rel_b))
    out_lat = o.transpose(1, 0, 3, 2, 4).reshape(bsz, s, C_WIDTH) @ w_out
    out_ctx = None
    if need_ctx:
        oc = attend(q_c[:, :, None], k_c, v_c)[:, :, 0]
        out_ctx = heads_to_tokens(oc) @ w_out
    return out_ctx, out_lat


def hier_moe(h, w_rg, b_rg, w_re, b_re, w_gate, w_up, w_down):
    n, d = h.shape
    hf = h.astype(jnp.float32)
    pg = jax.nn.softmax(hf @ w_rg.astype(jnp.float32) + b_rg.astype(jnp.float32), axis=-1)
    g_sel = jnp.argmax(pg, axis=-1)
    p_gsel = jnp.take_along_axis(pg, g_sel[:, None], axis=-1)
    le = (hf @ w_re.astype(jnp.float32) + b_re.astype(jnp.float32)).reshape(n, N_GROUPS, EXPERTS_PER_GROUP)
    le_sel = jnp.take_along_axis(le, g_sel[:, None, None], axis=1)[:, 0]
    top_p, top_i = lax.top_k(jax.nn.softmax(le_sel, axis=-1), TOP_K)
    gate_w = p_gsel * top_p / jnp.sum(top_p, axis=-1, keepdims=True)
    experts = g_sel[:, None] * EXPERTS_PER_GROUP + top_i

    nkk = n * TOP_K
    flat_e = experts.reshape(-1).astype(jnp.int32)
    flat_w = gate_w.reshape(-1)
    order = jnp.argsort(flat_e)
    sorted_e = flat_e[order]
    tok_sorted = (jnp.arange(nkk, dtype=jnp.int32) // TOP_K)[order]
    w_sorted = flat_w[order]
    counts = jnp.bincount(flat_e, length=N_EXPERTS)
    padded = ((counts + MOE_BLOCK - 1) // MOE_BLOCK) * MOE_BLOCK
    ends = jnp.cumsum(padded)
    pad_start = ends - padded
    start = jnp.cumsum(counts) - counts
    rank = jnp.arange(nkk, dtype=jnp.int32) - start[sorted_e]
    dest = pad_start[sorted_e] + rank
    total = -(-(nkk + N_EXPERTS * (MOE_BLOCK - 1)) // MOE_BLOCK) * MOE_BLOCK
    nblk = total // MOE_BLOCK
    buf_tok = jnp.full((total,), n, jnp.int32).at[dest].set(tok_sorted)
    h_pad = jnp.concatenate([h, jnp.zeros((1, d), h.dtype)], axis=0)
    x_buf = h_pad[buf_tok].reshape(nblk, MOE_BLOCK, d)
    blk_e = jnp.clip(jnp.searchsorted(ends, jnp.arange(nblk, dtype=ends.dtype) * MOE_BLOCK, side='right'), 0, N_EXPERTS - 1)

    def run_block(args):
        xb, e = args
        return (jax.nn.silu(xb @ w_gate[e]) * (xb @ w_up[e])) @ w_down[e]

    y = lax.map(run_block, (x_buf, blk_e)).reshape(total, d)
    return jnp.zeros((n, d), h.dtype).at[tok_sorted].add(y[dest] * w_sorted[:, None].astype(h.dtype))


def setup_inputs(seed: int = 0) -> dict:
    key = jax.random.key(seed)
    ks = jax.random.split(key, 32)

    def nrm(k, shape, scale):
        return jax.random.normal(k, shape, jnp.float32) * scale

    def gain(k, shape):
        return 1.0 + nrm(k, shape, 0.1)

    D = D_MODEL
    return {
        "x": nrm(ks[0], (BATCH, SEQ, D), 1.0),
        "c": nrm(ks[1], (BATCH, D), 1.0),
        "ctx": nrm(ks[2], (BATCH, CTX_LEN, D), 1.0),
        "c_ctx": nrm(ks[3], (D,), 1.0),
        "w_ada": nrm(ks[4], (DEPTH, D, 6 * D), 0.02),
        "b_ada": nrm(ks[5], (DEPTH, 6 * D), 0.02),
        "norm_mix": gain(ks[6], (DEPTH, D)),
        "norm_ffn": gain(ks[7], (DEPTH, D)),
        "norm_final": gain(ks[8], (D,)),
        "ab_w_in": nrm(ks[9], (N_EVEN, D, AB_IN), D ** -0.5),
        "ab_w_out": nrm(ks[10], (N_EVEN, AB_OUT, D), AB_OUT ** -0.5),
        "mla_q_norm": gain(ks[11], (N_EVEN, Q_LORA)),
        "mla_w_q_up": nrm(ks[12], (N_EVEN, Q_LORA, H_A * (NOPE_A + ROPE_A)), Q_LORA ** -0.5),
        "mla_kv_norm": gain(ks[13], (N_EVEN, KV_LORA)),
        "mla_w_kv_up": nrm(ks[14], (N_EVEN, KV_LORA, H_A * (NOPE_A + V_A)), KV_LORA ** -0.5),
        "gqa_q_norm": gain(ks[15], (N_EVEN, HEAD_DIM)),
        "gqa_k_norm": gain(ks[16], (N_EVEN, HEAD_DIM)),
        "na_w_in": nrm(ks[17], (N_ODD, D, 3 * C_WIDTH), D ** -0.5),
        "na_w_out": nrm(ks[18], (N_ODD, C_WIDTH, D), C_WIDTH ** -0.5),
        "na_rpb": nrm(ks[19], (N_ODD, H_C, 2 * WIN_R - 1, 2 * WIN_C - 1), 0.1),
        "moe_w_rg": nrm(ks[20], (DEPTH, D, N_GROUPS), D ** -0.5),
        "moe_b_rg": nrm(ks[21], (DEPTH, N_GROUPS), 0.01),
        "moe_w_re": nrm(ks[22], (DEPTH, D, N_EXPERTS), D ** -0.5),
        "moe_b_re": nrm(ks[23], (DEPTH, N_EXPERTS), 0.01),
        "moe_w_gate": nrm(ks[24], (DEPTH, N_EXPERTS, D, D_EXPERT), D ** -0.5),
        "moe_w_up": nrm(ks[25], (DEPTH, N_EXPERTS, D, D_EXPERT), D ** -0.5),
        "moe_w_down": nrm(ks[26], (DEPTH, N_EXPERTS, D_EXPERT, D), D_EXPERT ** -0.5),
    }


def reference(x, c, ctx, c_ctx, w_ada, b_ada, norm_mix, norm_ffn, norm_final, ab_w_in, ab_w_out, mla_q_norm, mla_w_q_up, mla_kv_norm, mla_w_kv_up, gqa_q_norm, gqa_k_norm, na_w_in, na_w_out, na_rpb, moe_w_rg, moe_b_rg, moe_w_re, moe_b_re, moe_w_gate, moe_w_up, moe_w_down):
    bsz, s, d = x.shape
    n_ctx = ctx.shape[1]
    rows_n = s // GRID_W
    wr = min(WIN_R, rows_n)
    t = jnp.arange(s, dtype=jnp.int32)
    r = t // GRID_W
    col = t % GRID_W
    rope_a = axial_rope_table(r.astype(jnp.float32), col.astype(jnp.float32), ROPE_A)
    rope_b = axial_rope_table(r.astype(jnp.float32), col.astype(jnp.float32), HEAD_DIM)
    rs = jnp.clip(r - wr // 2, 0, rows_n - wr)
    cs = jnp.clip(col - WIN_C // 2, 0, GRID_W - WIN_C)
    key_r = rs[:, None] + jnp.arange(wr, dtype=jnp.int32)[None]
    key_c = cs[:, None] + jnp.arange(WIN_C, dtype=jnp.int32)[None]
    nbr_idx = (key_r[:, :, None] * GRID_W + key_c[:, None, :]).reshape(s, wr * WIN_C)
    rel_idx = ((key_r - r[:, None] + WIN_R - 1)[:, :, None] * (2 * WIN_C - 1)
               + (key_c - col[:, None] + WIN_C - 1)[:, None, :]).reshape(s, wr * WIN_C)

    x_lat = x
    x_ctx = ctx
    silu_c = jax.nn.silu(c)
    silu_cc = jax.nn.silu(c_ctx)
    for l in range(DEPTH):
        last = l == DEPTH - 1
        mod_l = (silu_c @ w_ada[l] + b_ada[l])[:, None, :]
        mod_c = (silu_cc @ w_ada[l] + b_ada[l])[None, None, :]
        sh1, sc1, g1, sh2, sc2, g2 = jnp.split(mod_l, 6, axis=-1)
        sh1c, sc1c, g1c, sh2c, sc2c, g2c = jnp.split(mod_c, 6, axis=-1)
        h_l = modulate(x_lat, norm_mix[l], sh1, sc1)
        h_c = modulate(x_ctx, norm_mix[l], sh1c, sc1c)
        if l % 2 == 0:
            i = l // 2
            o_c, o_l = mixer_ab(h_c, h_l, rope_a, rope_b, ab_w_in[i], ab_w_out[i], mla_q_norm[i], mla_w_q_up[i],
                                mla_kv_norm[i], mla_w_kv_up[i], gqa_q_norm[i], gqa_k_norm[i], not last)
        else:
            i = l // 2
            o_c, o_l = mixer_na(h_c, h_l, nbr_idx, rel_idx, na_w_in[i], na_w_out[i], na_rpb[i], not last)
        x_lat = x_lat + g1 * o_l
        h_l = modulate(x_lat, norm_ffn[l], sh2, sc2)
        if not last:
            x_ctx = x_ctx + g1c * o_c
            h_c = modulate(x_ctx, norm_ffn[l], sh2c, sc2c)
            tokens = jnp.concatenate([h_c.reshape(-1, d), h_l.reshape(-1, d)], axis=0)
            y = hier_moe(tokens, moe_w_rg[l], moe_b_rg[l], moe_w_re[l], moe_b_re[l], moe_w_gate[l], moe_w_up[l], moe_w_down[l])
            n_c = bsz * n_ctx
            x_ctx = x_ctx + g2c * y[:n_c].reshape(bsz, n_ctx, d)
            x_lat = x_lat + g2 * y[n_c:].reshape(bsz, s, d)
        else:
            y = hier_moe(h_l.reshape(-1, d), moe_w_rg[l], moe_b_rg[l], moe_w_re[l], moe_b_re[l], moe_w_gate[l], moe_w_up[l], moe_w_down[l])
            x_lat = x_lat + g2 * y.reshape(bsz, s, d)
    return rmsnorm(x_lat, norm_final)
```

```cpp
#include <hip/hip_runtime.h>
#include <cstdio>
#include <cstdint>

#ifndef MK_PER_PHASE
#define MK_PER_PHASE 0
#endif


#ifndef EN_P0
#define EN_P0 1
#endif
#ifndef EN_NORM
#define EN_NORM 1
#endif
#ifndef EN_PREP
#define EN_PREP 1
#endif
#ifndef EN_ATT
#define EN_ATT 1
#endif
#ifndef EN_NA
#define EN_NA 1
#endif
#ifndef EN_ROUTE
#define EN_ROUTE 1
#endif
#ifndef EN_GATHER
#define EN_GATHER 1
#endif
#ifndef EN_FINAL
#define EN_FINAL 1
#endif
#ifndef EN_GEMM
#define EN_GEMM 255
#endif
#ifndef REP_PREP
#define REP_PREP 1
#endif
#ifndef REP_GATHER
#define REP_GATHER 1
#endif
#ifndef REP_UP
#define REP_UP 1
#endif
#ifndef REP_ATT
#define REP_ATT 1
#endif
#ifndef REP_NA
#define REP_NA 1
#endif
#ifndef REP_P0
#define REP_P0 1
#endif
#ifndef REP_MOE
#define REP_MOE 1
#endif
#ifndef REP_IN
#define REP_IN 1
#endif
#ifndef NOBAR_PROBE
#define NOBAR_PROBE 0
#endif
#ifndef EXP_PROBE
#define EXP_PROBE 0
#endif
#ifndef DBG_SEL
#define DBG_SEL -1
#endif
#ifndef W_CONST
#define W_CONST 0.f
#endif
#ifndef MOE_ALPHA
#define MOE_ALPHA 1.f
#endif
#define GAS __attribute__((address_space(1)))
#define LAS __attribute__((address_space(3)))
typedef unsigned short bf16_t;
typedef short bf16x8 __attribute__((ext_vector_type(8)));
typedef short s16x4 __attribute__((ext_vector_type(4)));
typedef float f32x4 __attribute__((ext_vector_type(4)));
typedef float f32x2 __attribute__((ext_vector_type(2)));
typedef float f32x16 __attribute__((ext_vector_type(16)));
typedef unsigned u32x4 __attribute__((ext_vector_type(4)));
typedef unsigned u32x2 __attribute__((ext_vector_type(2)));

constexpr int DM = 1024, SEQ = 16384, NLAT = 32768, CTXL = 256, NCTX = 512, MROWS = NLAT + NCTX;
constexpr int DEPTH = 4, GRIDW = 64, GRIDH = 256;
constexpr int AB_IN = 1440, AB_INP = 1536, QLORA = 384, KVLORA = 256;
constexpr int NEXP = 32, DEXP = 512;
constexpr float LOG2E = 1.4426950408889634f;
constexpr float SC_A = 0.10206207261596577f * LOG2E;
constexpr float SC_B = 0.125f * LOG2E;
constexpr float RMS_EPS = 1e-6f;
constexpr int NWAVES = 8, NTHREADS = 512;

constexpr size_t MiB = 1u << 20;
constexpr size_t WS_CTL = 0, CTL_ZERO_BYTES = 1 * MiB;
constexpr size_t WS_MOD = 1 * MiB;
constexpr size_t WS_ROPE = WS_MOD + 512 * 1024;
constexpr size_t WS_WIN = 2 * MiB;
constexpr size_t WS_WQUP = 8 * MiB;
constexpr size_t WS_WKVUP = 10 * MiB;
constexpr size_t WS_WOUT = 11 * MiB;
constexpr size_t WS_NIN = 15 * MiB;
constexpr size_t WS_NOUT = 27 * MiB;
constexpr size_t WS_LIST = 31 * MiB;
constexpr size_t WS_X = 41 * MiB;
constexpr size_t WS_H = 171 * MiB;
constexpr size_t WS_R = 236 * MiB;
constexpr size_t R_P = WS_R;
constexpr size_t R_CQN = R_P + 98 * MiB;
constexpr size_t R_CKVN = R_CQN + 25 * MiB;
constexpr size_t R_QA = R_CKVN + 17 * MiB;
constexpr size_t R_KVA = R_QA + 49 * MiB;
constexpr size_t R_KR = R_KVA + 65 * MiB;
constexpr size_t R_QB = R_KR + 3 * MiB;
constexpr size_t R_KB = R_QB + 33 * MiB;
constexpr size_t R_VB = R_KB + 9 * MiB;
constexpr size_t R_O = R_P;
constexpr size_t R_EVEN_END = R_VB + 9 * MiB;
constexpr size_t R_QK = WS_R;
constexpr size_t R_VT = R_QK + 130 * MiB;
constexpr size_t R_VTC = R_VT + 64 * MiB;
constexpr size_t R_ON = R_VTC + 1 * MiB;
constexpr size_t R_ODD_END = R_ON + 65 * MiB;
constexpr int MOE_MAXT = 292;
constexpr size_t R_XB = WS_R;
constexpr size_t R_ACT = R_XB + 146 * MiB;
constexpr size_t R_RI = R_ACT + 73 * MiB;
constexpr size_t R_Y = R_RI + 1 * MiB;
constexpr size_t R_MOE_END = R_Y + 130 * MiB;
constexpr size_t WS_MOEW = 606 * MiB;
constexpr size_t MOEW_LAYER = 96 * MiB, MOEW_DN = 64 * MiB;
constexpr size_t WS_END = WS_MOEW + 4 * MOEW_LAYER;
static_assert(R_EVEN_END <= WS_MOEW && R_ODD_END <= WS_MOEW && R_MOE_END <= WS_MOEW, "overlay region");
static_assert(WS_END <= 1024 * MiB, "workspace");

constexpr int CW_BAR = 4096;
constexpr int CW_DBG = 8192;
constexpr int CW_CNT = 16384;
static_assert((CW_CNT + 4 * 32 * 64) * 4 <= (int)CTL_ZERO_BYTES, "ctl");

constexpr int RING_BYTES = 131072;
constexpr int TAB_LD = 1028;
constexpr int LDS_TAB = 36 * TAB_LD * 4;
constexpr int MISC_OFF = LDS_TAB;
constexpr int TILE_E_OFF = MISC_OFF + 64;
constexpr int MOE_NT_OFF = TILE_E_OFF + 1280;
constexpr int CNTL_OFF = MOE_NT_OFF + 16;
constexpr int REC_OFF = CNTL_OFF + 256;
constexpr int LDS_BYTES = REC_OFF + 3328;
static_assert(LDS_BYTES <= 163840, "LDS");

#define RLX_AGENT __ATOMIC_RELAXED, __HIP_MEMORY_SCOPE_AGENT
#define LDS_WAIT() asm volatile("s_waitcnt lgkmcnt(0)" ::: "memory")
#define VM_WAIT() asm volatile("s_waitcnt vmcnt(0)" ::: "memory")
#define SBAR() __builtin_amdgcn_sched_barrier(0)

__device__ __forceinline__ unsigned cvt_pk_bf16(float lo, float hi) { unsigned r; asm volatile("v_cvt_pk_bf16_f32 %0, %1, %2" : "=v"(r) : "v"(lo), "v"(hi)); return r; }
__device__ __forceinline__ float u2f(unsigned u) { return __builtin_bit_cast(float, u); }
__device__ __forceinline__ float bf16lo(unsigned w) { return __builtin_bit_cast(float, w << 16); }
__device__ __forceinline__ float bf16hi(unsigned w) { return __builtin_bit_cast(float, w & 0xffff0000u); }
__device__ __forceinline__ float wave_sum(float v) {
    v += __builtin_bit_cast(float, __builtin_amdgcn_update_dpp(0, __builtin_bit_cast(int, v), 0xB1, 0xF, 0xF, true));
    v += __builtin_bit_cast(float, __builtin_amdgcn_update_dpp(0, __builtin_bit_cast(int, v), 0x4E, 0xF, 0xF, true));
    v += __builtin_bit_cast(float, __builtin_amdgcn_update_dpp(0, __builtin_bit_cast(int, v), 0x141, 0xF, 0xF, true));
    v += __builtin_bit_cast(float, __builtin_amdgcn_update_dpp(0, __builtin_bit_cast(int, v), 0x140, 0xF, 0xF, true));
    { auto rr = __builtin_amdgcn_permlane16_swap(__float_as_uint(v), __float_as_uint(v), false, false); v = __uint_as_float(rr[0]) + __uint_as_float(rr[1]); }
    { auto rr = __builtin_amdgcn_permlane32_swap(__float_as_uint(v), __float_as_uint(v), false, false); v = __uint_as_float(rr[0]) + __uint_as_float(rr[1]); }
    return v;
}
__device__ __forceinline__ int row_class(int m) { return m < SEQ ? 0 : (m < NLAT ? 1 : 2); }

namespace pg8 {
constexpr int BM = 256, BK = 64, HALF = 128, HTB = HALF * BK * 2, STAGE_BYTES = 8 * HTB, NXCD = 8, WGM = 8;
__host__ __device__ __forceinline__ int lds_byte(int r, int c) { const int st = (r >> 4) * 2 + (c >> 5), rr = r & 15, cc = c & 31, ob = rr * 64 + cc * 2; return st * 1024 + (ob ^ (((ob >> 9) & 1) << 5)); }
__host__ __device__ __forceinline__ void stage_rc(int b, int& R, int& C) { const int st = b / 1024, sb = b % 1024, swz = sb ^ (((sb >> 9) & 1) << 5); R = (st >> 1) * 16 + swz / 64; C = (st & 1) * 32 + (swz % 64) / 2; }
__host__ __device__ __forceinline__ int perm32(int rho) { const int n = rho >> 4, i = rho & 15; return 8 * (i >> 2) + 4 * n + (i & 3); }

struct Unit { int pm, pn; };
struct Gemm { const bf16_t* A; const bf16_t* Bt; int lda, K; };

struct StaticOrder {
    static constexpr bool GATHER = false;
    int nM, nN, nwg, G, c;
    __device__ void init(int nM_, int nN_, int G_, int c_) { nM = nM_; nN = nN_; nwg = nM * nN; G = G_; c = c_; }
    __device__ bool next(int i, Unit& u) const {
        const long L = (long)i * G + c; if (L >= nwg) return false;
        int wgid = (int)L; { const int q = nwg / NXCD, r = nwg % NXCD, xcd = wgid % NXCD, off = wgid / NXCD; wgid = (xcd < r ? xcd * (q + 1) : r * (q + 1) + (xcd - r) * q) + off; }
        const int nig = WGM * nN, gid = wgid / nig, fm = gid * WGM, gsz = (nM - fm) < WGM ? (nM - fm) : WGM;
        u.pm = fm + ((wgid % nig) % gsz); u.pn = (wgid % nig) / gsz; return true;
    }
    __device__ __forceinline__ size_t boff(const Unit&) const { return 0; }
};
struct MoeOrder {
    static constexpr bool GATHER = false;
    const LAS int* tile_e; int nT, G, c; size_t estride;
    __device__ bool next(int i, Unit& u) const { const int L = i * G + c; u.pm = L >> 2; u.pn = L & 3; return u.pm < nT; }
    __device__ __forceinline__ size_t boff(const Unit& u) const { return (size_t)tile_e[u.pm] * estride; }
};
struct MoeGatherOrder : MoeOrder {
    static constexpr bool GATHER = true;
    const LAS int* lcnt; const LAS int* lbase; const u32x2* list;
    __device__ __forceinline__ unsigned rowoff(int r, int C, int lda) const { const int e = tile_e[r >> 8], j = r - lbase[e];
        unsigned tok = 0u; if (j < lcnt[e]) tok = list[(size_t)e * MROWS + j].x >> 1; return (tok * (unsigned)lda + (unsigned)C) * 2u; }
};

template <class Epi, class Sched, bool ALIGN_EPI = false>
__device__ __forceinline__ void gemm_phase(LAS unsigned char* lds, const Gemm g, const Sched& S, const Epi& E, const int tid) {
    const int wid = __builtin_amdgcn_readfirstlane(tid >> 6), lane = tid & 63, wr = wid >> 2, wc = wid & 3, fr = lane & 15, fq = lane >> 4;
    const int K = g.K, nt = K / BK;
    constexpr bool GA = Sched::GATHER;
    unsigned voffA[2], voffB[2]; int sR[2], sC[2];
#pragma unroll
    for (int i = 0; i < 2; ++i) { int R, C; stage_rc(tid * 16 + i * 8192, R, C); const int Rb = (R & ~31) + perm32(R & 31); sR[i] = R; sC[i] = C;
        voffA[i] = (unsigned)(R * g.lda + C) * 2u; voffB[i] = (unsigned)(Rb * K + C) * 2u; }
    unsigned ra[2][2], rn[2][2];
    const size_t kstep = (size_t)(BK * 2);
    const size_t hstepA = (size_t)HALF * g.lda * 2, hstepB = (size_t)HALF * K * 2;
    const size_t tstepA = 2 * hstepA, tstepB = 2 * hstepB;
    const unsigned ldsw = (unsigned)wid * 1024u;
    const int aoff = lds_byte(wr * 64 + fr, fq * 8), boff = lds_byte(wc * 32 + fr, fq * 8);
#define PG8_SA(b, h) (((b) * 2 + (h)) * HTB)
#define PG8_SB(b, h) ((4 + (b) * 2 + (h)) * HTB)
#define PG8_STAGE(bufoff, gbase, voff) do { _Pragma("unroll") for (int _i = 0; _i < 2; ++_i) \
        __builtin_amdgcn_global_load_lds((const unsigned*)((const char*)(gbase) + (voff)[_i]), (LAS unsigned*)(lds + (bufoff) + ldsw + _i * 8192), 16, 0, 0); } while (0)
#define PG8_ROWS(dst, u) do { if constexpr (GA) { _Pragma("unroll") for (int _h = 0; _h < 2; ++_h) _Pragma("unroll") for (int _i = 0; _i < 2; ++_i) dst[_h][_i] = S.rowoff((u).pm * 256 + _h * 128 + sR[_i], sC[_i], g.lda); } } while (0)
#define PG8_STAGE_A(bufoff, gbase, R, h) do { if constexpr (GA) { _Pragma("unroll") for (int _i = 0; _i < 2; ++_i) \
        __builtin_amdgcn_global_load_lds((const unsigned*)((const char*)(gbase) + (R)[h][_i]), (LAS unsigned*)(lds + (bufoff) + ldsw + _i * 8192), 16, 0, 0); } \
        else PG8_STAGE(bufoff, (gbase) + (h) * hstepA, voffA); } while (0)
#define PG8_LDA(dst, b, h) do { _Pragma("unroll") for (int m = 0; m < 4; ++m) _Pragma("unroll") for (int k = 0; k < 2; ++k) dst[m][k] = *(const LAS bf16x8*)(lds + PG8_SA(b, h) + aoff + m * 2048 + k * 1024); } while (0)
#define PG8_LDB(dst, b, h) do { _Pragma("unroll") for (int n = 0; n < 2; ++n) _Pragma("unroll") for (int k = 0; k < 2; ++k) dst[n][k] = *(const LAS bf16x8*)(lds + PG8_SB(b, h) + boff + n * 2048 + k * 1024); } while (0)
#define PG8_MMA(ai, bj, At, Bt) do { __builtin_amdgcn_s_setprio(1); _Pragma("unroll") for (int m = 0; m < 4; ++m) _Pragma("unroll") for (int n = 0; n < 2; ++n) _Pragma("unroll") for (int k = 0; k < 2; ++k) \
        acc[ai][bj][m][n] = __builtin_amdgcn_mfma_f32_16x16x32_bf16(Bt[n][k], At[m][k], acc[ai][bj][m][n], 0, 0, 0); __builtin_amdgcn_s_setprio(0); } while (0)
#define PG8_WAIT_V(n) asm volatile("s_waitcnt vmcnt(" #n ")" ::: "memory")
#define PG8_WAIT_L(n) asm volatile("s_waitcnt lgkmcnt(" #n ")" ::: "memory")
#define PG8_BAR __builtin_amdgcn_s_barrier()
#define PG8_SCHED __builtin_amdgcn_sched_barrier(0)
    Unit cur, nxt; int ui = 0;
    if (!S.next(0, cur)) return;
    f32x4 acc[2][2][4][2];
#pragma unroll
    for (int a = 0; a < 2; ++a)
#pragma unroll
        for (int b = 0; b < 2; ++b)
#pragma unroll
            for (int m = 0; m < 4; ++m)
#pragma unroll
                for (int n = 0; n < 2; ++n) acc[a][b][m][n] = (f32x4){0.f, 0.f, 0.f, 0.f};
    bf16x8 At[4][2], B0[2][2], B1[2][2];
    const char* cA = (const char*)g.A + (GA ? (size_t)0 : (size_t)cur.pm * tstepA); const char* cB = (const char*)g.Bt + S.boff(cur) * 2 + (size_t)cur.pn * tstepB;
    PG8_ROWS(ra, cur);
    PG8_STAGE(PG8_SB(0, 0), cB, voffB); PG8_STAGE(PG8_SB(0, 1), cB + hstepB, voffB); PG8_STAGE_A(PG8_SA(0, 0), cA, ra, 0); PG8_STAGE_A(PG8_SA(0, 1), cA, ra, 1);
    if (wr == 1) PG8_BAR;
    PG8_WAIT_V(2); PG8_BAR;
    PG8_STAGE(PG8_SB(1, 0), cB + kstep, voffB); PG8_STAGE_A(PG8_SA(1, 0), cA + kstep, ra, 0); PG8_STAGE(PG8_SB(1, 1), cB + hstepB + kstep, voffB);
    PG8_WAIT_V(6); PG8_BAR;
    for (;;) {
        const bool has_next = S.next(ui + 1, nxt);
        if constexpr (GA) { if (has_next) PG8_ROWS(rn, nxt); else { _Pragma("unroll") for (int _h = 0; _h < 2; ++_h) _Pragma("unroll") for (int _i = 0; _i < 2; ++_i) rn[_h][_i] = ra[_h][_i]; } }
        const char* nA = (has_next && !GA) ? (const char*)g.A + (size_t)nxt.pm * tstepA : cA; const char* nB = has_next ? (const char*)g.Bt + S.boff(nxt) * 2 + (size_t)nxt.pn * tstepB : cB;
        for (int t = 0; t < nt; t += 2) {
            const bool last = (t == nt - 2);
            const char* a1 = cA + (size_t)(t + 1) * kstep;
            const char* a2 = last ? nA : cA + (size_t)(t + 2) * kstep; const char* b2 = last ? nB : cB + (size_t)(t + 2) * kstep;
            const char* a3 = a2 + kstep; const char* b3 = b2 + kstep;
            unsigned rs[2][2];
            if constexpr (GA) { _Pragma("unroll") for (int _h = 0; _h < 2; ++_h) _Pragma("unroll") for (int _i = 0; _i < 2; ++_i) rs[_h][_i] = last ? rn[_h][_i] : ra[_h][_i]; }
            PG8_LDB(B0, 0, 0); PG8_LDB(B1, 0, 1); PG8_SCHED; PG8_LDA(At, 0, 0); PG8_STAGE_A(PG8_SA(1, 1), a1, ra, 1);
            PG8_WAIT_V(8); PG8_WAIT_L(0); PG8_BAR; PG8_MMA(0, 0, At, B0); PG8_MMA(0, 1, At, B1); PG8_BAR; PG8_SCHED;
            PG8_LDA(At, 0, 1); PG8_STAGE(PG8_SB(0, 0), b2, voffB); PG8_STAGE(PG8_SB(0, 1), b2 + hstepB, voffB); PG8_STAGE_A(PG8_SA(0, 0), a2, rs, 0);
            PG8_WAIT_V(8); PG8_WAIT_L(0); PG8_BAR; PG8_MMA(1, 0, At, B0); PG8_MMA(1, 1, At, B1); PG8_BAR; PG8_SCHED;
            PG8_LDB(B0, 1, 0); PG8_LDB(B1, 1, 1); PG8_SCHED; PG8_LDA(At, 1, 0); PG8_STAGE_A(PG8_SA(0, 1), a2, rs, 1);
            PG8_WAIT_V(8); PG8_WAIT_L(0); PG8_BAR; PG8_MMA(0, 0, At, B0); PG8_MMA(0, 1, At, B1); PG8_BAR; PG8_SCHED;
            PG8_LDA(At, 1, 1); PG8_STAGE(PG8_SB(1, 0), b3, voffB); PG8_STAGE(PG8_SB(1, 1), b3 + hstepB, voffB); PG8_STAGE_A(PG8_SA(1, 0), a3, rs, 0);
            PG8_WAIT_V(8); PG8_WAIT_L(0); PG8_BAR; PG8_MMA(1, 0, At, B0); PG8_MMA(1, 1, At, B1); PG8_BAR; PG8_SCHED;
        }
        if constexpr (ALIGN_EPI) { if (wr == 0) PG8_BAR; }
        E(acc, cur, wr, wc, fr, fq);
        if (!has_next) break;
#pragma unroll
        for (int a = 0; a < 2; ++a)
#pragma unroll
            for (int b = 0; b < 2; ++b)
#pragma unroll
                for (int m = 0; m < 4; ++m)
#pragma unroll
                    for (int n = 0; n < 2; ++n) acc[a][b][m][n] = (f32x4){0.f, 0.f, 0.f, 0.f};
        cur = nxt; cA = nA; cB = nB; ++ui;
        if constexpr (GA) { _Pragma("unroll") for (int _h = 0; _h < 2; ++_h) _Pragma("unroll") for (int _i = 0; _i < 2; ++_i) ra[_h][_i] = rn[_h][_i]; }
        if constexpr (ALIGN_EPI) { if (wr == 1) PG8_BAR; }
    }
    PG8_WAIT_V(0);
    if constexpr (!ALIGN_EPI) { if (wr == 0) PG8_BAR; }
    PG8_BAR;
#undef PG8_SA
#undef PG8_SB
#undef PG8_STAGE
#undef PG8_LDA
#undef PG8_ROWS
#undef PG8_STAGE_A
#undef PG8_LDB
#undef PG8_MMA
#undef PG8_WAIT_V
#undef PG8_WAIT_L
#undef PG8_BAR
#undef PG8_SCHED
}
}

#define XB_TMO      128
#define XB_XCNT(j)  (256  + 64 * (j))
#define XB_XSUB(j)  (1280 + 64 * (j))
#define XB_XGEN(j)  (2304 + 64 * (j))
#define XB_TOP      3328
#define XB_TOPGEN   3392
#define XCD_BAR_WORDS 3456
#define XB_SPIN_CAP (1u << 18)

__device__ __forceinline__ unsigned xb_ld(unsigned* p)              { return __hip_atomic_load(p, __ATOMIC_RELAXED, __HIP_MEMORY_SCOPE_AGENT); }
__device__ __forceinline__ unsigned xb_add(unsigned* p, unsigned v) { return __hip_atomic_fetch_add(p, v, __ATOMIC_RELAXED, __HIP_MEMORY_SCOPE_AGENT); }
__device__ __forceinline__ unsigned xb_xcc_id() { return (unsigned)__builtin_amdgcn_s_getreg((3 << 11) | 20) & 0xFu; }
#define XB_SPIN(cond, bar) do { unsigned _sp = 0; while (cond) { __builtin_amdgcn_s_sleep(1); \
    if ((++_sp & 255u) == 0u) { if (xb_ld(&(bar)[XB_TMO])) break; if (_sp > XB_SPIN_CAP) { atomicAdd(&(bar)[XB_TMO], 1u); break; } } } } while (0)

struct XcdBarrier {
    unsigned* bar; unsigned x;
    volatile LAS unsigned* st;
};
__device__ __forceinline__ XcdBarrier xcd_barrier_post(unsigned* bar, volatile LAS unsigned* st) {
    XcdBarrier b; b.bar = bar; b.x = xb_xcc_id(); b.st = st;
    if (threadIdx.x == 0) (void)xb_add(&bar[XB_XCNT(b.x)], 1u);
    return b;
}
__device__ __forceinline__ void xcd_barrier_complete(unsigned* bar, unsigned x, unsigned& nloc, unsigned& nx) {
    const unsigned G = gridDim.x * gridDim.y * gridDim.z;
    unsigned sum, cnt, mine, sp = 0u;
    for (;;) {
        sum = 0u; cnt = 0u; mine = 0u;
#pragma unroll
        for (unsigned j = 0; j < 16; ++j) { const unsigned c = xb_ld(&bar[XB_XCNT(j)]); sum += c; cnt += (c > 0u) ? 1u : 0u; mine = (j == x) ? c : mine; }
        if (sum == G) break;
        __builtin_amdgcn_s_sleep(1);
        if ((++sp & 255u) == 0u) { if (xb_ld(&bar[XB_TMO])) break; if (sp > XB_SPIN_CAP) { atomicAdd(&bar[XB_TMO], 1u); break; } }
    }
    nloc = mine > 0u ? mine : 1u; nx = cnt > 0u ? cnt : 1u;
}
__device__ __forceinline__ void xcd_barrier(const XcdBarrier& b) {
    asm volatile("s_waitcnt vmcnt(0)" ::: "memory");
    __syncthreads();
    if (threadIdx.x == 0) {
        unsigned* bar = b.bar;
        __builtin_amdgcn_s_waitcnt(0);
        unsigned nloc = b.st[0], nx = b.st[1];
        if (nloc == 0u) { xcd_barrier_complete(bar, b.x, nloc, nx); b.st[0] = nloc; b.st[1] = nx; }
        const unsigned old = xb_add(&bar[XB_XSUB(b.x)], 1u);
        const unsigned gen = old / nloc;
        if (old + 1u == (gen + 1u) * nloc) {
            __builtin_amdgcn_fence(__ATOMIC_RELEASE, "agent");
            asm volatile("s_waitcnt vmcnt(0)" ::: "memory");
            const unsigned og = xb_add(&bar[XB_TOP], 1u);
            const unsigned tg = og / nx;
            if (og + 1u == (tg + 1u) * nx) xb_add(&bar[XB_TOPGEN], 1u);
            else XB_SPIN(xb_ld(&bar[XB_TOPGEN]) == tg, bar);
            __builtin_amdgcn_fence(__ATOMIC_ACQUIRE, "agent");
            xb_add(&bar[XB_XGEN(b.x)], 1u);
            asm volatile("s_waitcnt vmcnt(0)" ::: "memory");
        } else {
            XB_SPIN(xb_ld(&bar[XB_XGEN(b.x)]) == gen, bar);
            __builtin_amdgcn_fence(__ATOMIC_ACQUIRE, "agent");
            asm volatile("s_waitcnt vmcnt(0)" ::: "memory");
        }
    }
    __syncthreads();
}

struct Args { const float* in[27]; float* out; unsigned char* ws; int ph_lo, ph_hi; };
struct Frame {
    LAS unsigned char* lds;
    unsigned char* ws;
    unsigned* ctl;
    const float* const* in;
    int tid, lane, wave, vcu, G, gw, NGW;
};

__device__ __forceinline__ void p0_transpose_item(const float* W, int K, int N, bf16_t* WT, int mode, LAS unsigned* scr, int item, int lane, float scale = 1.f) {
    const int nblk = (N + 63) / 64, kb = item / nblk, nb = item % nblk, k0 = 64 * kb, n0 = 64 * nb;
    const int drow0 = mode == 0 ? n0 : ((n0 >> 7) * 256 + (n0 & 127) + (mode == 2 ? 128 : 0));
    const int r = lane >> 4, n4 = lane & 15; const bool okc = n0 + 4 * n4 < N;
    f32x4 la[8], lb[8];
#pragma unroll
    for (int st = 0; st < 8; ++st) { const float* p = W + (size_t)(k0 + st * 8 + 2 * r) * N + n0 + 4 * n4;
        la[st] = okc ? __builtin_nontemporal_load((const f32x4*)p) : (f32x4){0.f, 0.f, 0.f, 0.f}; lb[st] = okc ? __builtin_nontemporal_load((const f32x4*)(p + N)) : (f32x4){0.f, 0.f, 0.f, 0.f}; }
#pragma unroll
    for (int st = 0; st < 8; ++st)
#pragma unroll
        for (int q = 0; q < 4; ++q) scr[(4 * n4 + q) * 33 + st * 4 + r] = cvt_pk_bf16(la[st][q] * scale, lb[st][q] * scale);
    LDS_WAIT(); asm volatile("" ::: "memory");
    const int c = lane & 7;
#pragma unroll
    for (int st = 0; st < 8; ++st) { const int n = st * 8 + (lane >> 3); const LAS unsigned* sp = scr + n * 33 + 4 * c;
        const u32x4 o = {sp[0], sp[1], sp[2], sp[3]};
        if (n0 + n < N) *(u32x4*)(WT + (size_t)(drow0 + n) * K + k0 + 8 * c) = o; }
    LDS_WAIT(); asm volatile("" ::: "memory");
}
__device__ __forceinline__ float silu_f(float x) { return x / (1.f + __expf(-x)); }

__device__ __forceinline__ void p0_prologue(Frame& F) {
    {
        LAS float* sv = (LAS float*)F.lds;
        LAS float* red = (LAS float*)(F.lds + 12288);
        const float* c = F.in[1]; const float* cc = F.in[3];
        for (int i = F.tid; i < 3072; i += NTHREADS) { const float x = i < 2048 ? c[i] : cc[i - 2048]; sv[i] = silu_f(x); }
        __syncthreads();
        const float* wada = F.in[4]; const float* bada = F.in[5]; float* mod = (float*)(F.ws + WS_MOD);
        for (int it = F.vcu; it < 4 * 96; it += F.G) {
            const int l = it / 96, n = (it % 96) * 64 + F.lane;
            const float* wp = wada + ((size_t)l * 1024 + F.wave * 128) * 6144 + n;
            float a0 = 0.f, a1 = 0.f, a2 = 0.f;
#pragma unroll 16
            for (int k = 0; k < 128; ++k) { const float w = wp[(size_t)k * 6144]; const int kk = F.wave * 128 + k; a0 += sv[kk] * w; a1 += sv[1024 + kk] * w; a2 += sv[2048 + kk] * w; }
            red[(F.wave * 3 + 0) * 64 + F.lane] = a0; red[(F.wave * 3 + 1) * 64 + F.lane] = a1; red[(F.wave * 3 + 2) * 64 + F.lane] = a2;
            __syncthreads();
            if (F.wave < 3) { float s = bada[l * 6144 + n];
#pragma unroll
                for (int w = 0; w < 8; ++w) s += red[(w * 3 + F.wave) * 64 + F.lane];
                mod[(size_t)(l * 3 + F.wave) * 6144 + n] = s; }
            __syncthreads();
        }
    }
    {
        f32x2* rope = (f32x2*)(F.ws + WS_ROPE);
        for (int e = F.vcu * NTHREADS + F.tid; e < 7680; e += F.G * NTHREADS) {
            int pos, i, n;
            if (e < 2048) { pos = e >> 3; i = e & 7; n = 8; } else if (e < 2560) { pos = (e - 2048) >> 3; i = e & 7; n = 8; }
            else if (e < 6656) { pos = (e - 2560) >> 4; i = (e - 2560) & 15; n = 16; } else { pos = (e - 6656) >> 4; i = (e - 6656) & 15; n = 16; }
            const float inv = powf(10000.f, -(float)i / (float)n);
            const float ang = (float)pos * inv; float s, co; sincosf(ang, &s, &co);
            rope[e] = (f32x2){co, s};
        }
    }
    {
        bf16_t* winT = (bf16_t*)(F.ws + WS_WIN);
        for (int e = F.vcu * NTHREADS + F.tid; e < 2 * 96 * 128; e += F.G * NTHREADS) { const int i = e / (96 * 128), r = (e / 128) % 96, c8 = e % 128;
            *(u32x4*)(winT + ((size_t)i * AB_INP + AB_IN + r) * 1024 + c8 * 8) = (u32x4){0u, 0u, 0u, 0u}; }
    }
    {
        LAS unsigned* scr = (LAS unsigned*)(F.lds + F.wave * 16384);
        constexpr int I_WIN = 16 * 23, I_QUP = 6 * 12, I_KVUP = 4 * 16, I_OUT = 16 * 16, I_NIN = 16 * 48, I_NOUT = 16 * 16;
        constexpr int I_SMALL = I_WIN + I_QUP + I_KVUP + I_OUT + I_NIN + I_NOUT;
        constexpr int NITEMS = 2 * I_SMALL + 128 * 384;
        for (int it = F.gw; it < NITEMS; it += F.NGW) {
            if (it < 2 * I_SMALL) {
                const int i = it / I_SMALL; int r = it % I_SMALL;
                if (r < I_WIN) { p0_transpose_item(F.in[9] + (size_t)i * 1024 * 1440, 1024, 1440, (bf16_t*)(F.ws + WS_WIN) + (size_t)i * AB_INP * 1024, 0, scr, r, F.lane); continue; } r -= I_WIN;
                if (r < I_QUP) { p0_transpose_item(F.in[12] + (size_t)i * 384 * 768, 384, 768, (bf16_t*)(F.ws + WS_WQUP) + (size_t)i * 768 * 384, 0, scr, r, F.lane, SC_A); continue; } r -= I_QUP;
                if (r < I_KVUP) { p0_transpose_item(F.in[14] + (size_t)i * 256 * 1024, 256, 1024, (bf16_t*)(F.ws + WS_WKVUP) + (size_t)i * 1024 * 256, 0, scr, r, F.lane); continue; } r -= I_KVUP;
                if (r < I_OUT) { p0_transpose_item(F.in[10] + (size_t)i * 1024 * 1024, 1024, 1024, (bf16_t*)(F.ws + WS_WOUT) + (size_t)i * 1024 * 1024, 0, scr, r, F.lane); continue; } r -= I_OUT;
                if (r < I_NIN) { p0_transpose_item(F.in[17] + (size_t)i * 1024 * 3072, 1024, 3072, (bf16_t*)(F.ws + WS_NIN) + (size_t)i * 3072 * 1024, 0, scr, r, F.lane); continue; } r -= I_NIN;
                p0_transpose_item(F.in[18] + (size_t)i * 1024 * 1024, 1024, 1024, (bf16_t*)(F.ws + WS_NOUT) + (size_t)i * 1024 * 1024, 0, scr, r, F.lane);
            } else {
                const int r = it - 2 * I_SMALL, le = r / 384, q = r % 384, kind = q >> 7, sub = q & 127, l = le >> 5, e = le & 31;
                bf16_t* gu = (bf16_t*)(F.ws + WS_MOEW + (size_t)l * MOEW_LAYER) + (size_t)e * 1024 * 1024;
                bf16_t* dn = (bf16_t*)(F.ws + WS_MOEW + (size_t)l * MOEW_LAYER + MOEW_DN) + (size_t)e * 1024 * 512;
                if (kind == 0) p0_transpose_item(F.in[24] + (size_t)le * 1024 * 512, 1024, 512, gu, 1, scr, sub, F.lane);
                else if (kind == 1) p0_transpose_item(F.in[25] + (size_t)le * 1024 * 512, 1024, 512, gu, 2, scr, sub, F.lane);
                else p0_transpose_item(F.in[26] + (size_t)le * 512 * 1024, 512, 1024, dn, 0, scr, sub, F.lane);
            }
        }
    }
}

__device__ __forceinline__ void store_bf16_row(bf16_t* orow, int lane, const f32x4 (&h)[4]) {
#pragma unroll
    for (int j = 0; j < 4; ++j) { u32x2 w; w.x = cvt_pk_bf16(h[j].x, h[j].y); w.y = cvt_pk_bf16(h[j].z, h[j].w); *(u32x2*)(orow + 256 * j + 4 * lane) = w; }
}
__device__ __forceinline__ void combine_row(f32x4 (&x)[4], const bf16_t* y0, const float* g2, int lane) {
#pragma unroll
    for (int j = 0; j < 4; ++j) {
        const u32x2 a = *(const u32x2*)(y0 + 256 * j + 4 * lane), b = *(const u32x2*)(y0 + 1024 + 256 * j + 4 * lane);
        const f32x4 g = *(const f32x4*)(g2 + 256 * j + 4 * lane) * MOE_ALPHA;
        x[j].x += g.x * (bf16lo(a.x) + bf16lo(b.x)); x[j].y += g.y * (bf16hi(a.x) + bf16hi(b.x));
        x[j].z += g.z * (bf16lo(a.y) + bf16lo(b.y)); x[j].w += g.w * (bf16hi(a.y) + bf16hi(b.y));
    }
}
__device__ __forceinline__ float row_rs(const f32x4 (&x)[4]) {
    float s = 0.f;
#pragma unroll
    for (int j = 0; j < 4; ++j) s += (x[j].x * x[j].x + x[j].y * x[j].y) + (x[j].z * x[j].z + x[j].w * x[j].w);
    return rsqrtf(wave_sum(s) * (1.f / 1024.f) + RMS_EPS);
}
__device__ __forceinline__ void modulate_row(const f32x4 (&x)[4], f32x4 (&h)[4], float rs, const float* gain, const float* sh, const float* sc, int lane) {
#pragma unroll
    for (int j = 0; j < 4; ++j) {
        const f32x4 g = *(const f32x4*)(gain + 256 * j + 4 * lane), s1 = *(const f32x4*)(sc + 256 * j + 4 * lane), s0 = *(const f32x4*)(sh + 256 * j + 4 * lane);
        h[j] = (x[j] * rs) * g * (s1 + 1.f) + s0;
    }
}

struct RowVec { f32x4 a[4], b[4], g[4]; };
__device__ __forceinline__ void load_rowvec(RowVec& V, const float* gain, const float* sh, const float* sc, const float* g2, int lane) {
#pragma unroll
    for (int j = 0; j < 4; ++j) { const int c = 256 * j + 4 * lane;
        const f32x4 g = *(const f32x4*)(gain + c), s1 = *(const f32x4*)(sc + c); V.a[j] = g * (s1 + 1.f); V.b[j] = *(const f32x4*)(sh + c);
        V.g[j] = g2 ? *(const f32x4*)(g2 + c) * MOE_ALPHA : (f32x4){0.f, 0.f, 0.f, 0.f}; }
}
struct RowRaw { f32x4 x[4]; u32x2 y0[4], y1[4]; };
__device__ __forceinline__ void load_rowraw(RowRaw& R, const float* xrow, const bf16_t* yrow, int lane) {
#pragma unroll
    for (int j = 0; j < 4; ++j) R.x[j] = *(const f32x4*)(xrow + 256 * j + 4 * lane);
    if (yrow) {
#pragma unroll
        for (int j = 0; j < 4; ++j) { R.y0[j] = *(const u32x2*)(yrow + 256 * j + 4 * lane); R.y1[j] = *(const u32x2*)(yrow + 1024 + 256 * j + 4 * lane); } }
}
__device__ __forceinline__ void combine_raw(RowRaw& R, const RowVec& V) {
#pragma unroll
    for (int j = 0; j < 4; ++j) { const u32x2 a = R.y0[j], b = R.y1[j];
        R.x[j].x += V.g[j].x * (bf16lo(a.x) + bf16lo(b.x)); R.x[j].y += V.g[j].y * (bf16hi(a.x) + bf16hi(b.x));
        R.x[j].z += V.g[j].z * (bf16lo(a.y) + bf16lo(b.y)); R.x[j].w += V.g[j].w * (bf16hi(a.y) + bf16hi(b.y)); }
}
__device__ __forceinline__ int chunk_lo(int gw, int M, int NGW) { return (int)(((long)gw * M) / NGW); }

__device__ __forceinline__ void mix_norm_phase(Frame& F, int l) {
    float* X = (float*)(F.ws + WS_X); bf16_t* H = (bf16_t*)(F.ws + WS_H);
    const float* mod = (const float*)(F.ws + WS_MOD); const bf16_t* Y = (const bf16_t*)(F.ws + R_Y);
    const float* gain = F.in[6] + l * 1024;
    const int r0 = chunk_lo(F.gw, MROWS, F.NGW), r1 = chunk_lo(F.gw + 1, MROWS, F.NGW);
    RowVec V; RowRaw cur, nxt; int vcur = -1;
#define SRC(m) ((l == 0) ? ((m) < NLAT ? F.in[0] + (size_t)(m) * 1024 : F.in[2] + (size_t)((m) - NLAT) * 1024) : X + (size_t)(m) * 1024)
    if (r0 < r1) load_rowraw(nxt, SRC(r0), l > 0 ? Y + (size_t)r0 * 2048 : nullptr, F.lane);
    for (int m = r0; m < r1; ++m) {
        cur = nxt;
        if (m + 1 < r1) load_rowraw(nxt, SRC(m + 1), l > 0 ? Y + (size_t)(m + 1) * 2048 : nullptr, F.lane);
        const int v = row_class(m);
        if (v != vcur) { vcur = v; const float* mv = mod + (size_t)(l * 3 + v) * 6144;
            load_rowvec(V, gain, mv, mv + 1024, l > 0 ? mod + ((size_t)((l - 1) * 3 + v) * 6 + 5) * 1024 : nullptr, F.lane); }
        if (l > 0) combine_raw(cur, V);
#pragma unroll
        for (int j = 0; j < 4; ++j) *(f32x4*)(X + (size_t)m * 1024 + 256 * j + 4 * F.lane) = cur.x[j];
        const float rs = row_rs(cur.x);
        f32x4 h[4];
#pragma unroll
        for (int j = 0; j < 4; ++j) h[j] = (cur.x[j] * rs) * V.a[j] + V.b[j];
        store_bf16_row(H + (size_t)m * 1024, F.lane, h);
    }
#undef SRC
}
__device__ __forceinline__ void final_phase(Frame& F, float* out) {
    const float* X = (const float*)(F.ws + WS_X); const float* mod = (const float*)(F.ws + WS_MOD); const bf16_t* Y = (const bf16_t*)(F.ws + R_Y);
    const float* gain = F.in[8];
    const int r0 = chunk_lo(F.gw, NLAT, F.NGW), r1 = chunk_lo(F.gw + 1, NLAT, F.NGW);
    RowVec V; RowRaw cur, nxt; int vcur = -1;
    if (r0 < r1) load_rowraw(nxt, X + (size_t)r0 * 1024, Y + (size_t)r0 * 2048, F.lane);
    for (int m = r0; m < r1; ++m) {
        cur = nxt;
        if (m + 1 < r1) load_rowraw(nxt, X + (size_t)(m + 1) * 1024, Y + (size_t)(m + 1) * 2048, F.lane);
        const int v = row_class(m);
        if (v != vcur) { vcur = v; const float* mv = mod + (size_t)(3 * 3 + v) * 6144; load_rowvec(V, gain, mv, mv + 1024, mv + 5 * 1024, F.lane); }
        combine_raw(cur, V);
        float rs = row_rs(cur.x);
        if (DBG_SEL >= 0 && DBG_SEL < 100) rs *= 1.f + (DBG_SEL >= 16 ? 10.f : 1.f) * fminf(u2f(__hip_atomic_load(F.ctl + CW_DBG + DBG_SEL, RLX_AGENT)), 0.3f);
        if (DBG_SEL == 101) { float code = 0.f;
            for (int g = 0; g < 8; ++g) { float e = 0.f; for (int q = 0; q < 4; ++q) e = fmaxf(e, u2f(__hip_atomic_load(F.ctl + CW_DBG + 16 + 4 * g + q, RLX_AGENT))); if (e > 0.05f) code += 0.1f * (float)(1 << g); }
            rs *= 1.f + code; }
#pragma unroll
        for (int j = 0; j < 4; ++j) { const f32x4 g = *(const f32x4*)(gain + 256 * j + 4 * F.lane); *(f32x4*)(out + (size_t)m * 1024 + 256 * j + 4 * F.lane) = (cur.x[j] * rs) * g; }
    }
}

__device__ __forceinline__ void ffn_norm_route_phase(Frame& F, int l) {
    const int M = (l == DEPTH - 1) ? NLAT : MROWS;
    const float* X = (const float*)(F.ws + WS_X); bf16_t* H = (bf16_t*)(F.ws + WS_H);
    const float* mod = (const float*)(F.ws + WS_MOD);
    const float* gain = F.in[7] + l * 1024;
    LAS float* tab = (LAS float*)F.lds;
    LAS int* lcnt = (LAS int*)(F.lds + CNTL_OFF); LAS int* lbase = lcnt + 32;
    LAS int* rec = (LAS int*)(F.lds + REC_OFF);
    {
        const float* wrg = F.in[20] + (size_t)l * 4096; const float* wre = F.in[22] + (size_t)l * 32768;
        for (int i = F.tid; i < 4096; i += NTHREADS) tab[(i & 3) * TAB_LD + (i >> 2)] = wrg[i];
        for (int i = F.tid; i < 32768; i += NTHREADS) tab[(4 + (i & 31)) * TAB_LD + (i >> 5)] = wre[i];
        if (F.tid < 32) lcnt[F.tid] = 0;
    }
    __syncthreads();
    const float* brg = F.in[21] + l * 4; const float* bre = F.in[23] + l * 32;
    const int r0 = chunk_lo(F.gw, M, F.NGW), r1 = chunk_lo(F.gw + 1, M, F.NGW);
    RowVec V; RowRaw cur, nxt; int vcur = -1;
    if (r0 < r1) load_rowraw(nxt, X + (size_t)r0 * 1024, nullptr, F.lane);
    int it = 0;
    for (int m = r0; m < r1; ++m, ++it) {
        cur = nxt;
        if (m + 1 < r1) load_rowraw(nxt, X + (size_t)(m + 1) * 1024, nullptr, F.lane);
        const int v = row_class(m);
        if (v != vcur) { vcur = v; const float* mv = mod + (size_t)(l * 3 + v) * 6144; load_rowvec(V, gain, mv + 3 * 1024, mv + 4 * 1024, nullptr, F.lane); }
        const float rs = row_rs(cur.x);
        f32x4 h[4];
#pragma unroll
        for (int j = 0; j < 4; ++j) h[j] = (cur.x[j] * rs) * V.a[j] + V.b[j];
        store_bf16_row(H + (size_t)m * 1024, F.lane, h);
        float lg[36];
#pragma unroll
        for (int o = 0; o < 36; ++o) {
            f32x2 a2 = {0.f, 0.f};
#pragma unroll
            for (int j = 0; j < 4; ++j) { const f32x4 w = *(const LAS f32x4*)(tab + o * TAB_LD + 256 * j + 4 * F.lane);
                a2 = __builtin_elementwise_fma((f32x2){h[j].x, h[j].y}, (f32x2){w.x, w.y}, a2); a2 = __builtin_elementwise_fma((f32x2){h[j].z, h[j].w}, (f32x2){w.z, w.w}, a2); }
            lg[o] = a2.x + a2.y;
        }
#pragma unroll
        for (int o = 0; o < 36; ++o) lg[o] = wave_sum(lg[o]);
        float g0 = lg[0] + brg[0], g1 = lg[1] + brg[1], g2 = lg[2] + brg[2], g3 = lg[3] + brg[3];
        int gs = 0; float gm = g0;
        if (g1 > gm) { gm = g1; gs = 1; } if (g2 > gm) { gm = g2; gs = 2; } if (g3 > gm) { gm = g3; gs = 3; }
        const float pg = 1.f / (__expf(g0 - gm) + __expf(g1 - gm) + __expf(g2 - gm) + __expf(g3 - gm));
        float se[8];
#pragma unroll
        for (int j = 0; j < 8; ++j) { const float a0 = lg[4 + j] + bre[j], a1 = lg[12 + j] + bre[8 + j], a2 = lg[20 + j] + bre[16 + j], a3 = lg[28 + j] + bre[24 + j];
            se[j] = gs == 0 ? a0 : (gs == 1 ? a1 : (gs == 2 ? a2 : a3)); }
        int i0 = 0; float m0 = se[0];
#pragma unroll
        for (int j = 1; j < 8; ++j) if (se[j] > m0) { m0 = se[j]; i0 = j; }
        int i1 = -1; float m1 = -3.0e38f;
#pragma unroll
        for (int j = 0; j < 8; ++j) if (j != i0 && se[j] > m1) { m1 = se[j]; i1 = j; }
        const float e1 = __expf(m1 - m0), w0 = pg / (1.f + e1), w1 = pg * e1 / (1.f + e1);
        if (F.lane < 2) {
            const int e = gs * 8 + (F.lane == 0 ? i0 : i1); const float w = F.lane == 0 ? w0 : w1;
            const int lr = atomicAdd((int*)(lcnt + e), 1);
            LAS int* r = rec + ((it * 8 + F.wave) * 2 + F.lane) * 3; r[0] = e; r[1] = lr; r[2] = __builtin_bit_cast(int, W_CONST > 0.f ? W_CONST : w);
        }
    }
    __syncthreads();
    if (F.tid < 32) lbase[F.tid] = (int)__hip_atomic_fetch_add(F.ctl + CW_CNT + (l * 32 + F.tid) * 64, (unsigned)lcnt[F.tid], RLX_AGENT);
    __syncthreads();
    u32x2* list = (u32x2*)(F.ws + WS_LIST);
    it = 0;
    for (int m = r0; m < r1; ++m, ++it) {
        if (F.lane < 2) { const LAS int* r = rec + ((it * 8 + F.wave) * 2 + F.lane) * 3; const int e = r[0], pos = lbase[e] + r[1];
            list[(size_t)e * MROWS + pos] = (u32x2){(unsigned)(2 * m + F.lane), (unsigned)r[2]}; }
    }
}

__device__ __forceinline__ void moe_tile_map(Frame& F, int l) {
    LAS int* tile_e = (LAS int*)(F.lds + TILE_E_OFF); LAS int* nt = (LAS int*)(F.lds + MOE_NT_OFF);
    LAS int* lcnt = (LAS int*)(F.lds + CNTL_OFF); LAS int* lbase = lcnt + 32;
    __syncthreads();
    if (F.tid < 32) lcnt[F.tid] = (int)__hip_atomic_load(F.ctl + CW_CNT + (l * 32 + F.tid) * 64, RLX_AGENT);
    __syncthreads();
    if (F.tid == 0) {
        int t0 = 0;
        for (int e = 0; e < 32; ++e) { const int c = lcnt[e], n = (c + 255) >> 8; lbase[e] = t0 * 256; for (int t = 0; t < n && t0 + t < 320; ++t) tile_e[t0 + t] = e; t0 += n; }
        nt[0] = t0 < MOE_MAXT ? t0 : MOE_MAXT;
    }
    __syncthreads();
}
__device__ __forceinline__ void moe_gather_phase(Frame& F, int l) {
    moe_tile_map(F, l);
    const LAS int* tile_e = (const LAS int*)(F.lds + TILE_E_OFF); const int nT = *(const LAS int*)(F.lds + MOE_NT_OFF);
    const LAS int* lcnt = (const LAS int*)(F.lds + CNTL_OFF); const LAS int* lbase = lcnt + 32;
    const bf16_t* H = (const bf16_t*)(F.ws + WS_H); bf16_t* XB = (bf16_t*)(F.ws + R_XB); u32x2* RI = (u32x2*)(F.ws + R_RI);
    const u32x2* list = (const u32x2*)(F.ws + WS_LIST);
    const int nrows = nT * 256;
    for (int rb = F.gw * 4; rb < nrows; rb += F.NGW * 4) {
        u32x2 ri[4]; u32x4 a[4], b[4];
#pragma unroll
        for (int q = 0; q < 4; ++q) { const int r = rb + q; const int e = tile_e[r >> 8], j = r - lbase[e];
            ri[q] = (u32x2){0xffffffffu, 0u};
            if (j < lcnt[e]) ri[q] = list[(size_t)e * MROWS + j]; }
#pragma unroll
        for (int q = 0; q < 4; ++q) { a[q] = (u32x4){0u, 0u, 0u, 0u}; b[q] = a[q];
            if (ri[q].x != 0xffffffffu) { const bf16_t* src = H + (size_t)(ri[q].x >> 1) * 1024; a[q] = *(const u32x4*)(src + F.lane * 8); b[q] = *(const u32x4*)(src + 512 + F.lane * 8); } }
#pragma unroll
        for (int q = 0; q < 4; ++q) { const int r = rb + q;
            *(u32x4*)(XB + (size_t)r * 1024 + F.lane * 8) = a[q]; *(u32x4*)(XB + (size_t)r * 1024 + 512 + F.lane * 8) = b[q];
            if (F.lane == 0) RI[r] = ri[q]; }
    }
}

using pg8::Unit;
__device__ __forceinline__ u32x4 pack8(const f32x4 v0, const f32x4 v1) { u32x4 w; w.x = cvt_pk_bf16(v0[0], v0[1]); w.y = cvt_pk_bf16(v0[2], v0[3]); w.z = cvt_pk_bf16(v1[0], v1[1]); w.w = cvt_pk_bf16(v1[2], v1[3]); return w; }

struct EpiStore {
    bf16_t* O; int ldc;
    __device__ __forceinline__ void operator()(const f32x4 (&acc)[2][2][4][2], const Unit& u, int wr, int wc, int fr, int fq) const {
        const int row0 = u.pm * 256 + wr * 64 + fr, col0 = u.pn * 256 + wc * 32 + 8 * fq;
#pragma unroll
        for (int ai = 0; ai < 2; ++ai)
#pragma unroll
            for (int m = 0; m < 4; ++m) { bf16_t* rowp = O + (size_t)(row0 + ai * 128 + m * 16) * ldc + col0;
#pragma unroll
                for (int bj = 0; bj < 2; ++bj) *(u32x4*)(rowp + bj * 128) = pack8(acc[ai][bj][m][0], acc[ai][bj][m][1]); }
    }
};
struct EpiOut {
    float* X; const float* modl;
    __device__ __forceinline__ void operator()(const f32x4 (&acc)[2][2][4][2], const Unit& u, int wr, int wc, int fr, int fq) const {
        const int row0 = u.pm * 256 + wr * 64 + fr, col0 = u.pn * 256 + wc * 32 + 8 * fq;
        const int v = u.pm < 64 ? 0 : (u.pm < 128 ? 1 : 2);
        const float* g1 = modl + (size_t)v * 6144 + 2 * 1024 + col0;
        f32x4 g[2][2];
#pragma unroll
        for (int bj = 0; bj < 2; ++bj) { g[bj][0] = *(const f32x4*)(g1 + bj * 128); g[bj][1] = *(const f32x4*)(g1 + bj * 128 + 4); }
#pragma unroll
        for (int ai = 0; ai < 2; ++ai)
#pragma unroll
            for (int m = 0; m < 4; ++m) { float* rowp = X + (size_t)(row0 + ai * 128 + m * 16) * 1024 + col0;
#pragma unroll
                for (int bj = 0; bj < 2; ++bj) { f32x4* p = (f32x4*)(rowp + bj * 128);
                    const f32x4 a = p[0], b = p[1];
                    p[0] = a + g[bj][0] * acc[ai][bj][m][0]; p[1] = b + g[bj][1] * acc[ai][bj][m][1]; } }
    }
};
struct EpiNaIn {
    bf16_t* QK; bf16_t* Vt; bf16_t* Vtc;
    __device__ __forceinline__ void operator()(const f32x4 (&acc)[2][2][4][2], const Unit& u, int wr, int wc, int fr, int fq) const {
        const int row0 = u.pm * 256 + wr * 64 + fr, col0 = u.pn * 256 + wc * 32 + 8 * fq;
        if (u.pn < 8) {
            const float sc = u.pn < 4 ? SC_B : 1.f;
#pragma unroll
            for (int ai = 0; ai < 2; ++ai)
#pragma unroll
                for (int m = 0; m < 4; ++m) { bf16_t* rowp = QK + (size_t)(row0 + ai * 128 + m * 16) * 2048 + col0;
#pragma unroll
                    for (int bj = 0; bj < 2; ++bj) *(u32x4*)(rowp + bj * 128) = pack8(acc[ai][bj][m][0] * sc, acc[ai][bj][m][1] * sc); }
        } else {
#pragma unroll
            for (int ai = 0; ai < 2; ++ai)
#pragma unroll
                for (int m = 0; m < 4; ++m) { const int row = row0 + ai * 128 + m * 16;
                    bf16_t* base; size_t ld;
                    if (row < NLAT) { base = Vt + (size_t)(row >> 14) * 1024 * SEQ + (row & (SEQ - 1)); ld = SEQ; }
                    else { const int rc = row - NLAT; base = Vtc + (size_t)(rc >> 8) * 1024 * CTXL + (rc & 255); ld = CTXL; }
#pragma unroll
                    for (int bj = 0; bj < 2; ++bj) { const int hc = col0 + bj * 128 - 2048;
                        const u32x4 w = pack8(acc[ai][bj][m][0], acc[ai][bj][m][1]);
                        bf16_t* p = base + (size_t)hc * ld;
                        p[0] = (bf16_t)(w.x & 0xffff); p[ld] = (bf16_t)(w.x >> 16); p[2 * ld] = (bf16_t)(w.y & 0xffff); p[3 * ld] = (bf16_t)(w.y >> 16);
                        p[4 * ld] = (bf16_t)(w.z & 0xffff); p[5 * ld] = (bf16_t)(w.z >> 16); p[6 * ld] = (bf16_t)(w.w & 0xffff); p[7 * ld] = (bf16_t)(w.w >> 16); } }
        }
    }
};
struct EpiMoe1 {
    bf16_t* ACT;
    __device__ __forceinline__ void operator()(const f32x4 (&acc)[2][2][4][2], const Unit& u, int wr, int wc, int fr, int fq) const {
        const int row0 = u.pm * 256 + wr * 64 + fr, col0 = u.pn * 128 + wc * 32 + 8 * fq;
#pragma unroll
        for (int ai = 0; ai < 2; ++ai)
#pragma unroll
            for (int m = 0; m < 4; ++m) { f32x4 o[2];
#pragma unroll
                for (int n = 0; n < 2; ++n)
#pragma unroll
                    for (int i = 0; i < 4; ++i) { const float g = acc[ai][0][m][n][i], up = acc[ai][1][m][n][i];
                        o[n][i] = g * __builtin_amdgcn_rcpf(1.f + __builtin_amdgcn_exp2f(-g * LOG2E)) * up; }
                *(u32x4*)(ACT + (size_t)(row0 + ai * 128 + m * 16) * 512 + col0) = pack8(o[0], o[1]); }
    }
};
struct EpiMoe2 {
    bf16_t* Y; const LAS int* tile_e; const LAS int* lcnt; const LAS int* lbase; const u32x2* list;
    __device__ __forceinline__ void operator()(const f32x4 (&acc)[2][2][4][2], const Unit& u, int wr, int wc, int fr, int fq) const {
        const int row0 = u.pm * 256 + wr * 64 + fr, col0 = u.pn * 256 + wc * 32 + 8 * fq;
        const int e = tile_e[u.pm], j0 = row0 - lbase[e], cnt = lcnt[e];
#pragma unroll
        for (int ai = 0; ai < 2; ++ai)
#pragma unroll
            for (int m = 0; m < 4; ++m) { const int j = j0 + ai * 128 + m * 16;
                if (j < cnt) { const u32x2 ri = list[(size_t)e * MROWS + j]; const float w = u2f(ri.y); bf16_t* rowp = Y + (size_t)ri.x * 1024 + col0;
#pragma unroll
                    for (int bj = 0; bj < 2; ++bj) *(u32x4*)(rowp + bj * 128) = pack8(acc[ai][bj][m][0] * w, acc[ai][bj][m][1] * w); } }
    }
};

__device__ __forceinline__ void ab_prep_phase(Frame& F, int li) {
    const bf16_t* P = (const bf16_t*)(F.ws + R_P);
    bf16_t* CQN = (bf16_t*)(F.ws + R_CQN); bf16_t* CKVN = (bf16_t*)(F.ws + R_CKVN); bf16_t* KR = (bf16_t*)(F.ws + R_KR);
    bf16_t* QB = (bf16_t*)(F.ws + R_QB); bf16_t* KB = (bf16_t*)(F.ws + R_KB); bf16_t* VB = (bf16_t*)(F.ws + R_VB);
    const f32x2* rope = (const f32x2*)(F.ws + WS_ROPE);
    const float* qn = F.in[11] + li * QLORA; const float* kvn = F.in[13] + li * KVLORA; const float* gqn = F.in[15] + li * 64; const float* gkn = F.in[16] + li * 64;
    const int l = F.lane;
    for (int m = F.gw; m < MROWS; m += F.NGW) {
        const bf16_t* p = P + (size_t)m * AB_INP;
        const bool lat = m < NLAT; const int t = m & (SEQ - 1), gr = t >> 6, gc = t & 63;
        const unsigned* pc = (const unsigned*)(p + 6 * l); const unsigned c0 = pc[0], c1 = pc[1], c2 = pc[2];
        const u32x2 kv = *(const u32x2*)(p + 384 + 4 * l);
        const unsigned krw = *(const unsigned*)(p + 640 + 2 * (l & 15));
        const u32x4 gq = *(const u32x4*)(p + 672 + 8 * l);
        const unsigned gkw = *(const unsigned*)(p + 1184 + 2 * l), gvw = *(const unsigned*)(p + 1312 + 2 * l);
        { float x[6] = {bf16lo(c0), bf16hi(c0), bf16lo(c1), bf16hi(c1), bf16lo(c2), bf16hi(c2)};
          float ss = 0.f;
#pragma unroll
          for (int i = 0; i < 6; ++i) ss += x[i] * x[i];
          const float rs = rsqrtf(wave_sum(ss) * (1.f / 384.f) + RMS_EPS);
          unsigned* o = (unsigned*)(CQN + (size_t)m * QLORA + 6 * l);
#pragma unroll
          for (int i = 0; i < 3; ++i) o[i] = cvt_pk_bf16(x[2 * i] * rs * qn[6 * l + 2 * i], x[2 * i + 1] * rs * qn[6 * l + 2 * i + 1]); }
        { float x[4] = {bf16lo(kv.x), bf16hi(kv.x), bf16lo(kv.y), bf16hi(kv.y)};
          const float ss = (x[0] * x[0] + x[1] * x[1]) + (x[2] * x[2] + x[3] * x[3]);
          const float rs = rsqrtf(wave_sum(ss) * (1.f / 256.f) + RMS_EPS);
          const f32x4 g = *(const f32x4*)(kvn + 4 * l);
          u32x2 w; w.x = cvt_pk_bf16(x[0] * rs * g.x, x[1] * rs * g.y); w.y = cvt_pk_bf16(x[2] * rs * g.z, x[3] * rs * g.w);
          *(u32x2*)(CKVN + (size_t)m * KVLORA + 4 * l) = w; }
        if (l < 16) { float x1 = bf16lo(krw), x2 = bf16hi(krw);
            if (lat) { const f32x2 cs = (l < 8) ? rope[gr * 8 + l] : rope[2048 + gc * 8 + (l - 8)]; const float a = x1 * cs.x - x2 * cs.y, b = x1 * cs.y + x2 * cs.x; x1 = a; x2 = b; }
            *(unsigned*)(KR + (size_t)m * 32 + 2 * l) = cvt_pk_bf16(x1, x2); }
        { float x[8] = {bf16lo(gq.x), bf16hi(gq.x), bf16lo(gq.y), bf16hi(gq.y), bf16lo(gq.z), bf16hi(gq.z), bf16lo(gq.w), bf16hi(gq.w)};
          float ss = 0.f;
#pragma unroll
          for (int i = 0; i < 8; ++i) ss += x[i] * x[i];
          ss += __shfl_xor(ss, 1); ss += __shfl_xor(ss, 2); ss += __shfl_xor(ss, 4);
          const float rs = rsqrtf(ss * (1.f / 64.f) + RMS_EPS);
          const int d0 = (l & 7) * 8;
          const f32x4 g0 = *(const f32x4*)(gqn + d0), g1 = *(const f32x4*)(gqn + d0 + 4);
          x[0] *= rs * g0.x; x[1] *= rs * g0.y; x[2] *= rs * g0.z; x[3] *= rs * g0.w; x[4] *= rs * g1.x; x[5] *= rs * g1.y; x[6] *= rs * g1.z; x[7] *= rs * g1.w;
          if (lat) { const int p0 = (l & 7) * 4; const f32x2* tp = (p0 < 16) ? rope + 2560 + gr * 16 + p0 : rope + 6656 + gc * 16 + (p0 - 16);
              const f32x4 cs0 = *(const f32x4*)tp, cs1 = *(const f32x4*)(tp + 2);
              float a;
              a = x[0] * cs0[0] - x[1] * cs0[1]; x[1] = x[0] * cs0[1] + x[1] * cs0[0]; x[0] = a;
              a = x[2] * cs0[2] - x[3] * cs0[3]; x[3] = x[2] * cs0[3] + x[3] * cs0[2]; x[2] = a;
              a = x[4] * cs1[0] - x[5] * cs1[1]; x[5] = x[4] * cs1[1] + x[5] * cs1[0]; x[4] = a;
              a = x[6] * cs1[2] - x[7] * cs1[3]; x[7] = x[6] * cs1[3] + x[7] * cs1[2]; x[6] = a; }
          u32x4 w; w.x = cvt_pk_bf16(x[0] * SC_B, x[1] * SC_B); w.y = cvt_pk_bf16(x[2] * SC_B, x[3] * SC_B); w.z = cvt_pk_bf16(x[4] * SC_B, x[5] * SC_B); w.w = cvt_pk_bf16(x[6] * SC_B, x[7] * SC_B);
          *(u32x4*)(QB + (size_t)m * 512 + 8 * l) = w; }
        { float x1 = bf16lo(gkw), x2 = bf16hi(gkw);
          float ss = x1 * x1 + x2 * x2;
          ss += __shfl_xor(ss, 1); ss += __shfl_xor(ss, 2); ss += __shfl_xor(ss, 4); ss += __shfl_xor(ss, 8); ss += __shfl_xor(ss, 16);
          const float rs = rsqrtf(ss * (1.f / 64.f) + RMS_EPS);
          const int pi = l & 31;
          x1 *= rs * gkn[2 * pi]; x2 *= rs * gkn[2 * pi + 1];
          if (lat) { const f32x2 cs = (pi < 16) ? rope[2560 + gr * 16 + pi] : rope[6656 + gc * 16 + (pi - 16)]; const float a = x1 * cs.x - x2 * cs.y, b = x1 * cs.y + x2 * cs.x; x1 = a; x2 = b; }
          *(unsigned*)(KB + (size_t)m * 128 + 2 * l) = cvt_pk_bf16(x1, x2);
          *(unsigned*)(VB + (size_t)m * 128 + 2 * l) = gvw; }
    }
}

namespace att {
constexpr int B_KN = 0, B_KR = 8192, B_V = 12288, BUF = 20480;
constexpr float THR2 = 8.f * LOG2E;
__device__ __forceinline__ int crow(int r, int hi) { return (r & 3) + 8 * (r >> 2) + 4 * hi; }
__device__ __forceinline__ int swz64(int row, int ch) { return row * 128 + ((ch ^ ((row >> 1) & 7)) << 4); }
__device__ __forceinline__ int swz32(int row, int ch) { return row * 64 + ((ch ^ ((row >> 2) & 3)) << 4); }
__device__ __forceinline__ int v_st(int k, int c) { const int kk = k;     return ((kk >> 3) * 2 + (c >> 5)) * 512 + ((kk & 7) * 32 + (c & 31)) * 2; }
__device__ __forceinline__ int v_rd_base(int lane) { return ((lane & 3) << 3) | (((lane >> 2) & 3) << 6) | (((lane >> 4) & 1) << 5) | (((lane >> 5) & 1) << 8); }
constexpr int v_rd_off(int d0, int ks, int half) { return d0 * 512 + ks * 2048 + half * 1024; }
template <int OFF> __device__ __forceinline__ s16x4 tr_read(unsigned vb) {
    s16x4 r; asm volatile("ds_read_b64_tr_b16 %0, %1 offset:%2" : "=&v"(r) : "v"(vb), "i"(OFF) : "memory"); return r;
}
__device__ __forceinline__ float psm_max(const f32x16& p0, const f32x16& p1) {
    float pmax = p0[0];
#pragma unroll
    for (int r = 1; r < 16; ++r) pmax = fmaxf(pmax, p0[r]);
#pragma unroll
    for (int r = 0; r < 16; ++r) pmax = fmaxf(pmax, p1[r]);
    { auto rr = __builtin_amdgcn_permlane32_swap(__float_as_uint(pmax), __float_as_uint(pmax), false, false);
      pmax = fmaxf(__uint_as_float(rr[0]), __uint_as_float(rr[1])); }
    return pmax;
}
template <bool FIRST> __device__ __forceinline__ void psm_apply(f32x16& p0, f32x16& p1, float pmax, float& m_reg, f32x16& negm, float& alpha) {
    alpha = 1.f;
    if (FIRST || !__builtin_expect(__all(pmax <= THR2), 1)) {
        const float delta = FIRST ? pmax : fmaxf(pmax, 0.f);
        if (!FIRST) alpha = __builtin_amdgcn_exp2f(-delta);
        m_reg += delta;
#pragma unroll
        for (int r = 0; r < 16; ++r) { p0[r] -= delta; p1[r] -= delta; negm[r] = -m_reg; }
    }
#pragma unroll
    for (int r = 0; r < 16; ++r) p0[r] = EXP_PROBE ? fmaf(p0[r], 0.001f, 1.f) : __builtin_amdgcn_exp2f(p0[r]);
}
template <bool FIRST> __device__ __forceinline__ void partialSM(f32x16& p0, f32x16& p1, float& m_reg, f32x16& negm, float& alpha) {
    const float pmax = psm_max(p0, p1); psm_apply<FIRST>(p0, p1, pmax, m_reg, negm, alpha);
}
#define ATT_PK4(P, BASE, OUT) do { unsigned a0 = cvt_pk_bf16(P[BASE + 0], P[BASE + 1]), a1 = cvt_pk_bf16(P[BASE + 2], P[BASE + 3]);   \
    unsigned b0 = cvt_pk_bf16(P[BASE + 4], P[BASE + 5]), b1 = cvt_pk_bf16(P[BASE + 6], P[BASE + 7]);                              \
    auto r0 = __builtin_amdgcn_permlane32_swap(a0, b0, false, false); auto r1 = __builtin_amdgcn_permlane32_swap(a1, b1, false, false); \
    u32x4 w = {r0[0], r1[0], r0[1], r1[1]}; OUT = __builtin_bit_cast(bf16x8, w); } while (0)
#define ATT_PKN(P, BASE, OUT) do { u32x4 w = {cvt_pk_bf16(P[BASE + 0], P[BASE + 1]), cvt_pk_bf16(P[BASE + 2], P[BASE + 3]), cvt_pk_bf16(P[BASE + 4], P[BASE + 5]), cvt_pk_bf16(P[BASE + 6], P[BASE + 7])}; \
    OUT = __builtin_bit_cast(bf16x8, w); } while (0)
__device__ __forceinline__ void finishSM(f32x16& p0, f32x16& p1, float alpha, float& l_reg, bf16x8& pa0, bf16x8& pa1, bf16x8& pa2, bf16x8& pa3) {
#pragma unroll
    for (int r = 0; r < 16; ++r) p1[r] = EXP_PROBE ? fmaf(p1[r], 0.001f, 1.f) : __builtin_amdgcn_exp2f(p1[r]);
    float ps = 0.f;
#pragma unroll
    for (int r = 0; r < 16; ++r) ps += p0[r];
#pragma unroll
    for (int r = 0; r < 16; ++r) ps += p1[r];
    { auto rr = __builtin_amdgcn_permlane32_swap(__float_as_uint(ps), __float_as_uint(ps), false, false);
      ps = __uint_as_float(rr[0]) + __uint_as_float(rr[1]); }
    l_reg = l_reg * alpha + ps;
    ATT_PKN(p0, 0, pa0); ATT_PKN(p0, 8, pa1); ATT_PKN(p1, 0, pa2); ATT_PKN(p1, 8, pa3);
}
template <int DQK> __device__ __forceinline__ void qkt(f32x16& p0, f32x16& p1, const LAS char* buf, const bf16x8* qr, int r32, int hi, const f32x16& negm) {
#pragma unroll
    for (int d0 = 0; d0 < 4; ++d0) { const int ch = d0 * 2 + hi;
        const bf16x8 b0 = *(const LAS bf16x8*)(buf + B_KN + swz64(r32, ch));
        const bf16x8 b1 = *(const LAS bf16x8*)(buf + B_KN + swz64(32 + r32, ch));
        p0 = __builtin_amdgcn_mfma_f32_32x32x16_bf16(b0, qr[d0], d0 == 0 ? negm : p0, 0, 0, 0);
        p1 = __builtin_amdgcn_mfma_f32_32x32x16_bf16(b1, qr[d0], d0 == 0 ? negm : p1, 0, 0, 0); }
    if constexpr (DQK == 96) {
#pragma unroll
        for (int d0 = 0; d0 < 2; ++d0) { const int ch = d0 * 2 + hi;
            const bf16x8 b0 = *(const LAS bf16x8*)(buf + B_KR + swz32(r32, ch));
            const bf16x8 b1 = *(const LAS bf16x8*)(buf + B_KR + swz32(32 + r32, ch));
            p0 = __builtin_amdgcn_mfma_f32_32x32x16_bf16(b0, qr[4 + d0], p0, 0, 0, 0);
            p1 = __builtin_amdgcn_mfma_f32_32x32x16_bf16(b1, qr[4 + d0], p1, 0, 0, 0); }
    }
}
template <int D0> __device__ __forceinline__ void pv_one(f32x16& od, unsigned vb, bf16x8 pa0, bf16x8 pa1, bf16x8 pa2, bf16x8 pa3) {
    const s16x4 l0 = tr_read<v_rd_off(D0, 0, 0)>(vb), h0 = tr_read<v_rd_off(D0, 0, 1)>(vb), l1 = tr_read<v_rd_off(D0, 1, 0)>(vb), h1 = tr_read<v_rd_off(D0, 1, 1)>(vb);
    const s16x4 l2 = tr_read<v_rd_off(D0, 2, 0)>(vb), h2 = tr_read<v_rd_off(D0, 2, 1)>(vb), l3 = tr_read<v_rd_off(D0, 3, 0)>(vb), h3 = tr_read<v_rd_off(D0, 3, 1)>(vb);
    asm volatile("s_waitcnt lgkmcnt(0)" ::: "memory"); SBAR();
#define ATT_PK(L, H) (bf16x8){L[0], L[1], L[2], L[3], H[0], H[1], H[2], H[3]}
    od = __builtin_amdgcn_mfma_f32_32x32x16_bf16(ATT_PK(l0, h0), pa0, od, 0, 0, 0);
    od = __builtin_amdgcn_mfma_f32_32x32x16_bf16(ATT_PK(l1, h1), pa1, od, 0, 0, 0);
    od = __builtin_amdgcn_mfma_f32_32x32x16_bf16(ATT_PK(l2, h2), pa2, od, 0, 0, 0);
    od = __builtin_amdgcn_mfma_f32_32x32x16_bf16(ATT_PK(l3, h3), pa3, od, 0, 0, 0);
#undef ATT_PK
}

#define ATT_PK(L, H) (bf16x8){L[0], L[1], L[2], L[3], H[0], H[1], H[2], H[3]}
template <bool FIXM> __device__ __forceinline__ void pv_psm(f32x16& o0, f32x16& o1, unsigned vb, bf16x8 pa0, bf16x8 pa1, bf16x8 pa2, bf16x8 pa3,
                                       f32x16& p0, f32x16& p1, float& m_reg, f32x16& negm, float& alpha) {
    { const s16x4 l0 = tr_read<v_rd_off(0, 0, 0)>(vb), h0 = tr_read<v_rd_off(0, 0, 1)>(vb), l1 = tr_read<v_rd_off(0, 1, 0)>(vb), h1 = tr_read<v_rd_off(0, 1, 1)>(vb);
      const s16x4 l2 = tr_read<v_rd_off(0, 2, 0)>(vb), h2 = tr_read<v_rd_off(0, 2, 1)>(vb), l3 = tr_read<v_rd_off(0, 3, 0)>(vb), h3 = tr_read<v_rd_off(0, 3, 1)>(vb);
      float pmax = 0.f; SBAR(); if (!FIXM) pmax = psm_max(p0, p1); else { _Pragma("unroll") for (int r = 0; r < 8; ++r) p0[r] = __builtin_amdgcn_exp2f(p0[r]); } SBAR();
      asm volatile("s_waitcnt lgkmcnt(0)" ::: "memory"); SBAR();
      o0 = __builtin_amdgcn_mfma_f32_32x32x16_bf16(ATT_PK(l0, h0), pa0, o0, 0, 0, 0);
      o0 = __builtin_amdgcn_mfma_f32_32x32x16_bf16(ATT_PK(l1, h1), pa1, o0, 0, 0, 0);
      o0 = __builtin_amdgcn_mfma_f32_32x32x16_bf16(ATT_PK(l2, h2), pa2, o0, 0, 0, 0);
      o0 = __builtin_amdgcn_mfma_f32_32x32x16_bf16(ATT_PK(l3, h3), pa3, o0, 0, 0, 0);
      SBAR();
      const s16x4 m0 = tr_read<v_rd_off(1, 0, 0)>(vb), n0 = tr_read<v_rd_off(1, 0, 1)>(vb), m1 = tr_read<v_rd_off(1, 1, 0)>(vb), n1 = tr_read<v_rd_off(1, 1, 1)>(vb);
      const s16x4 m2 = tr_read<v_rd_off(1, 2, 0)>(vb), n2 = tr_read<v_rd_off(1, 2, 1)>(vb), m3 = tr_read<v_rd_off(1, 3, 0)>(vb), n3 = tr_read<v_rd_off(1, 3, 1)>(vb);
      SBAR(); if (!FIXM) psm_apply<false>(p0, p1, pmax, m_reg, negm, alpha); else { alpha = 1.f; _Pragma("unroll") for (int r = 8; r < 16; ++r) p0[r] = __builtin_amdgcn_exp2f(p0[r]); } SBAR();
      asm volatile("s_waitcnt lgkmcnt(0)" ::: "memory"); SBAR();
      o1 = __builtin_amdgcn_mfma_f32_32x32x16_bf16(ATT_PK(m0, n0), pa0, o1, 0, 0, 0);
      o1 = __builtin_amdgcn_mfma_f32_32x32x16_bf16(ATT_PK(m1, n1), pa1, o1, 0, 0, 0);
      o1 = __builtin_amdgcn_mfma_f32_32x32x16_bf16(ATT_PK(m2, n2), pa2, o1, 0, 0, 0);
      o1 = __builtin_amdgcn_mfma_f32_32x32x16_bf16(ATT_PK(m3, n3), pa3, o1, 0, 0, 0); }
}
#undef ATT_PK
template <int DQK, bool FIXM>
__device__ __forceinline__ void attn_unit(const bf16_t* __restrict__ Qp, int ldq, const bf16_t* __restrict__ Knp, int ldk, const bf16_t* __restrict__ Krp,
                                          const bf16_t* __restrict__ Vp, int ldv, bf16_t* __restrict__ Op, int lat0, int nlt, int ctx0, int NT, LAS char* lds, const int tid, const f32x2* rope, int qtok0, float mfix) {
    constexpr int NQ = DQK / 16;
    const int wid = tid >> 6, lane = tid & 63, r32 = lane & 31, hi = lane >> 5;
    float m_reg = 0.f, l_reg = 0.f; f32x16 o0 = {}, o1 = {}, negm = {}; bf16x8 qr[NQ];
    if (FIXM) { _Pragma("unroll") for (int r = 0; r < 16; ++r) negm[r] = -mfix; }
    const bf16_t* Qw = Qp + (size_t)(wid * 32 + r32) * ldq + hi * 8;
#pragma unroll
    for (int d0 = 0; d0 < NQ; ++d0) qr[d0] = *(const bf16x8*)(Qw + d0 * 16);
    if constexpr (DQK == 96) { if (qtok0 >= 0) {
        const int t = qtok0 + wid * 32 + r32, gr = t >> 6, gc = t & 63;
#pragma unroll
        for (int e = 0; e < 2; ++e) { const f32x2* tp = (e == 0) ? rope + gr * 8 + hi * 4 : rope + 2048 + gc * 8 + hi * 4;
            const f32x4 cs0 = *(const f32x4*)tp, cs1 = *(const f32x4*)(tp + 2);
            const u32x4 w = __builtin_bit_cast(u32x4, qr[4 + e]); u32x4 o;
            { const float x1 = bf16lo(w.x), x2 = bf16hi(w.x); o.x = cvt_pk_bf16(x1 * cs0[0] - x2 * cs0[1], x1 * cs0[1] + x2 * cs0[0]); }
            { const float x1 = bf16lo(w.y), x2 = bf16hi(w.y); o.y = cvt_pk_bf16(x1 * cs0[2] - x2 * cs0[3], x1 * cs0[3] + x2 * cs0[2]); }
            { const float x1 = bf16lo(w.z), x2 = bf16hi(w.z); o.z = cvt_pk_bf16(x1 * cs1[0] - x2 * cs1[1], x1 * cs1[1] + x2 * cs1[0]); }
            { const float x1 = bf16lo(w.w), x2 = bf16hi(w.w); o.w = cvt_pk_bf16(x1 * cs1[2] - x2 * cs1[3], x1 * cs1[3] + x2 * cs1[2]); }
            qr[4 + e] = __builtin_bit_cast(bf16x8, o); } } }
    const int sr = tid >> 3, c8 = tid & 7, sr2 = (tid >> 2) & 63, c4 = tid & 3;
    const bool krw = (DQK == 96) && (tid < 256);
    const int kn_st = B_KN + swz64(sr, c8), v_stw = B_V + v_st(sr, c8 * 8), kr_st = B_KR + swz32(sr2, c4);
    const unsigned vb0 = (unsigned)(uintptr_t)lds + B_V + v_rd_base(lane);
    bf16x8 skn[2], sv[2], skr;
#define KROW(j) ((j) < nlt ? lat0 + 64 * (j) : ctx0 + 64 * ((j) - nlt))
#define SLOAD(i, j) do { const int _row = KROW(j); skn[i] = *(const bf16x8*)(Knp + (size_t)(_row + sr) * ldk + c8 * 8); sv[i] = *(const bf16x8*)(Vp + (size_t)(_row + sr) * ldv + c8 * 8); \
        } while (0)
#define KRLOAD(j) do { if (krw) skr = *(const bf16x8*)(Krp + (size_t)(KROW(j) + sr2) * 32 + c4 * 8); } while (0)
#define SWRITE(b, i) do { *(LAS bf16x8*)(lds + (b) * BUF + kn_st) = skn[i]; *(LAS bf16x8*)(lds + (b) * BUF + v_stw) = sv[i]; if (krw) *(LAS bf16x8*)(lds + (b) * BUF + kr_st) = skr; } while (0)
#define SWRITEO(boff, i) do { *(LAS bf16x8*)(lds + (boff) + kn_st) = skn[i]; *(LAS bf16x8*)(lds + (boff) + v_stw) = sv[i]; if (krw) *(LAS bf16x8*)(lds + (boff) + kr_st) = skr; } while (0)
#define PVO(boff) do { pv_one<0>(o0, vb0 + (boff), pa0, pa1, pa2, pa3); pv_one<1>(o1, vb0 + (boff), pa0, pa1, pa2, pa3); } while (0)
#define SWAIT() asm volatile("s_waitcnt vmcnt(2)" ::: "memory")
#define RESC(a) do { if (__any((a) < 1.f)) { _Pragma("unroll") for (int r = 0; r < 16; ++r) { o0[r] *= (a); o1[r] *= (a); } } } while (0)
#define PV(bufi) do { pv_one<0>(o0, vb0 + (bufi) * BUF, pa0, pa1, pa2, pa3); pv_one<1>(o1, vb0 + (bufi) * BUF, pa0, pa1, pa2, pa3); } while (0)
    f32x16 pA0, pA1, pB0, pB1; float alA, alB; bf16x8 pa0, pa1, pa2, pa3;
    int bV = 0, bK = BUF, bW = 2 * BUF;
#define ROT() do { const int _t = bV; bV = bK; bK = bW; bW = _t; } while (0)
    __syncthreads();
    SLOAD(0, 0); KRLOAD(0); asm volatile("s_waitcnt vmcnt(0)" ::: "memory"); SWRITE(0, 0);
    SLOAD(1, 1); KRLOAD(1); if (2 < NT) SLOAD(0, 2);
    __syncthreads();
    qkt<DQK>(pA0, pA1, lds, qr, r32, hi, negm);
    if (FIXM) { alA = 1.f; _Pragma("unroll") for (int r = 0; r < 16; ++r) pA0[r] = __builtin_amdgcn_exp2f(pA0[r]); } else partialSM<true>(pA0, pA1, m_reg, negm, alA);
    SWAIT(); SWRITEO(BUF, 1);
    for (int j = 1; j + 1 < NT; j += 2) {
        if (!NOBAR_PROBE) __syncthreads();
        KRLOAD(j + 1);
        SBAR(); qkt<DQK>(pB0, pB1, lds + bK, qr, r32, hi, negm);
        finishSM(pA0, pA1, alA, l_reg, pa0, pa1, pa2, pa3); SBAR();
        SLOAD(1, j + 2); SBAR();
        if constexpr (FIXM) pv_psm<true>(o0, o1, vb0 + bV, pa0, pa1, pa2, pa3, pB0, pB1, m_reg, negm, alB); else { PVO(bV); partialSM<false>(pB0, pB1, m_reg, negm, alB); }
        SWAIT(); SWRITEO(bW, 0);
        if (!FIXM) RESC(alB); ROT();
        if (!NOBAR_PROBE) __syncthreads();
        if (j + 2 < NT) KRLOAD(j + 2);
        SBAR(); qkt<DQK>(pA0, pA1, lds + bK, qr, r32, hi, negm);
        finishSM(pB0, pB1, alB, l_reg, pa0, pa1, pa2, pa3); SBAR();
        if (j + 3 < NT) SLOAD(0, j + 3); SBAR();
        if constexpr (FIXM) pv_psm<true>(o0, o1, vb0 + bV, pa0, pa1, pa2, pa3, pA0, pA1, m_reg, negm, alA); else { PVO(bV); partialSM<false>(pA0, pA1, m_reg, negm, alA); }
        SWAIT(); SWRITEO(bW, 1);
        if (!FIXM) RESC(alA); ROT();
    }
    __syncthreads();
    SBAR(); qkt<DQK>(pB0, pB1, lds + bK, qr, r32, hi, negm);
    finishSM(pA0, pA1, alA, l_reg, pa0, pa1, pa2, pa3); SBAR();
    if constexpr (FIXM) pv_psm<true>(o0, o1, vb0 + bV, pa0, pa1, pa2, pa3, pB0, pB1, m_reg, negm, alB); else { PVO(bV); partialSM<false>(pB0, pB1, m_reg, negm, alB); }
    if (!FIXM) RESC(alB);
    finishSM(pB0, pB1, alB, l_reg, pa0, pa1, pa2, pa3); SBAR();
    PVO(bK);
#undef ROT
    const float inv = __builtin_amdgcn_rcpf(l_reg);
    bf16_t* Ow = Op + (size_t)(wid * 32 + r32) * 1024 + 4 * hi;
#pragma unroll
    for (int g = 0; g < 4; ++g) {
        u32x2 w0, w1;
        w0.x = cvt_pk_bf16(o0[4 * g] * inv, o0[4 * g + 1] * inv); w0.y = cvt_pk_bf16(o0[4 * g + 2] * inv, o0[4 * g + 3] * inv);
        w1.x = cvt_pk_bf16(o1[4 * g] * inv, o1[4 * g + 1] * inv); w1.y = cvt_pk_bf16(o1[4 * g + 2] * inv, o1[4 * g + 3] * inv);
        *(u32x2*)(Ow + 8 * g) = w0; *(u32x2*)(Ow + 32 + 8 * g) = w1;
    }
#undef KROW
#undef SLOAD
#undef SWRITE
#undef SWAIT
#undef KRLOAD
#undef SWRITEO
#undef PVO
#undef RESC
#undef PV
}
}

__device__ __forceinline__ void attn_phase(Frame& F, int li) {
    const bf16_t* QA = (const bf16_t*)(F.ws + R_QA); const bf16_t* KVA = (const bf16_t*)(F.ws + R_KVA); const bf16_t* KR = (const bf16_t*)(F.ws + R_KR);
    const bf16_t* QB = (const bf16_t*)(F.ws + R_QB); const bf16_t* KB = (const bf16_t*)(F.ws + R_KB); const bf16_t* VB = (const bf16_t*)(F.ws + R_VB);
    bf16_t* O = (bf16_t*)(F.ws + R_O);
    LAS char* lds = (LAS char*)F.lds;
    float mfixB; { float gq = 0.f, gk = 0.f; const float* a = F.in[15] + li * 64; const float* b = F.in[16] + li * 64;
        for (int i = 0; i < 64; ++i) { gq = fmaxf(gq, fabsf(a[i])); gk = fmaxf(gk, fabsf(b[i])); } mfixB = 64.f * gq * gk * SC_B * 1.02f; }
    constexpr int NU = 2048 + 32;
    for (int u = F.vcu; u < NU; u += F.G) {
        if (u < 1024 || (u >= 2048 && u < 2064)) {
            const bool isctx = u >= 2048; const int uu = isctx ? u - 2048 : u;
            const int b = isctx ? (uu >> 3) : (uu >> 9), h = isctx ? (uu & 7) : ((uu >> 6) & 7), qb = uu & 63;
            const int q0 = isctx ? NLAT + b * CTXL : b * SEQ + qb * 256;
            att::attn_unit<96, false>(QA + (size_t)q0 * 768 + h * 96, 768, KVA + h * 128, 1024, KR, KVA + h * 128 + 64, 1024, O + (size_t)q0 * 1024 + h * 64,
                               b * SEQ, isctx ? 0 : 256, NLAT + b * CTXL, isctx ? 4 : 260, lds, F.tid, (const f32x2*)(F.ws + WS_ROPE), isctx ? -1 : qb * 256, 0.f);
        } else {
            const bool isctx = u >= 2064; const int uu = isctx ? u - 2064 : u - 1024;
            const int b = isctx ? (uu >> 3) : (uu >> 9), h = isctx ? (uu & 7) : ((uu >> 6) & 7), qb = uu & 63, kvh = h >> 2;
            const int q0 = isctx ? NLAT + b * CTXL : b * SEQ + qb * 256;
            att::attn_unit<64, true>(QB + (size_t)q0 * 512 + h * 64, 512, KB + kvh * 64, 128, nullptr, VB + kvh * 64, 128, O + (size_t)q0 * 1024 + 512 + h * 64,
                               b * SEQ, isctx ? 0 : 256, NLAT + b * CTXL, isctx ? 4 : 260, lds, F.tid, nullptr, -1, mfixB);
        }
    }
}

namespace na {
constexpr int TABH = 528;
constexpr int L_KC = 0, L_VC = 32768, VC_LD = 528, L_TAB = L_VC + 64 * VC_LD, L_END = L_TAB + TABH * 4;
struct Tile { bf16x8 kf[4]; bf16x8 vf[2][2]; };
__device__ __forceinline__ void load_tile(Tile& T, const bf16_t* kbase, const bf16_t* vbase, size_t vld, int r32, int hi) {
#pragma unroll
    for (int d0 = 0; d0 < 4; ++d0) T.kf[d0] = *(const bf16x8*)(kbase + (size_t)r32 * 2048 + d0 * 16 + hi * 8);
#pragma unroll
    for (int dv = 0; dv < 2; ++dv)
#pragma unroll
        for (int ks = 0; ks < 2; ++ks) T.vf[dv][ks] = *(const bf16x8*)(vbase + (size_t)(32 * dv + r32) * vld + 16 * ks + 8 * hi);
}
__device__ __forceinline__ void load_tile_lds(Tile& T, const LAS char* lds, int t, int r32, int hi) {
#pragma unroll
    for (int d0 = 0; d0 < 4; ++d0) T.kf[d0] = *(const LAS bf16x8*)(lds + L_KC + att::swz64(32 * t + r32, d0 * 2 + hi));
#pragma unroll
    for (int dv = 0; dv < 2; ++dv)
#pragma unroll
        for (int ks = 0; ks < 2; ++ks) T.vf[dv][ks] = *(const LAS bf16x8*)(lds + L_VC + (32 * dv + r32) * VC_LD + (32 * t + 16 * ks + 8 * hi) * 2);
}
constexpr int L_WST = L_END, WST_K = 0, WST_V = 4096, WST_VLD = 80, WST_BYTES = 4096 + 64 * 80;
struct RawTile { bf16x8 k[4], v[4]; };
__device__ __forceinline__ void load_raw(RawTile& T, const bf16_t* kbase, const bf16_t* vbase, int lane) {
#pragma unroll
    for (int i = 0; i < 4; ++i) { T.k[i] = *(const bf16x8*)(kbase + (size_t)(i * 8 + (lane >> 3)) * 2048 + (lane & 7) * 8);
                                  T.v[i] = *(const bf16x8*)(vbase + (size_t)(i * 16 + (lane >> 2)) * SEQ + (lane & 3) * 8); }
}
__device__ __forceinline__ void stage_raw(const RawTile& T, LAS char* w, int lane) {
#pragma unroll
    for (int i = 0; i < 4; ++i) { *(LAS bf16x8*)(w + WST_K + att::swz64(i * 8 + (lane >> 3), lane & 7)) = T.k[i];
                                  *(LAS bf16x8*)(w + WST_V + (i * 16 + (lane >> 2)) * WST_VLD + (lane & 3) * 16) = T.v[i]; }
}
__device__ __forceinline__ void load_tile_wst(Tile& T, const LAS char* w, int r32, int hi) {
#pragma unroll
    for (int d0 = 0; d0 < 4; ++d0) T.kf[d0] = *(const LAS bf16x8*)(w + WST_K + att::swz64(r32, d0 * 2 + hi));
#pragma unroll
    for (int dv = 0; dv < 2; ++dv)
#pragma unroll
        for (int ks = 0; ks < 2; ++ks) T.vf[dv][ks] = *(const LAS bf16x8*)(w + WST_V + (32 * dv + r32) * WST_VLD + (16 * ks + 8 * hi) * 2);
}
template <bool NBR> __device__ __forceinline__ void tile_step(const Tile& cur, const bf16x8 (&qr)[4], float& m_reg, float& l_reg, f32x16& o0, f32x16& o1,
                                                              bool vr, int dlt, const LAS float* tr, int hi) {
    f32x16 p = {};
#pragma unroll
    for (int d0 = 0; d0 < 4; ++d0) p = __builtin_amdgcn_mfma_f32_32x32x16_bf16(cur.kf[d0], qr[d0], p, 0, 0, 0);
    if (NBR) {
#pragma unroll
        for (int r = 0; r < 16; ++r) { const int kcl = (r & 3) + 8 * (r >> 2) + 4 * hi;
            const bool ok = vr && (kcl >= dlt) && (kcl < dlt + 16);
            p[r] = ok ? p[r] + tr[(r & 3) + 8 * (r >> 2)] : -3.0e38f; }
    }
    float pmax = p[0];
#pragma unroll
    for (int r = 1; r < 16; ++r) pmax = fmaxf(pmax, p[r]);
    { auto rr = __builtin_amdgcn_permlane32_swap(__float_as_uint(pmax), __float_as_uint(pmax), false, false);
      pmax = fmaxf(__uint_as_float(rr[0]), __uint_as_float(rr[1])); }
    if (!__all(pmax - m_reg <= att::THR2)) {
        const float mn = fmaxf(m_reg, pmax), alpha = __builtin_amdgcn_exp2f(m_reg - mn); m_reg = mn; l_reg *= alpha;
#pragma unroll
        for (int r = 0; r < 16; ++r) { o0[r] *= alpha; o1[r] *= alpha; }
    }
    float ps = 0.f;
#pragma unroll
    for (int r = 0; r < 16; ++r) { p[r] = __builtin_amdgcn_exp2f(p[r] - m_reg); ps += p[r]; }
    { auto rr = __builtin_amdgcn_permlane32_swap(__float_as_uint(ps), __float_as_uint(ps), false, false);
      ps = __uint_as_float(rr[0]) + __uint_as_float(rr[1]); }
    l_reg += ps;
    bf16x8 pa0, pa1;
    ATT_PK4(p, 0, pa0); ATT_PK4(p, 8, pa1);
    o0 = __builtin_amdgcn_mfma_f32_32x32x16_bf16(cur.vf[0][0], pa0, o0, 0, 0, 0);
    o0 = __builtin_amdgcn_mfma_f32_32x32x16_bf16(cur.vf[0][1], pa1, o0, 0, 0, 0);
    o1 = __builtin_amdgcn_mfma_f32_32x32x16_bf16(cur.vf[1][0], pa0, o1, 0, 0, 0);
    o1 = __builtin_amdgcn_mfma_f32_32x32x16_bf16(cur.vf[1][1], pa1, o1, 0, 0, 0);
}
__device__ __forceinline__ void store_o(bf16_t* Ow, const f32x16& o0, const f32x16& o1, float inv) {
#pragma unroll
    for (int g = 0; g < 4; ++g) {
        u32x2 w0, w1;
        w0.x = cvt_pk_bf16(o0[4 * g] * inv, o0[4 * g + 1] * inv); w0.y = cvt_pk_bf16(o0[4 * g + 2] * inv, o0[4 * g + 3] * inv);
        w1.x = cvt_pk_bf16(o1[4 * g] * inv, o1[4 * g + 1] * inv); w1.y = cvt_pk_bf16(o1[4 * g + 2] * inv, o1[4 * g + 3] * inv);
        *(u32x2*)(Ow + 8 * g) = w0; *(u32x2*)(Ow + 32 + 8 * g) = w1;
    }
}
__device__ __forceinline__ void na_phase(Frame& F, int li, bool need_ctx) {
    const bf16_t* QK = (const bf16_t*)(F.ws + R_QK); const bf16_t* Vt = (const bf16_t*)(F.ws + R_VT); const bf16_t* Vtc = (const bf16_t*)(F.ws + R_VTC);
    bf16_t* ON = (bf16_t*)(F.ws + R_ON);
    LAS char* lds = (LAS char*)F.lds; LAS float* tab = (LAS float*)(lds + L_TAB);
    const int r32 = F.lane & 31, hi = F.lane >> 5;
    for (int bi = F.vcu; bi < 256; bi += F.G) {
        const int bh = bi >> 3, b = bh >> 4, h = bh & 15, sub = bi & 7;
        __syncthreads();
        { const float* rpb = F.in[19] + ((size_t)li * 16 + h) * 465;
          for (int i = F.tid; i < TABH; i += NTHREADS) { const int j = i - 16; tab[i] = (j >= 0 && j < 465) ? rpb[j] * LOG2E : 0.f; }
          const bf16_t* ksrc = QK + (size_t)(NLAT + b * CTXL) * 2048 + 1024 + h * 64; const bf16_t* vsrc = Vtc + (size_t)(b * 16 + h) * 64 * CTXL;
#pragma unroll
          for (int i = 0; i < 4; ++i) { const int c = F.tid + NTHREADS * i;
              *(LAS bf16x8*)(lds + L_KC + att::swz64(c >> 3, c & 7)) = *(const bf16x8*)(ksrc + (size_t)(c >> 3) * 2048 + (c & 7) * 8);
              *(LAS bf16x8*)(lds + L_VC + (c >> 5) * VC_LD + (c & 31) * 16) = *(const bf16x8*)(vsrc + (size_t)(c >> 5) * CTXL + (c & 31) * 8); } }
        __syncthreads();
        for (int pi = F.wave; pi < 64; pi += NWAVES) {
            const int patch = sub * 64 + pi, R = 2 * (patch >> 2), C = 16 * (patch & 3);
            const int qrow = R + (r32 >> 4), qcol = C + (r32 & 15), mq = b * SEQ + qrow * 64 + qcol;
            const int krow_lo = min(max(R - 4, 0), 248), krow_hi = min(max(R - 3, 0), 248) + 7, nn = krow_hi - krow_lo + 1, kc0 = min(max(C - 8, 0), 32);
            const int rsq = min(max(qrow - 4, 0), 248), dlt = min(max(qcol - 8, 0), 48) - kc0;
            const LAS float* tb = tab + 16 + (kc0 - qcol + 15);
            bf16x8 qr[4];
#pragma unroll
            for (int d0 = 0; d0 < 4; ++d0) qr[d0] = *(const bf16x8*)(QK + (size_t)mq * 2048 + h * 64 + d0 * 16 + hi * 8);
            const bf16_t* kn_base = QK + (size_t)(b * SEQ + krow_lo * 64 + kc0) * 2048 + 1024 + h * 64;
            const bf16_t* vn_base = Vt + (size_t)(b * 16 + h) * 64 * SEQ + krow_lo * 64 + kc0;
            float m_reg = -1e30f, l_reg = 0.f; f32x16 o0 = {}, o1 = {};
            Tile cur; RawTile nb;
            LAS char* wst = lds + L_WST + F.wave * WST_BYTES;
            load_raw(nb, kn_base, vn_base, F.lane);
#pragma unroll 2
            for (int t = 0; t < 8; ++t) { load_tile_lds(cur, lds, t, r32, hi); tile_step<false>(cur, qr, m_reg, l_reg, o0, o1, false, 0, tb, hi); }
            for (int t = 0; t < nn; ++t) {
                stage_raw(nb, wst, F.lane);
                if (t + 1 < nn) load_raw(nb, kn_base + (size_t)(t + 1) * 64 * 2048, vn_base + (t + 1) * 64, F.lane);
                load_tile_wst(cur, wst, r32, hi);
                const int kr = krow_lo + t; const bool vr = (kr >= rsq) && (kr < rsq + 8); const int rt = min(max(kr - qrow + 7, 0), 14);
                tile_step<true>(cur, qr, m_reg, l_reg, o0, o1, vr, dlt, tb + rt * 31 + 4 * hi, hi);
            }
            store_o(ON + (size_t)mq * 1024 + h * 64 + 4 * hi, o0, o1, __builtin_amdgcn_rcpf(l_reg));
        }
    }
    if (need_ctx) {
        for (int it = F.gw; it < 2 * 16 * 8; it += F.NGW) {
            const int bh = it >> 3, b = bh >> 4, h = bh & 15, mq = NLAT + b * CTXL + (it & 7) * 32 + r32;
            bf16x8 qr[4];
#pragma unroll
            for (int d0 = 0; d0 < 4; ++d0) qr[d0] = *(const bf16x8*)(QK + (size_t)mq * 2048 + h * 64 + d0 * 16 + hi * 8);
            const bf16_t* kc_base = QK + (size_t)(NLAT + b * CTXL) * 2048 + 1024 + h * 64; const bf16_t* vc_base = Vtc + (size_t)(b * 16 + h) * 64 * CTXL;
            float m_reg = -1e30f, l_reg = 0.f; f32x16 o0 = {}, o1 = {};
            Tile cur, nxt;
            load_tile(cur, kc_base, vc_base, CTXL, r32, hi);
            for (int t = 0; t < 8; ++t) {
                if (t + 1 < 8) load_tile(nxt, kc_base + (size_t)(t + 1) * 32 * 2048, vc_base + (t + 1) * 32, CTXL, r32, hi);
                tile_step<false>(cur, qr, m_reg, l_reg, o0, o1, false, 0, tab, hi);
                cur = nxt;
            }
            store_o(ON + (size_t)mq * 1024 + h * 64 + 4 * hi, o0, o1, __builtin_amdgcn_rcpf(l_reg));
        }
    }
}
}


__device__ __forceinline__ void dbg_mean_abs(Frame& F, const bf16_t* p, int nrows, int ld, int ncols, int slot) {
    float s = 0.f;
    for (int r = F.gw; r < nrows; r += F.NGW)
        for (int c = F.lane * 8; c < ncols; c += 512) { const u32x4 w = *(const u32x4*)(p + (size_t)r * ld + c);
            s += fabsf(bf16lo(w.x)) + fabsf(bf16hi(w.x)) + fabsf(bf16lo(w.y)) + fabsf(bf16hi(w.y)) + fabsf(bf16lo(w.z)) + fabsf(bf16hi(w.z)) + fabsf(bf16lo(w.w)) + fabsf(bf16hi(w.w)); }
    s = wave_sum(s);
    if (F.lane == 0) atomicAdd((float*)(F.ctl + CW_DBG + slot), s / ((float)nrows * (float)ncols));
}

__device__ __forceinline__ void dbg_ri(Frame& F, int slot) {
    const u32x2* RI = (const u32x2*)(F.ws + R_RI); float s = 0.f;
    for (int r = F.gw * 64 + F.lane; r < 65536; r += F.NGW * 64) { const u32x2 ri = RI[r]; if (ri.x != 0xffffffffu) s += 0.5f + u2f(ri.y); }
    s = wave_sum(s);
    if (F.lane == 0) atomicAdd((float*)(F.ctl + CW_DBG + slot), s / 65536.f);
}

__device__ __forceinline__ void dbg_listw(Frame& F, int slot) {
    const u32x2* listw = (const u32x2*)(F.ws + WS_LIST); float s = 0.f;
    for (int e = 0; e < 32; ++e) { const int c = (int)__hip_atomic_load(F.ctl + CW_CNT + e * 64, RLX_AGENT);
        for (int j = F.gw * 64 + F.lane; j < c; j += F.NGW * 64) s += u2f(listw[(size_t)e * MROWS + j].y); }
    s = wave_sum(s);
    if (F.lane == 0) atomicAdd((float*)(F.ctl + CW_DBG + slot), s / 66560.f);
}

#ifndef DBG_CHECK
#define DBG_CHECK 0
#endif
#if DBG_CHECK
__device__ __forceinline__ unsigned hash_u(unsigned x) { x ^= x >> 16; x *= 0x7feb352du; x ^= x >> 15; x *= 0x846ca68bu; x ^= x >> 16; return x; }
__device__ __forceinline__ float bf2f(bf16_t v) { return u2f((unsigned)v << 16); }
__device__ __forceinline__ void dbg_max(Frame& F, int slot, float err) { if (F.lane == 0) atomicMax(F.ctl + CW_DBG + slot, __builtin_bit_cast(unsigned, err)); }
__device__ __forceinline__ void rope_ref(float& x1, float& x2, int i, int n, int gr, int gc) {
    const int ii = i < n ? i : i - n; const float inv = powf(10000.f, -(float)ii / (float)n), ang = (float)(i < n ? gr : gc) * inv;
    float sn, cs; sincosf(ang, &sn, &cs); const float a = x1 * cs - x2 * sn, b = x1 * sn + x2 * cs; x1 = a; x2 = b;
}
__device__ __forceinline__ void check_gemm(Frame& F, int slot, const bf16_t* A, int lda, const float* W, int K, int N, const bf16_t* C, int ldc, float scale, int M, int ns) {
    float worst = 0.f;
    for (int i = F.gw; i < ns; i += F.NGW) { const unsigned hsh = hash_u(i * 2654435761u + slot); const int row = hsh % (unsigned)M, col = (hsh >> 8) % (unsigned)N;
        float a = 0.f; for (int k = F.lane; k < K; k += 64) a += bf2f(A[(size_t)row * lda + k]) * W[(size_t)k * N + col];
        const float ref = wave_sum(a) * scale, got = bf2f(C[(size_t)row * ldc + col]); worst = fmaxf(worst, fabsf(got - ref) / (0.1f + fabsf(ref))); }
    dbg_max(F, slot, worst);
}
__device__ __forceinline__ void check_out0(Frame& F, int slot, int ns) {
    const float* X = (const float*)(F.ws + WS_X); const bf16_t* O = (const bf16_t*)(F.ws + R_O); const float* W = F.in[10]; const float* mod = (const float*)(F.ws + WS_MOD);
    float worst = 0.f;
    for (int i = F.gw; i < ns; i += F.NGW) { const unsigned hsh = hash_u(i * 2654435761u + slot); const int row = hsh % (unsigned)MROWS, col = (hsh >> 8) & 1023;
        float a = 0.f; for (int k = F.lane; k < 1024; k += 64) a += bf2f(O[(size_t)row * 1024 + k]) * W[(size_t)k * 1024 + col];
        const float xin = row < NLAT ? F.in[0][(size_t)row * 1024 + col] : F.in[2][(size_t)(row - NLAT) * 1024 + col];
        const float g1 = mod[(size_t)row_class(row) * 6144 + 2 * 1024 + col];
        const float ref = xin + g1 * wave_sum(a), got = X[(size_t)row * 1024 + col]; worst = fmaxf(worst, fabsf(got - ref) / (0.1f + fabsf(ref))); }
    dbg_max(F, slot, worst);
}
__device__ __forceinline__ void check_prep(Frame& F, int slot, int li, int ns) {
    const bf16_t* P = (const bf16_t*)(F.ws + R_P);
    const bf16_t* CQN = (const bf16_t*)(F.ws + R_CQN); const bf16_t* CKVN = (const bf16_t*)(F.ws + R_CKVN); const bf16_t* KR = (const bf16_t*)(F.ws + R_KR);
    const bf16_t* QB = (const bf16_t*)(F.ws + R_QB); const bf16_t* KB = (const bf16_t*)(F.ws + R_KB); const bf16_t* VB = (const bf16_t*)(F.ws + R_VB);
    const float* qn = F.in[11] + li * QLORA; const float* kvn = F.in[13] + li * KVLORA; const float* gqn = F.in[15] + li * 64; const float* gkn = F.in[16] + li * 64;
    float worst = 0.f;
#define CHK(got, ref) worst = fmaxf(worst, fabsf(bf2f(got) - (ref)) / (0.1f + fabsf(ref)))
    for (int i = F.gw; i < ns; i += F.NGW) { const unsigned hsh = hash_u(i * 2654435761u + slot); const int m = (i & 7) == 7 ? NLAT + hsh % NCTX : hsh % NLAT;
        const bf16_t* p = P + (size_t)m * AB_INP; const bool lat = m < NLAT; const int t = m & (SEQ - 1), gr = t >> 6, gc = t & 63;
        float s = 0.f; for (int c = F.lane; c < 384; c += 64) { const float v = bf2f(p[c]); s += v * v; }
        const float rq = rsqrtf(wave_sum(s) / 384.f + RMS_EPS);
        for (int c = F.lane; c < 384; c += 64) CHK(CQN[(size_t)m * 384 + c], bf2f(p[c]) * rq * qn[c]);
        s = 0.f; for (int c = F.lane; c < 256; c += 64) { const float v = bf2f(p[384 + c]); s += v * v; }
        const float rk = rsqrtf(wave_sum(s) / 256.f + RMS_EPS);
        for (int c = F.lane; c < 256; c += 64) CHK(CKVN[(size_t)m * 256 + c], bf2f(p[384 + c]) * rk * kvn[c]);
        if (F.lane < 16) { float x1 = bf2f(p[640 + 2 * F.lane]), x2 = bf2f(p[641 + 2 * F.lane]); if (lat) rope_ref(x1, x2, F.lane, 8, gr, gc);
            CHK(KR[(size_t)m * 32 + 2 * F.lane], x1); CHK(KR[(size_t)m * 32 + 2 * F.lane + 1], x2); }
        for (int pr = F.lane; pr < 256; pr += 64) { const int h = pr >> 5, i2 = pr & 31; float ss = 0.f;
            for (int d = 0; d < 64; ++d) { const float v = bf2f(p[672 + h * 64 + d]); ss += v * v; }
            const float r = rsqrtf(ss / 64.f + RMS_EPS);
            float x1 = bf2f(p[672 + h * 64 + 2 * i2]) * r * gqn[2 * i2], x2 = bf2f(p[672 + h * 64 + 2 * i2 + 1]) * r * gqn[2 * i2 + 1]; if (lat) rope_ref(x1, x2, i2, 16, gr, gc);
            CHK(QB[(size_t)m * 512 + h * 64 + 2 * i2], x1 * SC_B); CHK(QB[(size_t)m * 512 + h * 64 + 2 * i2 + 1], x2 * SC_B); }
        { const int h = F.lane >> 5, i2 = F.lane & 31; float ss = 0.f;
            for (int d = 0; d < 64; ++d) { const float v = bf2f(p[1184 + h * 64 + d]); ss += v * v; }
            const float r = rsqrtf(ss / 64.f + RMS_EPS);
            float x1 = bf2f(p[1184 + h * 64 + 2 * i2]) * r * gkn[2 * i2], x2 = bf2f(p[1184 + h * 64 + 2 * i2 + 1]) * r * gkn[2 * i2 + 1]; if (lat) rope_ref(x1, x2, i2, 16, gr, gc);
            CHK(KB[(size_t)m * 128 + h * 64 + 2 * i2], x1); CHK(KB[(size_t)m * 128 + h * 64 + 2 * i2 + 1], x2);
            CHK(VB[(size_t)m * 128 + 2 * F.lane], bf2f(p[1312 + 2 * F.lane])); CHK(VB[(size_t)m * 128 + 2 * F.lane + 1], bf2f(p[1313 + 2 * F.lane])); }
    }
#undef CHK
    dbg_max(F, slot, worst);
}
__device__ __forceinline__ void check_attn(Frame& F, int slot, int type, int ns) {
    const bf16_t* QA = (const bf16_t*)(F.ws + R_QA); const bf16_t* KVA = (const bf16_t*)(F.ws + R_KVA); const bf16_t* KR = (const bf16_t*)(F.ws + R_KR);
    const bf16_t* QB = (const bf16_t*)(F.ws + R_QB); const bf16_t* KB = (const bf16_t*)(F.ws + R_KB); const bf16_t* VB = (const bf16_t*)(F.ws + R_VB);
    const bf16_t* O = (const bf16_t*)(F.ws + R_O);
    LAS float* qs = (LAS float*)(F.lds + F.wave * 512);
    float worst = 0.f;
    for (int i = F.gw; i < ns; i += F.NGW) { const unsigned hsh = hash_u(i * 2654435761u + slot); const bool qctx = (i & 7) == 7;
        const int b = hsh & 1, h = (hsh >> 1) & 7, tq = qctx ? (hsh >> 4) % CTXL : (hsh >> 4) % SEQ, mq = qctx ? NLAT + b * CTXL + tq : b * SEQ + tq;
        const int DQ = type == 0 ? 96 : 64;
        for (int d = F.lane; d < DQ; d += 64) qs[d] = type == 0 ? bf2f(QA[(size_t)mq * 768 + h * 96 + d]) : bf2f(QB[(size_t)mq * 512 + h * 64 + d]);
        LDS_WAIT();
        if (type == 0 && !qctx && F.lane < 16) { float x1 = qs[64 + 2 * F.lane], x2 = qs[65 + 2 * F.lane]; rope_ref(x1, x2, F.lane, 8, tq >> 6, tq & 63); qs[64 + 2 * F.lane] = x1; qs[65 + 2 * F.lane] = x2; }
        LDS_WAIT();
        const int nk = qctx ? CTXL : SEQ + CTXL;
        float mx = -3.0e38f, emax = 0.f, rmax = 0.f;
        for (int pass = 0; pass < 5; ++pass) {
            float l = 0.f, o[16];
#pragma unroll
            for (int d = 0; d < 16; ++d) o[d] = 0.f;
            const int dv0 = (pass - 1) * 16;
            for (int j = F.lane; j < nk; j += 64) { const int kr = (qctx || j >= SEQ) ? NLAT + b * CTXL + (qctx ? j : j - SEQ) : b * SEQ + j;
                float sc = 0.f;
                if (type == 0) { const bf16_t* kp = KVA + (size_t)kr * 1024 + h * 128; const bf16_t* rp = KR + (size_t)kr * 32;
                    for (int d = 0; d < 64; ++d) sc += qs[d] * bf2f(kp[d]); for (int d = 0; d < 32; ++d) sc += qs[64 + d] * bf2f(rp[d]); }
                else { const bf16_t* kp = KB + (size_t)kr * 128 + (h >> 2) * 64; for (int d = 0; d < 64; ++d) sc += qs[d] * bf2f(kp[d]); }
                if (pass == 0) mx = fmaxf(mx, sc);
                else { const float pw = exp2f(sc - mx); l += pw; const bf16_t* vp = (type == 0 ? KVA + (size_t)kr * 1024 + h * 128 + 64 : VB + (size_t)kr * 128 + (h >> 2) * 64) + dv0;
#pragma unroll
                    for (int d = 0; d < 16; ++d) o[d] += pw * bf2f(vp[d]); } }
            if (pass == 0) { for (int s2 = 1; s2 < 64; s2 <<= 1) mx = fmaxf(mx, __shfl_xor(mx, s2)); }
            else { l = wave_sum(l);
#pragma unroll
                for (int d = 0; d < 16; ++d) { const float ref = wave_sum(o[d]) / l, got = bf2f(O[(size_t)mq * 1024 + (type == 0 ? 0 : 512) + h * 64 + dv0 + d]); emax = fmaxf(emax, fabsf(got - ref)); rmax = fmaxf(rmax, fabsf(ref)); } }
        }
        worst = fmaxf(worst, emax / (rmax + 1e-9f));
    }
    dbg_max(F, slot, worst);
}
__device__ __forceinline__ void check_na(Frame& F, int slot, int li, bool need_ctx, int ns) {
    const bf16_t* QK = (const bf16_t*)(F.ws + R_QK); const bf16_t* Vt = (const bf16_t*)(F.ws + R_VT); const bf16_t* Vtc = (const bf16_t*)(F.ws + R_VTC); const bf16_t* ON = (const bf16_t*)(F.ws + R_ON);
    const float* rpb = F.in[19] + (size_t)li * 16 * 465;
    LAS float* qs = (LAS float*)(F.lds + F.wave * 512);
    float worst = 0.f;
    for (int i = F.gw; i < ns; i += F.NGW) { const unsigned hsh = hash_u(i * 2654435761u + slot); const bool qctx = need_ctx && (i & 7) == 7;
        const int b = hsh & 1, h = (hsh >> 1) & 15; int tq = qctx ? (hsh >> 5) % CTXL : (hsh >> 5) % SEQ;
        if (!qctx && (i & 7) == 1) tq = ((hsh >> 5) & 7) * 64 + ((hsh >> 9) & 63) + ((hsh >> 20) & 1) * (SEQ - 512);
        const int mq = qctx ? NLAT + b * CTXL + tq : b * SEQ + tq, r = tq >> 6, c = tq & 63;
        if (F.lane < 64) qs[F.lane] = bf2f(QK[(size_t)mq * 2048 + h * 64 + F.lane]);
        LDS_WAIT();
        const int rs = min(max(r - 4, 0), GRIDH - 8), cs = min(max(c - 8, 0), GRIDW - 16);
        const int nk = qctx ? CTXL : 128 + CTXL;
        float mx = -3.0e38f;
        for (int pass = 0; pass < 2; ++pass) {
            float l = 0.f, o[64];
#pragma unroll
            for (int d = 0; d < 64; ++d) o[d] = 0.f;
            for (int j = F.lane; j < nk; j += 64) { const bool nb = !qctx && j < 128;
                const int kr_ = rs + (j >> 4), kc_ = cs + (j & 15);
                const int krow = nb ? b * SEQ + kr_ * 64 + kc_ : NLAT + b * CTXL + (qctx ? j : j - 128);
                const bf16_t* kp = QK + (size_t)krow * 2048 + 1024 + h * 64; float sc = 0.f;
                for (int d = 0; d < 64; ++d) sc += qs[d] * bf2f(kp[d]);
                if (nb) sc += rpb[h * 465 + (kr_ - r + 7) * 31 + (kc_ - c + 15)] * LOG2E;
                if (pass == 0) mx = fmaxf(mx, sc);
                else { const float pw = exp2f(sc - mx); l += pw;
#pragma unroll
                    for (int d = 0; d < 64; ++d) o[d] += pw * (nb ? bf2f(Vt[((size_t)(b * 16 + h) * 64 + d) * SEQ + kr_ * 64 + kc_]) : bf2f(Vtc[((size_t)(b * 16 + h) * 64 + d) * CTXL + (qctx ? j : j - 128)])); } }
            if (pass == 0) { for (int s2 = 1; s2 < 64; s2 <<= 1) mx = fmaxf(mx, __shfl_xor(mx, s2)); }
            else { l = wave_sum(l); float emax = 0.f, rmax = 0.f;
#pragma unroll
                for (int d = 0; d < 64; ++d) { const float ref = wave_sum(o[d]) / l, got = bf2f(ON[(size_t)mq * 1024 + h * 64 + d]); emax = fmaxf(emax, fabsf(got - ref)); rmax = fmaxf(rmax, fabsf(ref)); }
                worst = fmaxf(worst, emax / (rmax + 1e-9f)); } }
    }
    dbg_max(F, slot, worst);
}
#endif

constexpr int PH_PER_LAYER = 12, NPH = 2 + DEPTH * PH_PER_LAYER;
__global__ void __launch_bounds__(NTHREADS, 2) fwd(Args args) {
    extern __shared__ __attribute__((aligned(16))) unsigned char lds_raw[];
    Frame F;
    F.lds = (LAS unsigned char*)lds_raw; F.ws = args.ws; F.ctl = (unsigned*)(args.ws + WS_CTL); F.in = args.in;
    F.tid = threadIdx.x; F.lane = F.tid & 63; F.wave = __builtin_amdgcn_readfirstlane(F.tid >> 6);
    F.G = gridDim.x; { const int bx = blockIdx.x; F.vcu = (F.G % 8 == 0) ? (bx % 8) * (F.G / 8) + bx / 8 : bx; }
    F.gw = F.vcu * NWAVES + F.wave; F.NGW = F.G * NWAVES;
    volatile LAS unsigned* MISC = (volatile LAS unsigned*)(F.lds + MISC_OFF);
    if (F.tid < 16) MISC[F.tid] = 0u;
    __syncthreads();
    const int lo = args.ph_lo, hi = args.ph_hi;
    XcdBarrier bar; bar.bar = F.ctl + CW_BAR; bar.x = 0; bar.st = MISC;
    if (hi - lo > 1) bar = xcd_barrier_post(F.ctl + CW_BAR, MISC);
#define OPAQUE_V(x) asm volatile("" : "+v"(x))
#define OPAQUE_S(x) asm volatile("" : "+s"(x))
#define PHASE_BEGIN() do { GAS unsigned char* _ws = (GAS unsigned char*)args.ws; OPAQUE_S(_ws); F.ws = (unsigned char*)_ws; F.ctl = (unsigned*)(F.ws + WS_CTL); int _t = threadIdx.x; OPAQUE_V(_t); F.tid = _t; F.lane = _t & 63; \
    F.wave = __builtin_amdgcn_readfirstlane(_t >> 6); int _bx = blockIdx.x; OPAQUE_S(_bx); bx = _bx; F.vcu = (F.G % 8 == 0) ? (_bx % 8) * (F.G / 8) + _bx / 8 : _bx; F.gw = F.vcu * NWAVES + F.wave; \
    mod = (const float*)(F.ws + WS_MOD); } while (0)
#define RUN(k) ((k) >= lo && (k) < hi)
#define SEAM(k) do { if ((k) + 1 < hi) xcd_barrier(bar); } while (0)
    LAS unsigned char* ring = F.lds;
    const float* mod; int bx;

    if (RUN(0)) { PHASE_BEGIN(); if (EN_P0) for (int rep_ = 0; rep_ < REP_P0; ++rep_) { p0_prologue(F); __syncthreads(); } SEAM(0); }


#if DBG_CHECK == 2
#define CHECK_E2(l, li)
#define CHECK_PREP(l, li)
#define CHECK_UP(l, li)
#define CHECK_ATT(l, li) { check_attn(F, 32 + (l), 0, 2048); check_attn(F, 36 + (l), 1, 2048); __syncthreads(); }
#define CHECK_OUT(l, li)
#define CHECK_NA(l, li, nc)
#elif DBG_CHECK
#define CHECK_E2(l, li) { check_gemm(F, 16 + (l), (const bf16_t*)(F.ws + WS_H), 1024, F.in[9] + (size_t)(li) * 1024 * 1440, 1024, 1440, (const bf16_t*)(F.ws + R_P), AB_INP, 1.f, MROWS, 4096); }
#define CHECK_PREP(l, li) { check_prep(F, 20 + (l), li, 2048); }
#define CHECK_UP(l, li) { check_gemm(F, 24 + (l), (const bf16_t*)(F.ws + R_CQN), 384, F.in[12] + (size_t)(li) * 384 * 768, 384, 768, (const bf16_t*)(F.ws + R_QA), 768, SC_A, MROWS, 4096); \
                          check_gemm(F, 28 + (l), (const bf16_t*)(F.ws + R_CKVN), 256, F.in[14] + (size_t)(li) * 256 * 1024, 256, 1024, (const bf16_t*)(F.ws + R_KVA), 1024, 1.f, MROWS, 4096); }
#define CHECK_ATT(l, li) { check_attn(F, 32 + (l), 0, 2048); check_attn(F, 36 + (l), 1, 2048); __syncthreads(); }
#define CHECK_OUT(l, li) { if ((l) == 0) check_out0(F, 40, 4096); }
#define CHECK_NA(l, li, nc) { check_na(F, 44 + (l), li, nc, 4096); __syncthreads(); }
#else
#define CHECK_E2(l, li)
#define CHECK_PREP(l, li)
#define CHECK_UP(l, li)
#define CHECK_ATT(l, li)
#define CHECK_OUT(l, li)
#define CHECK_NA(l, li, nc)
#endif
#define LAYER_BODY(LL) { constexpr int l = (LL); \
        const int pb = 1 + l * PH_PER_LAYER, li = l >> 1; \
        if (RUN(pb)) { PHASE_BEGIN(); if (EN_NORM) mix_norm_phase(F, l); SEAM(pb); } \
        if ((l & 1) == 0) { \
            if (RUN(pb + 1)) { PHASE_BEGIN(); \
                pg8::Gemm g{(const bf16_t*)(F.ws + WS_H), (const bf16_t*)(F.ws + WS_WIN) + (size_t)li * AB_INP * 1024, 1024, 1024}; \
                pg8::StaticOrder S; S.init(MROWS / 256, AB_INP / 256, F.G, bx); \
                EpiStore E{(bf16_t*)(F.ws + R_P), AB_INP}; \
                if (EN_GEMM & 1) { pg8::gemm_phase<EpiStore, pg8::StaticOrder, true>(ring, g, S, E, F.tid); if (REP_IN >= 2) pg8::gemm_phase<EpiStore, pg8::StaticOrder, true>(ring, g, S, E, F.tid); if (REP_IN >= 3) pg8::gemm_phase<EpiStore, pg8::StaticOrder, true>(ring, g, S, E, F.tid); } \
                SEAM(pb + 1); CHECK_E2(l, li) \
            } \
            if (RUN(pb + 2)) { PHASE_BEGIN(); if (EN_PREP) for (int rep_ = 0; rep_ < REP_PREP; ++rep_) ab_prep_phase(F, li); SEAM(pb + 2); CHECK_PREP(l, li) } \
            if (RUN(pb + 3)) { PHASE_BEGIN(); \
                { pg8::Gemm g{(const bf16_t*)(F.ws + R_CQN), (const bf16_t*)(F.ws + WS_WQUP) + (size_t)li * 768 * 384, QLORA, QLORA}; \
                  pg8::StaticOrder S; S.init(MROWS / 256, 3, F.G, bx); \
                  EpiStore E{(bf16_t*)(F.ws + R_QA), 768}; \
                  if (EN_GEMM & 2) { pg8::gemm_phase<EpiStore, pg8::StaticOrder, true>(ring, g, S, E, F.tid); if (REP_UP >= 2) pg8::gemm_phase<EpiStore, pg8::StaticOrder, true>(ring, g, S, E, F.tid); } } \
                { pg8::Gemm g{(const bf16_t*)(F.ws + R_CKVN), (const bf16_t*)(F.ws + WS_WKVUP) + (size_t)li * 1024 * 256, KVLORA, KVLORA}; \
                  pg8::StaticOrder S; S.init(MROWS / 256, 4, F.G, (bx + 134) % F.G); \
                  EpiStore E{(bf16_t*)(F.ws + R_KVA), 1024}; \
                  if (EN_GEMM & 4) { pg8::gemm_phase<EpiStore, pg8::StaticOrder, true>(ring, g, S, E, F.tid); if (REP_UP >= 2) pg8::gemm_phase<EpiStore, pg8::StaticOrder, true>(ring, g, S, E, F.tid); } } \
                SEAM(pb + 3); CHECK_UP(l, li) \
            } \
            if (RUN(pb + 4)) { PHASE_BEGIN(); if (EN_ATT) for (int rep_ = 0; rep_ < REP_ATT; ++rep_) { attn_phase(F, li); if (rep_ + 1 < REP_ATT) __syncthreads(); } SEAM(pb + 4); CHECK_ATT(l, li) } \
            if (RUN(pb + 5)) { PHASE_BEGIN(); \
                pg8::Gemm g{(const bf16_t*)(F.ws + R_O), (const bf16_t*)(F.ws + WS_WOUT) + (size_t)li * 1024 * 1024, 1024, 1024}; \
                pg8::StaticOrder S; S.init(MROWS / 256, 4, F.G, bx); \
                EpiOut E{(float*)(F.ws + WS_X), mod + (size_t)l * 3 * 6144}; \
                if (EN_GEMM & 8) pg8::gemm_phase<EpiOut, pg8::StaticOrder, true>(ring, g, S, E, F.tid); \
                SEAM(pb + 5); CHECK_OUT(l, li) \
            } \
        } else { \
            const bool last = (l == DEPTH - 1); \
            if (RUN(pb + 1)) { PHASE_BEGIN(); \
                pg8::Gemm g{(const bf16_t*)(F.ws + WS_H), (const bf16_t*)(F.ws + WS_NIN) + (size_t)li * 3072 * 1024, 1024, 1024}; \
                pg8::StaticOrder S; S.init(MROWS / 256, 12, F.G, bx); \
                EpiNaIn E{(bf16_t*)(F.ws + R_QK), (bf16_t*)(F.ws + R_VT), (bf16_t*)(F.ws + R_VTC)}; \
                if (EN_GEMM & 16) { pg8::gemm_phase<EpiNaIn, pg8::StaticOrder, true>(ring, g, S, E, F.tid); if (REP_IN >= 2) pg8::gemm_phase<EpiNaIn, pg8::StaticOrder, true>(ring, g, S, E, F.tid); if (REP_IN >= 3) pg8::gemm_phase<EpiNaIn, pg8::StaticOrder, true>(ring, g, S, E, F.tid); } \
                SEAM(pb + 1); \
            } \
            if (RUN(pb + 4)) { PHASE_BEGIN(); if (EN_NA) for (int rep_ = 0; rep_ < REP_NA; ++rep_) { na::na_phase(F, li, !last); if (rep_ + 1 < REP_NA) __syncthreads(); } SEAM(pb + 4); CHECK_NA(l, li, !last) } \
            if (RUN(pb + 5)) { PHASE_BEGIN(); \
                pg8::Gemm g{(const bf16_t*)(F.ws + R_ON), (const bf16_t*)(F.ws + WS_NOUT) + (size_t)li * 1024 * 1024, 1024, 1024}; \
                pg8::StaticOrder S; S.init((last ? NLAT : MROWS) / 256, 4, F.G, bx); \
                EpiOut E{(float*)(F.ws + WS_X), mod + (size_t)l * 3 * 6144}; \
                if (EN_GEMM & 32) pg8::gemm_phase<EpiOut, pg8::StaticOrder, true>(ring, g, S, E, F.tid); \
                SEAM(pb + 5); \
            } \
        } \
        if (RUN(pb + 6)) { PHASE_BEGIN(); if (EN_ROUTE) ffn_norm_route_phase(F, l); SEAM(pb + 6); } \
                if (RUN(pb + 8)) { PHASE_BEGIN(); \
            moe_tile_map(F, l); \
            if (DBG_SEL == 0 && l == 0 && blockIdx.x == 0 && F.tid == 0) F.ctl[CW_DBG + 0] = __builtin_bit_cast(unsigned, 0.001f * (float)*(const LAS int*)(F.lds + MOE_NT_OFF)); \
            pg8::Gemm g{(const bf16_t*)(F.ws + WS_H), (const bf16_t*)(F.ws + WS_MOEW + (size_t)l * MOEW_LAYER), 1024, 1024}; \
            pg8::MoeGatherOrder S; S.tile_e = (const LAS int*)(F.lds + TILE_E_OFF); S.nT = *(const LAS int*)(F.lds + MOE_NT_OFF); S.G = F.G; S.c = bx; S.estride = (size_t)1024 * 1024; \
            S.lcnt = (const LAS int*)(F.lds + CNTL_OFF); S.lbase = S.lcnt + 32; S.list = (const u32x2*)(F.ws + WS_LIST); \
            EpiMoe1 E{(bf16_t*)(F.ws + R_ACT)}; \
            if (EN_GEMM & 64) { pg8::gemm_phase<EpiMoe1, pg8::MoeGatherOrder, true>(ring, g, S, E, F.tid); if (REP_MOE >= 2) pg8::gemm_phase<EpiMoe1, pg8::MoeGatherOrder, true>(ring, g, S, E, F.tid); if (REP_MOE >= 3) pg8::gemm_phase<EpiMoe1, pg8::MoeGatherOrder, true>(ring, g, S, E, F.tid); } \
            SEAM(pb + 8); if (DBG_SEL == 2 && l == 0) dbg_mean_abs(F, (const bf16_t*)(F.ws + R_ACT), 65536, 512, 512, 2); \
        } \
        if (RUN(pb + 9)) { PHASE_BEGIN(); \
            moe_tile_map(F, l); \
            pg8::Gemm g{(const bf16_t*)(F.ws + R_ACT), (const bf16_t*)(F.ws + WS_MOEW + (size_t)l * MOEW_LAYER + MOEW_DN), 512, 512}; \
            pg8::MoeOrder S{(const LAS int*)(F.lds + TILE_E_OFF), *(const LAS int*)(F.lds + MOE_NT_OFF), F.G, bx, (size_t)1024 * 512}; \
            EpiMoe2 E{(bf16_t*)(F.ws + R_Y), (const LAS int*)(F.lds + TILE_E_OFF), (const LAS int*)(F.lds + CNTL_OFF), (const LAS int*)(F.lds + CNTL_OFF) + 32, (const u32x2*)(F.ws + WS_LIST)}; if (DBG_SEL == 4 && l == 0) dbg_ri(F, 4); if (DBG_SEL == 6 && l == 0) dbg_listw(F, 6); if (DBG_SEL == 5 && l == 0) dbg_mean_abs(F, (const bf16_t*)(F.ws + WS_MOEW + MOEW_DN), 32768, 512, 512, 5); \
            if (EN_GEMM & 128) { pg8::gemm_phase<EpiMoe2, pg8::MoeOrder, true>(ring, g, S, E, F.tid); if (REP_MOE >= 2) pg8::gemm_phase<EpiMoe2, pg8::MoeOrder, true>(ring, g, S, E, F.tid); if (REP_MOE >= 3) pg8::gemm_phase<EpiMoe2, pg8::MoeOrder, true>(ring, g, S, E, F.tid); } \
            SEAM(pb + 9); if (DBG_SEL == 1 && l == 0) dbg_mean_abs(F, (const bf16_t*)(F.ws + R_Y), 65536, 1024, 1024, 1); \
        } \
    }
    LAYER_BODY(0)
    LAYER_BODY(1)
    LAYER_BODY(2)
    LAYER_BODY(3)
#undef LAYER_BODY
    if (RUN(NPH - 1)) { PHASE_BEGIN(); if (EN_FINAL) final_phase(F, args.out); }
#undef RUN
#undef SEAM
}

extern "C" void kernel_launch(void* const* d_in, const int* in_sizes, int n_in, void* d_out, int out_size, void* d_ws, size_t ws_size, hipStream_t stream) {
    static int grid = 0;
    if (grid == 0) {
        if (n_in != 27 || out_size != NLAT * DM || ws_size < WS_END) { fprintf(stderr, "kernel_launch: unexpected shapes: n_in %d out %d ws %zu (need %zu)\n", n_in, out_size, ws_size, (size_t)WS_END); grid = -1; return; }
        int dev = 0, cus = 0, per_cu = 0;
        if (hipGetDevice(&dev) != hipSuccess || hipDeviceGetAttribute(&cus, hipDeviceAttributeMultiprocessorCount, dev) != hipSuccess) { grid = -1; return; }
        if (hipFuncSetAttribute((const void*)fwd, hipFuncAttributeMaxDynamicSharedMemorySize, LDS_BYTES) != hipSuccess) { fprintf(stderr, "kernel_launch: hipFuncSetAttribute failed\n"); grid = -1; return; }
        if (hipOccupancyMaxActiveBlocksPerMultiprocessor(&per_cu, (const void*)fwd, NTHREADS, LDS_BYTES) != hipSuccess || per_cu < 1)
            fprintf(stderr, "kernel_launch: occupancy query reports %d workgroups per CU\n", per_cu);
        (void)hipGetLastError();
        grid = cus;
    }
    if (grid < 0) return;
    if (hipMemsetAsync((char*)d_ws + WS_CTL, 0, CTL_ZERO_BYTES, stream) != hipSuccess) return;
    Args a{};
    for (int i = 0; i < 27; ++i) a.in[i] = (const float*)d_in[i];
    a.out = (float*)d_out; a.ws = (unsigned char*)d_ws;
#if MK_PER_PHASE
    for (int p = 0; p < NPH; ++p) { a.ph_lo = p; a.ph_hi = p + 1; hipLaunchKernelGGL(fwd, dim3(grid), dim3(NTHREADS), LDS_BYTES, stream, a); }
#else
    a.ph_lo = 0; a.ph_hi = NPH;
    hipLaunchKernelGGL(fwd, dim3(grid), dim3(NTHREADS), LDS_BYTES, stream, a);
#endif
    const hipError_t le = hipPeekAtLastError();
    if (le != hipSuccess) fprintf(stderr, "kernel_launch: launch failed: %s\n", hipGetErrorName(le));
}
```

```cpp
#include <hip/hip_runtime.h>
#include <cstdio>
#include <cstdint>

#ifndef MK_PER_PHASE
#define MK_PER_PHASE 0
#endif


#ifndef EN_P0
#define EN_P0 1
#endif
#ifndef EN_NORM
#define EN_NORM 1
#endif
#ifndef EN_PREP
#define EN_PREP 1
#endif
#ifndef EN_ATT
#define EN_ATT 1
#endif
#ifndef EN_NA
#define EN_NA 1
#endif
#ifndef EN_ROUTE
#define EN_ROUTE 1
#endif
#ifndef EN_GATHER
#define EN_GATHER 1
#endif
#ifndef EN_FINAL
#define EN_FINAL 1
#endif
#ifndef EN_GEMM
#define EN_GEMM 255
#endif
#ifndef REP_PREP
#define REP_PREP 1
#endif
#ifndef REP_GATHER
#define REP_GATHER 1
#endif
#ifndef REP_UP
#define REP_UP 1
#endif
#ifndef REP_ATT
#define REP_ATT 1
#endif
#ifndef REP_NA
#define REP_NA 1
#endif
#ifndef REP_P0
#define REP_P0 1
#endif
#ifndef REP_MOE
#define REP_MOE 1
#endif
#ifndef REP_IN
#define REP_IN 1
#endif
#ifndef NOBAR_PROBE
#define NOBAR_PROBE 0
#endif
#ifndef EXP_PROBE
#define EXP_PROBE 0
#endif
#ifndef DBG_SEL
#define DBG_SEL -1
#endif
#ifndef W_CONST
#define W_CONST 0.f
#endif
#ifndef MOE_ALPHA
#define MOE_ALPHA 1.f
#endif
#define GAS __attribute__((address_space(1)))
#define LAS __attribute__((address_space(3)))
typedef unsigned short bf16_t;
typedef short bf16x8 __attribute__((ext_vector_type(8)));
typedef short s16x4 __attribute__((ext_vector_type(4)));
typedef float f32x4 __attribute__((ext_vector_type(4)));
typedef float f32x2 __attribute__((ext_vector_type(2)));
typedef float f32x16 __attribute__((ext_vector_type(16)));
typedef unsigned u32x4 __attribute__((ext_vector_type(4)));
typedef unsigned u32x2 __attribute__((ext_vector_type(2)));

constexpr int DM = 1024, SEQ = 16384, NLAT = 32768, CTXL = 256, NCTX = 512, MROWS = NLAT + NCTX;
constexpr int DEPTH = 4, GRIDW = 64, GRIDH = 256;
constexpr int AB_IN = 1440, AB_INP = 1536, QLORA = 384, KVLORA = 256;
constexpr int NEXP = 32, DEXP = 512;
constexpr float LOG2E = 1.4426950408889634f;
constexpr float SC_A = 0.10206207261596577f * LOG2E;
constexpr float SC_B = 0.125f * LOG2E;
constexpr float RMS_EPS = 1e-6f;
constexpr int NWAVES = 8, NTHREADS = 512;

constexpr size_t MiB = 1u << 20;
constexpr size_t WS_CTL = 0, CTL_ZERO_BYTES = 1 * MiB;
constexpr size_t WS_MOD = 1 * MiB;
constexpr size_t WS_ROPE = WS_MOD + 512 * 1024;
constexpr size_t WS_WIN = 2 * MiB;
constexpr size_t WS_WQUP = 8 * MiB;
constexpr size_t WS_WKVUP = 10 * MiB;
constexpr size_t WS_WOUT = 11 * MiB;
constexpr size_t WS_NIN = 15 * MiB;
constexpr size_t WS_NOUT = 27 * MiB;
constexpr size_t WS_LIST = 31 * MiB;
constexpr size_t WS_X = 41 * MiB;
constexpr size_t WS_H = 171 * MiB;
constexpr size_t WS_R = 236 * MiB;
constexpr size_t R_P = WS_R;
constexpr size_t R_CQN = R_P + 98 * MiB;
constexpr size_t R_CKVN = R_CQN + 25 * MiB;
constexpr size_t R_QA = R_CKVN + 17 * MiB;
constexpr size_t R_KVA = R_QA + 49 * MiB;
constexpr size_t R_KR = R_KVA + 65 * MiB;
constexpr size_t R_QB = R_KR + 3 * MiB;
constexpr size_t R_KB = R_QB + 33 * MiB;
constexpr size_t R_VB = R_KB + 9 * MiB;
constexpr size_t R_O = R_P;
constexpr size_t R_EVEN_END = R_VB + 9 * MiB;
constexpr size_t R_QK = WS_R;
constexpr size_t R_VT = R_QK + 130 * MiB;
constexpr size_t R_VTC = R_VT + 64 * MiB;
constexpr size_t R_ON = R_VTC + 1 * MiB;
constexpr size_t R_ODD_END = R_ON + 65 * MiB;
constexpr int MOE_MAXT = 292;
constexpr size_t R_XB = WS_R;
constexpr size_t R_ACT = R_XB + 146 * MiB;
constexpr size_t R_RI = R_ACT + 73 * MiB;
constexpr size_t R_Y = R_RI + 1 * MiB;
constexpr size_t R_MOE_END = R_Y + 130 * MiB;
constexpr size_t WS_MOEW = 606 * MiB;
constexpr size_t MOEW_LAYER = 96 * MiB, MOEW_DN = 64 * MiB;
constexpr size_t WS_END = WS_MOEW + 4 * MOEW_LAYER;
static_assert(R_EVEN_END <= WS_MOEW && R_ODD_END <= WS_MOEW && R_MOE_END <= WS_MOEW, "overlay region");
static_assert(WS_END <= 1024 * MiB, "workspace");

constexpr int CW_BAR = 4096;
constexpr int CW_DBG = 8192;
constexpr int CW_CNT = 16384;
static_assert((CW_CNT + 4 * 32 * 64) * 4 <= (int)CTL_ZERO_BYTES, "ctl");

constexpr int RING_BYTES = 131072;
constexpr int TAB_LD = 1028;
constexpr int LDS_TAB = 36 * TAB_LD * 4;
constexpr int MISC_OFF = LDS_TAB;
constexpr int TILE_E_OFF = MISC_OFF + 64;
constexpr int MOE_NT_OFF = TILE_E_OFF + 1280;
constexpr int CNTL_OFF = MOE_NT_OFF + 16;
constexpr int REC_OFF = CNTL_OFF + 256;
constexpr int LDS_BYTES = REC_OFF + 3328;
static_assert(LDS_BYTES <= 163840, "LDS");

#define RLX_AGENT __ATOMIC_RELAXED, __HIP_MEMORY_SCOPE_AGENT
#define LDS_WAIT() asm volatile("s_waitcnt lgkmcnt(0)" ::: "memory")
#define VM_WAIT() asm volatile("s_waitcnt vmcnt(0)" ::: "memory")
#define SBAR() __builtin_amdgcn_sched_barrier(0)

__device__ __forceinline__ unsigned cvt_pk_bf16(float lo, float hi) { unsigned r; asm volatile("v_cvt_pk_bf16_f32 %0, %1, %2" : "=v"(r) : "v"(lo), "v"(hi)); return r; }
__device__ __forceinline__ float u2f(unsigned u) { return __builtin_bit_cast(float, u); }
__device__ __forceinline__ float bf16lo(unsigned w) { return __builtin_bit_cast(float, w << 16); }
__device__ __forceinline__ float bf16hi(unsigned w) { return __builtin_bit_cast(float, w & 0xffff0000u); }
__device__ __forceinline__ float wave_sum(float v) {
    v += __builtin_bit_cast(float, __builtin_amdgcn_update_dpp(0, __builtin_bit_cast(int, v), 0xB1, 0xF, 0xF, true));
    v += __builtin_bit_cast(float, __builtin_amdgcn_update_dpp(0, __builtin_bit_cast(int, v), 0x4E, 0xF, 0xF, true));
    v += __builtin_bit_cast(float, __builtin_amdgcn_update_dpp(0, __builtin_bit_cast(int, v), 0x141, 0xF, 0xF, true));
    v += __builtin_bit_cast(float, __builtin_amdgcn_update_dpp(0, __builtin_bit_cast(int, v), 0x140, 0xF, 0xF, true));
    { auto rr = __builtin_amdgcn_permlane16_swap(__float_as_uint(v), __float_as_uint(v), false, false); v = __uint_as_float(rr[0]) + __uint_as_float(rr[1]); }
    { auto rr = __builtin_amdgcn_permlane32_swap(__float_as_uint(v), __float_as_uint(v), false, false); v = __uint_as_float(rr[0]) + __uint_as_float(rr[1]); }
    return v;
}
__device__ __forceinline__ int row_class(int m) { return m < SEQ ? 0 : (m < NLAT ? 1 : 2); }

namespace pg8 {
constexpr int BM = 256, BK = 64, HALF = 128, HTB = HALF * BK * 2, STAGE_BYTES = 8 * HTB, NXCD = 8, WGM = 8;
__host__ __device__ __forceinline__ int lds_byte(int r, int c) { const int st = (r >> 4) * 2 + (c >> 5), rr = r & 15, cc = c & 31, ob = rr * 64 + cc * 2; return st * 1024 + (ob ^ (((ob >> 9) & 1) << 5)); }
__host__ __device__ __forceinline__ void stage_rc(int b, int& R, int& C) { const int st = b / 1024, sb = b % 1024, swz = sb ^ (((sb >> 9) & 1) << 5); R = (st >> 1) * 16 + swz / 64; C = (st & 1) * 32 + (swz % 64) / 2; }
__host__ __device__ __forceinline__ int perm32(int rho) { const int n = rho >> 4, i = rho & 15; return 8 * (i >> 2) + 4 * n + (i & 3); }

struct Unit { int pm, pn; };
struct Gemm { const bf16_t* A; const bf16_t* Bt; int lda, K; };

struct StaticOrder {
    static constexpr bool GATHER = false;
    int nM, nN, nwg, G, c;
    __device__ void init(int nM_, int nN_, int G_, int c_) { nM = nM_; nN = nN_; nwg = nM * nN; G = G_; c = c_; }
    __device__ bool next(int i, Unit& u) const {
        const long L = (long)i * G + c; if (L >= nwg) return false;
        int wgid = (int)L; { const int q = nwg / NXCD, r = nwg % NXCD, xcd = wgid % NXCD, off = wgid / NXCD; wgid = (xcd < r ? xcd * (q + 1) : r * (q + 1) + (xcd - r) * q) + off; }
        const int nig = WGM * nN, gid = wgid / nig, fm = gid * WGM, gsz = (nM - fm) < WGM ? (nM - fm) : WGM;
        u.pm = fm + ((wgid % nig) % gsz); u.pn = (wgid % nig) / gsz; return true;
    }
    __device__ __forceinline__ size_t boff(const Unit&) const { return 0; }
};
struct MoeOrder {
    static constexpr bool GATHER = false;
    const LAS int* tile_e; int nT, G, c; size_t estride;
    __device__ bool next(int i, Unit& u) const { const int L = i * G + c; u.pm = L >> 2; u.pn = L & 3; return u.pm < nT; }
    __device__ __forceinline__ size_t boff(const Unit& u) const { return (size_t)tile_e[u.pm] * estride; }
};
struct MoeGatherOrder : MoeOrder {
    static constexpr bool GATHER = true;
    const LAS int* lcnt; const LAS int* lbase; const u32x2* list;
    __device__ __forceinline__ unsigned rowoff(int r, int C, int lda) const { const int e = tile_e[r >> 8], j = r - lbase[e];
        unsigned tok = 0u; if (j < lcnt[e]) tok = list[(size_t)e * MROWS + j].x >> 1; return (tok * (unsigned)lda + (unsigned)C) * 2u; }
};

template <class Epi, class Sched, bool ALIGN_EPI = false>
__device__ __forceinline__ void gemm_phase(LAS unsigned char* lds, const Gemm g, const Sched& S, const Epi& E, const int tid) {
    const int wid = __builtin_amdgcn_readfirstlane(tid >> 6), lane = tid & 63, wr = wid >> 2, wc = wid & 3, fr = lane & 15, fq = lane >> 4;
    const int K = g.K, nt = K / BK;
    constexpr bool GA = Sched::GATHER;
    unsigned voffA[2], voffB[2]; int sR[2], sC[2];
#pragma unroll
    for (int i = 0; i < 2; ++i) { int R, C; stage_rc(tid * 16 + i * 8192, R, C); const int Rb = (R & ~31) + perm32(R & 31); sR[i] = R; sC[i] = C;
        voffA[i] = (unsigned)(R * g.lda + C) * 2u; voffB[i] = (unsigned)(Rb * K + C) * 2u; }
    unsigned ra[2][2], rn[2][2];
    const size_t kstep = (size_t)(BK * 2);
    const size_t hstepA = (size_t)HALF * g.lda * 2, hstepB = (size_t)HALF * K * 2;
    const size_t tstepA = 2 * hstepA, tstepB = 2 * hstepB;
    const unsigned ldsw = (unsigned)wid * 1024u;
    const int aoff = lds_byte(wr * 64 + fr, fq * 8), boff = lds_byte(wc * 32 + fr, fq * 8);
#define PG8_SA(b, h) (((b) * 2 + (h)) * HTB)
#define PG8_SB(b, h) ((4 + (b) * 2 + (h)) * HTB)
#define PG8_STAGE(bufoff, gbase, voff) do { _Pragma("unroll") for (int _i = 0; _i < 2; ++_i) \
        __builtin_amdgcn_global_load_lds((const unsigned*)((const char*)(gbase) + (voff)[_i]), (LAS unsigned*)(lds + (bufoff) + ldsw + _i * 8192), 16, 0, 0); } while (0)
#define PG8_ROWS(dst, u) do { if constexpr (GA) { _Pragma("unroll") for (int _h = 0; _h < 2; ++_h) _Pragma("unroll") for (int _i = 0; _i < 2; ++_i) dst[_h][_i] = S.rowoff((u).pm * 256 + _h * 128 + sR[_i], sC[_i], g.lda); } } while (0)
#define PG8_STAGE_A(bufoff, gbase, R, h) do { if constexpr (GA) { _Pragma("unroll") for (int _i = 0; _i < 2; ++_i) \
        __builtin_amdgcn_global_load_lds((const unsigned*)((const char*)(gbase) + (R)[h][_i]), (LAS unsigned*)(lds + (bufoff) + ldsw + _i * 8192), 16, 0, 0); } \
        else PG8_STAGE(bufoff, (gbase) + (h) * hstepA, voffA); } while (0)
#define PG8_LDA(dst, b, h) do { _Pragma("unroll") for (int m = 0; m < 4; ++m) _Pragma("unroll") for (int k = 0; k < 2; ++k) dst[m][k] = *(const LAS bf16x8*)(lds + PG8_SA(b, h) + aoff + m * 2048 + k * 1024); } while (0)
#define PG8_LDB(dst, b, h) do { _Pragma("unroll") for (int n = 0; n < 2; ++n) _Pragma("unroll") for (int k = 0; k < 2; ++k) dst[n][k] = *(const LAS bf16x8*)(lds + PG8_SB(b, h) + boff + n * 2048 + k * 1024); } while (0)
#define PG8_MMA(ai, bj, At, Bt) do { __builtin_amdgcn_s_setprio(1); _Pragma("unroll") for (int m = 0; m < 4; ++m) _Pragma("unroll") for (int n = 0; n < 2; ++n) _Pragma("unroll") for (int k = 0; k < 2; ++k) \
        acc[ai][bj][m][n] = __builtin_amdgcn_mfma_f32_16x16x32_bf16(Bt[n][k], At[m][k], acc[ai][bj][m][n], 0, 0, 0); __builtin_amdgcn_s_setprio(0); } while (0)
#define PG8_WAIT_V(n) asm volatile("s_waitcnt vmcnt(" #n ")" ::: "memory")
#define PG8_WAIT_L(n) asm volatile("s_waitcnt lgkmcnt(" #n ")" ::: "memory")
#define PG8_BAR __builtin_amdgcn_s_barrier()
#define PG8_SCHED __builtin_amdgcn_sched_barrier(0)
    Unit cur, nxt; int ui = 0;
    if (!S.next(0, cur)) return;
    f32x4 acc[2][2][4][2];
#pragma unroll
    for (int a = 0; a < 2; ++a)
#pragma unroll
        for (int b = 0; b < 2; ++b)
#pragma unroll
            for (int m = 0; m < 4; ++m)
#pragma unroll
                for (int n = 0; n < 2; ++n) acc[a][b][m][n] = (f32x4){0.f, 0.f, 0.f, 0.f};
    bf16x8 At[4][2], B0[2][2], B1[2][2];
    const char* cA = (const char*)g.A + (GA ? (size_t)0 : (size_t)cur.pm * tstepA); const char* cB = (const char*)g.Bt + S.boff(cur) * 2 + (size_t)cur.pn * tstepB;
    PG8_ROWS(ra, cur);
    PG8_STAGE(PG8_SB(0, 0), cB, voffB); PG8_STAGE(PG8_SB(0, 1), cB + hstepB, voffB); PG8_STAGE_A(PG8_SA(0, 0), cA, ra, 0); PG8_STAGE_A(PG8_SA(0, 1), cA, ra, 1);
    if (wr == 1) PG8_BAR;
    PG8_WAIT_V(2); PG8_BAR;
    PG8_STAGE(PG8_SB(1, 0), cB + kstep, voffB); PG8_STAGE_A(PG8_SA(1, 0), cA + kstep, ra, 0); PG8_STAGE(PG8_SB(1, 1), cB + hstepB + kstep, voffB);
    PG8_WAIT_V(6); PG8_BAR;
    for (;;) {
        const bool has_next = S.next(ui + 1, nxt);
        if constexpr (GA) { if (has_next) PG8_ROWS(rn, nxt); else { _Pragma("unroll") for (int _h = 0; _h < 2; ++_h) _Pragma("unroll") for (int _i = 0; _i < 2; ++_i) rn[_h][_i] = ra[_h][_i]; } }
        const char* nA = (has_next && !GA) ? (const char*)g.A + (size_t)nxt.pm * tstepA : cA; const char* nB = has_next ? (const char*)g.Bt + S.boff(nxt) * 2 + (size_t)nxt.pn * tstepB : cB;
        for (int t = 0; t < nt; t += 2) {
            const bool last = (t == nt - 2);
            const char* a1 = cA + (size_t)(t + 1) * kstep;
            const char* a2 = last ? nA : cA + (size_t)(t + 2) * kstep; const char* b2 = last ? nB : cB + (size_t)(t + 2) * kstep;
            const char* a3 = a2 + kstep; const char* b3 = b2 + kstep;
            unsigned rs[2][2];
            if constexpr (GA) { _Pragma("unroll") for (int _h = 0; _h < 2; ++_h) _Pragma("unroll") for (int _i = 0; _i < 2; ++_i) rs[_h][_i] = last ? rn[_h][_i] : ra[_h][_i]; }
            PG8_LDB(B0, 0, 0); PG8_LDB(B1, 0, 1); PG8_SCHED; PG8_LDA(At, 0, 0); PG8_STAGE_A(PG8_SA(1, 1), a1, ra, 1);
            PG8_WAIT_V(8); PG8_WAIT_L(0); PG8_BAR; PG8_MMA(0, 0, At, B0); PG8_MMA(0, 1, At, B1); PG8_BAR; PG8_SCHED;
            PG8_LDA(At, 0, 1); PG8_STAGE(PG8_SB(0, 0), b2, voffB); PG8_STAGE(PG8_SB(0, 1), b2 + hstepB, voffB); PG8_STAGE_A(PG8_SA(0, 0), a2, rs, 0);
            PG8_WAIT_V(8); PG8_WAIT_L(0); PG8_BAR; PG8_MMA(1, 0, At, B0); PG8_MMA(1, 1, At, B1); PG8_BAR; PG8_SCHED;
            PG8_LDB(B0, 1, 0); PG8_LDB(B1, 1, 1); PG8_SCHED; PG8_LDA(At, 1, 0); PG8_STAGE_A(PG8_SA(0, 1), a2, rs, 1);
            PG8_WAIT_V(8); PG8_WAIT_L(0); PG8_BAR; PG8_MMA(0, 0, At, B0); PG8_MMA(0, 1, At, B1); PG8_BAR; PG8_SCHED;
            PG8_LDA(At, 1, 1); PG8_STAGE(PG8_SB(1, 0), b3, voffB); PG8_STAGE(PG8_SB(1, 1), b3 + hstepB, voffB); PG8_STAGE_A(PG8_SA(1, 0), a3, rs, 0);
            PG8_WAIT_V(8); PG8_WAIT_L(0); PG8_BAR; PG8_MMA(1, 0, At, B0); PG8_MMA(1, 1, At, B1); PG8_BAR; PG8_SCHED;
        }
        if constexpr (ALIGN_EPI) { if (wr == 0) PG8_BAR; }
        E(acc, cur, wr, wc, fr, fq);
        if (!has_next) break;
#pragma unroll
        for (int a = 0; a < 2; ++a)
#pragma unroll
            for (int b = 0; b < 2; ++b)
#pragma unroll
                for (int m = 0; m < 4; ++m)
#pragma unroll
                    for (int n = 0; n < 2; ++n) acc[a][b][m][n] = (f32x4){0.f, 0.f, 0.f, 0.f};
        cur = nxt; cA = nA; cB = nB; ++ui;
        if constexpr (GA) { _Pragma("unroll") for (int _h = 0; _h < 2; ++_h) _Pragma("unroll") for (int _i = 0; _i < 2; ++_i) ra[_h][_i] = rn[_h][_i]; }
        if constexpr (ALIGN_EPI) { if (wr == 1) PG8_BAR; }
    }
    PG8_WAIT_V(0);
    if constexpr (!ALIGN_EPI) { if (wr == 0) PG8_BAR; }
    PG8_BAR;
#undef PG8_SA
#undef PG8_SB
#undef PG8_STAGE
#undef PG8_LDA
#undef PG8_ROWS
#undef PG8_STAGE_A
#undef PG8_LDB
#undef PG8_MMA
#undef PG8_WAIT_V
#undef PG8_WAIT_L
#undef PG8_BAR
#undef PG8_SCHED
}
}

#define XB_TMO      128
#define XB_XCNT(j)  (256  + 64 * (j))
#define XB_XSUB(j)  (1280 + 64 * (j))
#define XB_XGEN(j)  (2304 + 64 * (j))
#define XB_TOP      3328
#define XB_TOPGEN   3392
#define XCD_BAR_WORDS 3456
#define XB_SPIN_CAP (1u << 18)

__device__ __forceinline__ unsigned xb_ld(unsigned* p)              { return __hip_atomic_load(p, __ATOMIC_RELAXED, __HIP_MEMORY_SCOPE_AGENT); }
__device__ __forceinline__ unsigned xb_add(unsigned* p, unsigned v) { return __hip_atomic_fetch_add(p, v, __ATOMIC_RELAXED, __HIP_MEMORY_SCOPE_AGENT); }
__device__ __forceinline__ unsigned xb_xcc_id() { return (unsigned)__builtin_amdgcn_s_getreg((3 << 11) | 20) & 0xFu; }
#define XB_SPIN(cond, bar) do { unsigned _sp = 0; while (cond) { __builtin_amdgcn_s_sleep(1); \
    if ((++_sp & 255u) == 0u) { if (xb_ld(&(bar)[XB_TMO])) break; if (_sp > XB_SPIN_CAP) { atomicAdd(&(bar)[XB_TMO], 1u); break; } } } } while (0)

struct XcdBarrier {
    unsigned* bar; unsigned x;
    volatile LAS unsigned* st;
};
__device__ __forceinline__ XcdBarrier xcd_barrier_post(unsigned* bar, volatile LAS unsigned* st) {
    XcdBarrier b; b.bar = bar; b.x = xb_xcc_id(); b.st = st;
    if (threadIdx.x == 0) (void)xb_add(&bar[XB_XCNT(b.x)], 1u);
    return b;
}
__device__ __forceinline__ void xcd_barrier_complete(unsigned* bar, unsigned x, unsigned& nloc, unsigned& nx) {
    const unsigned G = gridDim.x * gridDim.y * gridDim.z;
    unsigned sum, cnt, mine, sp = 0u;
    for (;;) {
        sum = 0u; cnt = 0u; mine = 0u;
#pragma unroll
        for (unsigned j = 0; j < 16; ++j) { const unsigned c = xb_ld(&bar[XB_XCNT(j)]); sum += c; cnt += (c > 0u) ? 1u : 0u; mine = (j == x) ? c : mine; }
        if (sum == G) break;
        __builtin_amdgcn_s_sleep(1);
        if ((++sp & 255u) == 0u) { if (xb_ld(&bar[XB_TMO])) break; if (sp > XB_SPIN_CAP) { atomicAdd(&bar[XB_TMO], 1u); break; } }
    }
    nloc = mine > 0u ? mine : 1u; nx = cnt > 0u ? cnt : 1u;
}
__device__ __forceinline__ void xcd_barrier(const XcdBarrier& b) {
    asm volatile("s_waitcnt vmcnt(0)" ::: "memory");
    __syncthreads();
    if (threadIdx.x == 0) {
        unsigned* bar = b.bar;
        __builtin_amdgcn_s_waitcnt(0);
        unsigned nloc = b.st[0], nx = b.st[1];
        if (nloc == 0u) { xcd_barrier_complete(bar, b.x, nloc, nx); b.st[0] = nloc; b.st[1] = nx; }
        const unsigned old = xb_add(&bar[XB_XSUB(b.x)], 1u);
        const unsigned gen = old / nloc;
        if (old + 1u == (gen + 1u) * nloc) {
            __builtin_amdgcn_fence(__ATOMIC_RELEASE, "agent");
            asm volatile("s_waitcnt vmcnt(0)" ::: "memory");
            const unsigned og = xb_add(&bar[XB_TOP], 1u);
            const unsigned tg = og / nx;
            if (og + 1u == (tg + 1u) * nx) xb_add(&bar[XB_TOPGEN], 1u);
            else XB_SPIN(xb_ld(&bar[XB_TOPGEN]) == tg, bar);
            __builtin_amdgcn_fence(__ATOMIC_ACQUIRE, "agent");
            xb_add(&bar[XB_XGEN(b.x)], 1u);
            asm volatile("s_waitcnt vmcnt(0)" ::: "memory");
        } else {
            XB_SPIN(xb_ld(&bar[XB_XGEN(b.x)]) == gen, bar);
            __builtin_amdgcn_fence(__ATOMIC_ACQUIRE, "agent");
            asm volatile("s_waitcnt vmcnt(0)" ::: "memory");
        }
    }
    __syncthreads();
}

struct Args { const float* in[27]; float* out; unsigned char* ws; int ph_lo, ph_hi; };
struct Frame {
    LAS unsigned char* lds;
    unsigned char* ws;
    unsigned* ctl;
    const float* const* in;
    int tid, lane, wave, vcu, G, gw, NGW;
};

__device__ __forceinline__ void p0_transpose_item(const float* W, int K, int N, bf16_t* WT, int mode, LAS unsigned* scr, int item, int lane, float scale = 1.f) {
    const int nblk = (N + 63) / 64, kb = item / nblk, nb = item % nblk, k0 = 64 * kb, n0 = 64 * nb;
    const int drow0 = mode == 0 ? n0 : ((n0 >> 7) * 256 + (n0 & 127) + (mode == 2 ? 128 : 0));
    const int r = lane >> 4, n4 = lane & 15; const bool okc = n0 + 4 * n4 < N;
    f32x4 la[8], lb[8];
#pragma unroll
    for (int st = 0; st < 8; ++st) { const float* p = W + (size_t)(k0 + st * 8 + 2 * r) * N + n0 + 4 * n4;
        la[st] = okc ? __builtin_nontemporal_load((const f32x4*)p) : (f32x4){0.f, 0.f, 0.f, 0.f}; lb[st] = okc ? __builtin_nontemporal_load((const f32x4*)(p + N)) : (f32x4){0.f, 0.f, 0.f, 0.f}; }
#pragma unroll
    for (int st = 0; st < 8; ++st)
#pragma unroll
        for (int q = 0; q < 4; ++q) scr[(4 * n4 + q) * 33 + st * 4 + r] = cvt_pk_bf16(la[st][q] * scale, lb[st][q] * scale);
    LDS_WAIT(); asm volatile("" ::: "memory");
    const int c = lane & 7;
#pragma unroll
    for (int st = 0; st < 8; ++st) { const int n = st * 8 + (lane >> 3); const LAS unsigned* sp = scr + n * 33 + 4 * c;
        const u32x4 o = {sp[0], sp[1], sp[2], sp[3]};
        if (n0 + n < N) *(u32x4*)(WT + (size_t)(drow0 + n) * K + k0 + 8 * c) = o; }
    LDS_WAIT(); asm volatile("" ::: "memory");
}
__device__ __forceinline__ float silu_f(float x) { return x / (1.f + __expf(-x)); }

__device__ __forceinline__ void p0_prologue(Frame& F) {
    {
        LAS float* sv = (LAS float*)F.lds;
        LAS float* red = (LAS float*)(F.lds + 12288);
        const float* c = F.in[1]; const float* cc = F.in[3];
        for (int i = F.tid; i < 3072; i += NTHREADS) { const float x = i < 2048 ? c[i] : cc[i - 2048]; sv[i] = silu_f(x); }
        __syncthreads();
        const float* wada = F.in[4]; const float* bada = F.in[5]; float* mod = (float*)(F.ws + WS_MOD);
        for (int it = F.vcu; it < 4 * 96; it += F.G) {
            const int l = it / 96, n = (it % 96) * 64 + F.lane;
            const float* wp = wada + ((size_t)l * 1024 + F.wave * 128) * 6144 + n;
            float a0 = 0.f, a1 = 0.f, a2 = 0.f;
#pragma unroll 16
            for (int k = 0; k < 128; ++k) { const float w = wp[(size_t)k * 6144]; const int kk = F.wave * 128 + k; a0 += sv[kk] * w; a1 += sv[1024 + kk] * w; a2 += sv[2048 + kk] * w; }
            red[(F.wave * 3 + 0) * 64 + F.lane] = a0; red[(F.wave * 3 + 1) * 64 + F.lane] = a1; red[(F.wave * 3 + 2) * 64 + F.lane] = a2;
            __syncthreads();
            if (F.wave < 3) { float s = bada[l * 6144 + n];
#pragma unroll
                for (int w = 0; w < 8; ++w) s += red[(w * 3 + F.wave) * 64 + F.lane];
                mod[(size_t)(l * 3 + F.wave) * 6144 + n] = s; }
            __syncthreads();
        }
    }
    {
        f32x2* rope = (f32x2*)(F.ws + WS_ROPE);
        for (int e = F.vcu * NTHREADS + F.tid; e < 7680; e += F.G * NTHREADS) {
            int pos, i, n;
            if (e < 2048) { pos = e >> 3; i = e & 7; n = 8; } else if (e < 2560) { pos = (e - 2048) >> 3; i = e & 7; n = 8; }
            else if (e < 6656) { pos = (e - 2560) >> 4; i = (e - 2560) & 15; n = 16; } else { pos = (e - 6656) >> 4; i = (e - 6656) & 15; n = 16; }
            const float inv = powf(10000.f, -(float)i / (float)n);
            const float ang = (float)pos * inv; float s, co; sincosf(ang, &s, &co);
            rope[e] = (f32x2){co, s};
        }
    }
    {
        bf16_t* winT = (bf16_t*)(F.ws + WS_WIN);
        for (int e = F.vcu * NTHREADS + F.tid; e < 2 * 96 * 128; e += F.G * NTHREADS) { const int i = e / (96 * 128), r = (e / 128) % 96, c8 = e % 128;
            *(u32x4*)(winT + ((size_t)i * AB_INP + AB_IN + r) * 1024 + c8 * 8) = (u32x4){0u, 0u, 0u, 0u}; }
    }
    {
        LAS unsigned* scr = (LAS unsigned*)(F.lds + F.wave * 16384);
        constexpr int I_WIN = 16 * 23, I_QUP = 6 * 12, I_KVUP = 4 * 16, I_OUT = 16 * 16, I_NIN = 16 * 48, I_NOUT = 16 * 16;
        constexpr int I_SMALL = I_WIN + I_QUP + I_KVUP + I_OUT + I_NIN + I_NOUT;
        constexpr int NITEMS = 2 * I_SMALL + 128 * 384;
        for (int it = F.gw; it < NITEMS; it += F.NGW) {
            if (it < 2 * I_SMALL) {
                const int i = it / I_SMALL; int r = it % I_SMALL;
                if (r < I_WIN) { p0_transpose_item(F.in[9] + (size_t)i * 1024 * 1440, 1024, 1440, (bf16_t*)(F.ws + WS_WIN) + (size_t)i * AB_INP * 1024, 0, scr, r, F.lane); continue; } r -= I_WIN;
                if (r < I_QUP) { p0_transpose_item(F.in[12] + (size_t)i * 384 * 768, 384, 768, (bf16_t*)(F.ws + WS_WQUP) + (size_t)i * 768 * 384, 0, scr, r, F.lane, SC_A); continue; } r -= I_QUP;
                if (r < I_KVUP) { p0_transpose_item(F.in[14] + (size_t)i * 256 * 1024, 256, 1024, (bf16_t*)(F.ws + WS_WKVUP) + (size_t)i * 1024 * 256, 0, scr, r, F.lane); continue; } r -= I_KVUP;
                if (r < I_OUT) { p0_transpose_item(F.in[10] + (size_t)i * 1024 * 1024, 1024, 1024, (bf16_t*)(F.ws + WS_WOUT) + (size_t)i * 1024 * 1024, 0, scr, r, F.lane); continue; } r -= I_OUT;
                if (r < I_NIN) { p0_transpose_item(F.in[17] + (size_t)i * 1024 * 3072, 1024, 3072, (bf16_t*)(F.ws + WS_NIN) + (size_t)i * 3072 * 1024, 0, scr, r, F.lane); continue; } r -= I_NIN;
                p0_transpose_item(F.in[18] + (size_t)i * 1024 * 1024, 1024, 1024, (bf16_t*)(F.ws + WS_NOUT) + (size_t)i * 1024 * 1024, 0, scr, r, F.lane);
            } else {
                const int r = it - 2 * I_SMALL, le = r / 384, q = r % 384, kind = q >> 7, sub = q & 127, l = le >> 5, e = le & 31;
                bf16_t* gu = (bf16_t*)(F.ws + WS_MOEW + (size_t)l * MOEW_LAYER) + (size_t)e * 1024 * 1024;
                bf16_t* dn = (bf16_t*)(F.ws + WS_MOEW + (size_t)l * MOEW_LAYER + MOEW_DN) + (size_t)e * 1024 * 512;
                if (kind == 0) p0_transpose_item(F.in[24] + (size_t)le * 1024 * 512, 1024, 512, gu, 1, scr, sub, F.lane);
                else if (kind == 1) p0_transpose_item(F.in[25] + (size_t)le * 1024 * 512, 1024, 512, gu, 2, scr, sub, F.lane);
                else p0_transpose_item(F.in[26] + (size_t)le * 512 * 1024, 512, 1024, dn, 0, scr, sub, F.lane);
            }
        }
    }
}

__device__ __forceinline__ void store_bf16_row(bf16_t* orow, int lane, const f32x4 (&h)[4]) {
#pragma unroll
    for (int j = 0; j < 4; ++j) { u32x2 w; w.x = cvt_pk_bf16(h[j].x, h[j].y); w.y = cvt_pk_bf16(h[j].z, h[j].w); *(u32x2*)(orow + 256 * j + 4 * lane) = w; }
}
__device__ __forceinline__ void combine_row(f32x4 (&x)[4], const bf16_t* y0, const float* g2, int lane) {
#pragma unroll
    for (int j = 0; j < 4; ++j) {
        const u32x2 a = *(const u32x2*)(y0 + 256 * j + 4 * lane), b = *(const u32x2*)(y0 + 1024 + 256 * j + 4 * lane);
        const f32x4 g = *(const f32x4*)(g2 + 256 * j + 4 * lane) * MOE_ALPHA;
        x[j].x += g.x * (bf16lo(a.x) + bf16lo(b.x)); x[j].y += g.y * (bf16hi(a.x) + bf16hi(b.x));
        x[j].z += g.z * (bf16lo(a.y) + bf16lo(b.y)); x[j].w += g.w * (bf16hi(a.y) + bf16hi(b.y));
    }
}
__device__ __forceinline__ float row_rs(const f32x4 (&x)[4]) {
    float s = 0.f;
#pragma unroll
    for (int j = 0; j < 4; ++j) s += (x[j].x * x[j].x + x[j].y * x[j].y) + (x[j].z * x[j].z + x[j].w * x[j].w);
    return rsqrtf(wave_sum(s) * (1.f / 1024.f) + RMS_EPS);
}
__device__ __forceinline__ void modulate_row(const f32x4 (&x)[4], f32x4 (&h)[4], float rs, const float* gain, const float* sh, const float* sc, int lane) {
#pragma unroll
    for (int j = 0; j < 4; ++j) {
        const f32x4 g = *(const f32x4*)(gain + 256 * j + 4 * lane), s1 = *(const f32x4*)(sc + 256 * j + 4 * lane), s0 = *(const f32x4*)(sh + 256 * j + 4 * lane);
        h[j] = (x[j] * rs) * g * (s1 + 1.f) + s0;
    }
}

struct RowVec { f32x4 a[4], b[4], g[4]; };
__device__ __forceinline__ void load_rowvec(RowVec& V, const float* gain, const float* sh, const float* sc, const float* g2, int lane) {
#pragma unroll
    for (int j = 0; j < 4; ++j) { const int c = 256 * j + 4 * lane;
        const f32x4 g = *(const f32x4*)(gain + c), s1 = *(const f32x4*)(sc + c); V.a[j] = g * (s1 + 1.f); V.b[j] = *(const f32x4*)(sh + c);
        V.g[j] = g2 ? *(const f32x4*)(g2 + c) * MOE_ALPHA : (f32x4){0.f, 0.f, 0.f, 0.f}; }
}
struct RowRaw { f32x4 x[4]; u32x2 y0[4], y1[4]; };
__device__ __forceinline__ void load_rowraw(RowRaw& R, const float* xrow, const bf16_t* yrow, int lane) {
#pragma unroll
    for (int j = 0; j < 4; ++j) R.x[j] = *(const f32x4*)(xrow + 256 * j + 4 * lane);
    if (yrow) {
#pragma unroll
        for (int j = 0; j < 4; ++j) { R.y0[j] = *(const u32x2*)(yrow + 256 * j + 4 * lane); R.y1[j] = *(const u32x2*)(yrow + 1024 + 256 * j + 4 * lane); } }
}
__device__ __forceinline__ void combine_raw(RowRaw& R, const RowVec& V) {
#pragma unroll
    for (int j = 0; j < 4; ++j) { const u32x2 a = R.y0[j], b = R.y1[j];
        R.x[j].x += V.g[j].x * (bf16lo(a.x) + bf16lo(b.x)); R.x[j].y += V.g[j].y * (bf16hi(a.x) + bf16hi(b.x));
        R.x[j].z += V.g[j].z * (bf16lo(a.y) + bf16lo(b.y)); R.x[j].w += V.g[j].w * (bf16hi(a.y) + bf16hi(b.y)); }
}
__device__ __forceinline__ int chunk_lo(int gw, int M, int NGW) { return (int)(((long)gw * M) / NGW); }

__device__ __forceinline__ void mix_norm_phase(Frame& F, int l) {
    float* X = (float*)(F.ws + WS_X); bf16_t* H = (bf16_t*)(F.ws + WS_H);
    const float* mod = (const float*)(F.ws + WS_MOD); const bf16_t* Y = (const bf16_t*)(F.ws + R_Y);
    const float* gain = F.in[6] + l * 1024;
    const int r0 = chunk_lo(F.gw, MROWS, F.NGW), r1 = chunk_lo(F.gw + 1, MROWS, F.NGW);
    RowVec V; RowRaw cur, nxt; int vcur = -1;
#define SRC(m) ((l == 0) ? ((m) < NLAT ? F.in[0] + (size_t)(m) * 1024 : F.in[2] + (size_t)((m) - NLAT) * 1024) : X + (size_t)(m) * 1024)
    if (r0 < r1) load_rowraw(nxt, SRC(r0), l > 0 ? Y + (size_t)r0 * 2048 : nullptr, F.lane);
    for (int m = r0; m < r1; ++m) {
        cur = nxt;
        if (m + 1 < r1) load_rowraw(nxt, SRC(m + 1), l > 0 ? Y + (size_t)(m + 1) * 2048 : nullptr, F.lane);
        const int v = row_class(m);
        if (v != vcur) { vcur = v; const float* mv = mod + (size_t)(l * 3 + v) * 6144;
            load_rowvec(V, gain, mv, mv + 1024, l > 0 ? mod + ((size_t)((l - 1) * 3 + v) * 6 + 5) * 1024 : nullptr, F.lane); }
        if (l > 0) combine_raw(cur, V);
        if (l > 0) {
#pragma unroll
        for (int j = 0; j < 4; ++j) *(f32x4*)(X + (size_t)m * 1024 + 256 * j + 4 * F.lane) = cur.x[j]; }
        const float rs = row_rs(cur.x);
        f32x4 h[4];
#pragma unroll
        for (int j = 0; j < 4; ++j) h[j] = (cur.x[j] * rs) * V.a[j] + V.b[j];
        store_bf16_row(H + (size_t)m * 1024, F.lane, h);
    }
#undef SRC
}
__device__ __forceinline__ void final_phase(Frame& F, float* out) {
    const float* X = (const float*)(F.ws + WS_X); const float* mod = (const float*)(F.ws + WS_MOD); const bf16_t* Y = (const bf16_t*)(F.ws + R_Y);
    const float* gain = F.in[8];
    const int r0 = chunk_lo(F.gw, NLAT, F.NGW), r1 = chunk_lo(F.gw + 1, NLAT, F.NGW);
    RowVec V; RowRaw cur, nxt; int vcur = -1;
    if (r0 < r1) load_rowraw(nxt, X + (size_t)r0 * 1024, Y + (size_t)r0 * 2048, F.lane);
    for (int m = r0; m < r1; ++m) {
        cur = nxt;
        if (m + 1 < r1) load_rowraw(nxt, X + (size_t)(m + 1) * 1024, Y + (size_t)(m + 1) * 2048, F.lane);
        const int v = row_class(m);
        if (v != vcur) { vcur = v; const float* mv = mod + (size_t)(3 * 3 + v) * 6144; load_rowvec(V, gain, mv, mv + 1024, mv + 5 * 1024, F.lane); }
        combine_raw(cur, V);
        float rs = row_rs(cur.x);
        if (DBG_SEL >= 0 && DBG_SEL < 100) rs *= 1.f + (DBG_SEL >= 16 ? 10.f : 1.f) * fminf(u2f(__hip_atomic_load(F.ctl + CW_DBG + DBG_SEL, RLX_AGENT)), 0.3f);
        if (DBG_SEL == 101) { float code = 0.f;
            for (int g = 0; g < 8; ++g) { float e = 0.f; for (int q = 0; q < 4; ++q) e = fmaxf(e, u2f(__hip_atomic_load(F.ctl + CW_DBG + 16 + 4 * g + q, RLX_AGENT))); if (e > 0.05f) code += 0.1f * (float)(1 << g); }
            rs *= 1.f + code; }
#pragma unroll
        for (int j = 0; j < 4; ++j) { const f32x4 g = *(const f32x4*)(gain + 256 * j + 4 * F.lane); *(f32x4*)(out + (size_t)m * 1024 + 256 * j + 4 * F.lane) = (cur.x[j] * rs) * g; }
    }
}

__device__ __forceinline__ void ffn_norm_route_phase(Frame& F, int l) {
    const int M = (l == DEPTH - 1) ? NLAT : MROWS;
    const float* X = (const float*)(F.ws + WS_X); bf16_t* H = (bf16_t*)(F.ws + WS_H);
    const float* mod = (const float*)(F.ws + WS_MOD);
    const float* gain = F.in[7] + l * 1024;
    LAS float* tab = (LAS float*)F.lds;
    LAS int* lcnt = (LAS int*)(F.lds + CNTL_OFF); LAS int* lbase = lcnt + 32;
    LAS int* rec = (LAS int*)(F.lds + REC_OFF);
    {
        const float* wrg = F.in[20] + (size_t)l * 4096; const float* wre = F.in[22] + (size_t)l * 32768;
        for (int i = F.tid; i < 4096; i += NTHREADS) tab[(i & 3) * TAB_LD + (i >> 2)] = wrg[i];
        for (int i = F.tid; i < 32768; i += NTHREADS) tab[(4 + (i & 31)) * TAB_LD + (i >> 5)] = wre[i];
        if (F.tid < 32) lcnt[F.tid] = 0;
    }
    __syncthreads();
    const float* brg = F.in[21] + l * 4; const float* bre = F.in[23] + l * 32;
    const int r0 = chunk_lo(F.gw, M, F.NGW), r1 = chunk_lo(F.gw + 1, M, F.NGW);
    RowVec V; RowRaw cur, nxt; int vcur = -1;
    if (r0 < r1) load_rowraw(nxt, X + (size_t)r0 * 1024, nullptr, F.lane);
    int it = 0;
    for (int m = r0; m < r1; ++m, ++it) {
        cur = nxt;
        if (m + 1 < r1) load_rowraw(nxt, X + (size_t)(m + 1) * 1024, nullptr, F.lane);
        const int v = row_class(m);
        if (v != vcur) { vcur = v; const float* mv = mod + (size_t)(l * 3 + v) * 6144; load_rowvec(V, gain, mv + 3 * 1024, mv + 4 * 1024, nullptr, F.lane); }
        const float rs = row_rs(cur.x);
        f32x4 h[4];
#pragma unroll
        for (int j = 0; j < 4; ++j) h[j] = (cur.x[j] * rs) * V.a[j] + V.b[j];
        store_bf16_row(H + (size_t)m * 1024, F.lane, h);
        float lg[36];
#pragma unroll
        for (int o = 0; o < 36; ++o) {
            f32x2 a2 = {0.f, 0.f};
#pragma unroll
            for (int j = 0; j < 4; ++j) { const f32x4 w = *(const LAS f32x4*)(tab + o * TAB_LD + 256 * j + 4 * F.lane);
                a2 = __builtin_elementwise_fma((f32x2){h[j].x, h[j].y}, (f32x2){w.x, w.y}, a2); a2 = __builtin_elementwise_fma((f32x2){h[j].z, h[j].w}, (f32x2){w.z, w.w}, a2); }
            lg[o] = a2.x + a2.y;
        }
#pragma unroll
        for (int o = 0; o < 36; ++o) lg[o] = wave_sum(lg[o]);
        float g0 = lg[0] + brg[0], g1 = lg[1] + brg[1], g2 = lg[2] + brg[2], g3 = lg[3] + brg[3];
        int gs = 0; float gm = g0;
        if (g1 > gm) { gm = g1; gs = 1; } if (g2 > gm) { gm = g2; gs = 2; } if (g3 > gm) { gm = g3; gs = 3; }
        const float pg = 1.f / (__expf(g0 - gm) + __expf(g1 - gm) + __expf(g2 - gm) + __expf(g3 - gm));
        float se[8];
#pragma unroll
        for (int j = 0; j < 8; ++j) { const float a0 = lg[4 + j] + bre[j], a1 = lg[12 + j] + bre[8 + j], a2 = lg[20 + j] + bre[16 + j], a3 = lg[28 + j] + bre[24 + j];
            se[j] = gs == 0 ? a0 : (gs == 1 ? a1 : (gs == 2 ? a2 : a3)); }
        int i0 = 0; float m0 = se[0];
#pragma unroll
        for (int j = 1; j < 8; ++j) if (se[j] > m0) { m0 = se[j]; i0 = j; }
        int i1 = -1; float m1 = -3.0e38f;
#pragma unroll
        for (int j = 0; j < 8; ++j) if (j != i0 && se[j] > m1) { m1 = se[j]; i1 = j; }
        const float e1 = __expf(m1 - m0), w0 = pg / (1.f + e1), w1 = pg * e1 / (1.f + e1);
        if (F.lane < 2) {
            const int e = gs * 8 + (F.lane == 0 ? i0 : i1); const float w = F.lane == 0 ? w0 : w1;
            const int lr = atomicAdd((int*)(lcnt + e), 1);
            LAS int* r = rec + ((it * 8 + F.wave) * 2 + F.lane) * 3; r[0] = e; r[1] = lr; r[2] = __builtin_bit_cast(int, W_CONST > 0.f ? W_CONST : w);
        }
    }
    __syncthreads();
    if (F.tid < 32) lbase[F.tid] = (int)__hip_atomic_fetch_add(F.ctl + CW_CNT + (l * 32 + F.tid) * 64, (unsigned)lcnt[F.tid], RLX_AGENT);
    __syncthreads();
    u32x2* list = (u32x2*)(F.ws + WS_LIST);
    it = 0;
    for (int m = r0; m < r1; ++m, ++it) {
        if (F.lane < 2) { const LAS int* r = rec + ((it * 8 + F.wave) * 2 + F.lane) * 3; const int e = r[0], pos = lbase[e] + r[1];
            list[(size_t)e * MROWS + pos] = (u32x2){(unsigned)(2 * m + F.lane), (unsigned)r[2]}; }
    }
}

__device__ __forceinline__ void moe_tile_map(Frame& F, int l) {
    LAS int* tile_e = (LAS int*)(F.lds + TILE_E_OFF); LAS int* nt = (LAS int*)(F.lds + MOE_NT_OFF);
    LAS int* lcnt = (LAS int*)(F.lds + CNTL_OFF); LAS int* lbase = lcnt + 32;
    __syncthreads();
    if (F.tid < 32) lcnt[F.tid] = (int)__hip_atomic_load(F.ctl + CW_CNT + (l * 32 + F.tid) * 64, RLX_AGENT);
    __syncthreads();
    if (F.tid == 0) {
        int t0 = 0;
        for (int e = 0; e < 32; ++e) { const int c = lcnt[e], n = (c + 255) >> 8; lbase[e] = t0 * 256; for (int t = 0; t < n && t0 + t < 320; ++t) tile_e[t0 + t] = e; t0 += n; }
        nt[0] = t0 < MOE_MAXT ? t0 : MOE_MAXT;
    }
    __syncthreads();
}
__device__ __forceinline__ void moe_gather_phase(Frame& F, int l) {
    moe_tile_map(F, l);
    const LAS int* tile_e = (const LAS int*)(F.lds + TILE_E_OFF); const int nT = *(const LAS int*)(F.lds + MOE_NT_OFF);
    const LAS int* lcnt = (const LAS int*)(F.lds + CNTL_OFF); const LAS int* lbase = lcnt + 32;
    const bf16_t* H = (const bf16_t*)(F.ws + WS_H); bf16_t* XB = (bf16_t*)(F.ws + R_XB); u32x2* RI = (u32x2*)(F.ws + R_RI);
    const u32x2* list = (const u32x2*)(F.ws + WS_LIST);
    const int nrows = nT * 256;
    for (int rb = F.gw * 4; rb < nrows; rb += F.NGW * 4) {
        u32x2 ri[4]; u32x4 a[4], b[4];
#pragma unroll
        for (int q = 0; q < 4; ++q) { const int r = rb + q; const int e = tile_e[r >> 8], j = r - lbase[e];
            ri[q] = (u32x2){0xffffffffu, 0u};
            if (j < lcnt[e]) ri[q] = list[(size_t)e * MROWS + j]; }
#pragma unroll
        for (int q = 0; q < 4; ++q) { a[q] = (u32x4){0u, 0u, 0u, 0u}; b[q] = a[q];
            if (ri[q].x != 0xffffffffu) { const bf16_t* src = H + (size_t)(ri[q].x >> 1) * 1024; a[q] = *(const u32x4*)(src + F.lane * 8); b[q] = *(const u32x4*)(src + 512 + F.lane * 8); } }
#pragma unroll
        for (int q = 0; q < 4; ++q) { const int r = rb + q;
            *(u32x4*)(XB + (size_t)r * 1024 + F.lane * 8) = a[q]; *(u32x4*)(XB + (size_t)r * 1024 + 512 + F.lane * 8) = b[q];
            if (F.lane == 0) RI[r] = ri[q]; }
    }
}

using pg8::Unit;
__device__ __forceinline__ u32x4 pack8(const f32x4 v0, const f32x4 v1) { u32x4 w; w.x = cvt_pk_bf16(v0[0], v0[1]); w.y = cvt_pk_bf16(v0[2], v0[3]); w.z = cvt_pk_bf16(v1[0], v1[1]); w.w = cvt_pk_bf16(v1[2], v1[3]); return w; }

struct EpiStore {
    bf16_t* O; int ldc;
    __device__ __forceinline__ void operator()(const f32x4 (&acc)[2][2][4][2], const Unit& u, int wr, int wc, int fr, int fq) const {
        const int row0 = u.pm * 256 + wr * 64 + fr, col0 = u.pn * 256 + wc * 32 + 8 * fq;
#pragma unroll
        for (int ai = 0; ai < 2; ++ai)
#pragma unroll
            for (int m = 0; m < 4; ++m) { bf16_t* rowp = O + (size_t)(row0 + ai * 128 + m * 16) * ldc + col0;
#pragma unroll
                for (int bj = 0; bj < 2; ++bj) *(u32x4*)(rowp + bj * 128) = pack8(acc[ai][bj][m][0], acc[ai][bj][m][1]); }
    }
};
struct EpiOut {
    float* X; const float* modl;
    const float* Xs; const float* Xc;
    __device__ __forceinline__ void operator()(const f32x4 (&acc)[2][2][4][2], const Unit& u, int wr, int wc, int fr, int fq) const {
        const int row0 = u.pm * 256 + wr * 64 + fr, col0 = u.pn * 256 + wc * 32 + 8 * fq;
        const int v = u.pm < 64 ? 0 : (u.pm < 128 ? 1 : 2);
        const float* g1 = modl + (size_t)v * 6144 + 2 * 1024 + col0;
        f32x4 g[2][2];
#pragma unroll
        for (int bj = 0; bj < 2; ++bj) { g[bj][0] = *(const f32x4*)(g1 + bj * 128); g[bj][1] = *(const f32x4*)(g1 + bj * 128 + 4); }
#pragma unroll
        for (int ai = 0; ai < 2; ++ai)
#pragma unroll
            for (int m = 0; m < 4; ++m) { const int row = row0 + ai * 128 + m * 16; float* rowp = X + (size_t)row * 1024 + col0;
                const float* srcp = (u.pm < 128 ? Xs + (size_t)row * 1024 : Xc + (size_t)(row - NLAT) * 1024) + col0;
#pragma unroll
                for (int bj = 0; bj < 2; ++bj) { f32x4* p = (f32x4*)(rowp + bj * 128); const f32x4* q = (const f32x4*)(srcp + bj * 128);
                    const f32x4 a = q[0], b = q[1];
                    p[0] = a + g[bj][0] * acc[ai][bj][m][0]; p[1] = b + g[bj][1] * acc[ai][bj][m][1]; } }
    }
};
struct EpiNaIn {
    bf16_t* QK; bf16_t* Vt; bf16_t* Vtc;
    __device__ __forceinline__ void operator()(const f32x4 (&acc)[2][2][4][2], const Unit& u, int wr, int wc, int fr, int fq) const {
        const int row0 = u.pm * 256 + wr * 64 + fr, col0 = u.pn * 256 + wc * 32 + 8 * fq;
        if (u.pn < 8) {
            const float sc = u.pn < 4 ? SC_B : 1.f;
#pragma unroll
            for (int ai = 0; ai < 2; ++ai)
#pragma unroll
                for (int m = 0; m < 4; ++m) { bf16_t* rowp = QK + (size_t)(row0 + ai * 128 + m * 16) * 2048 + col0;
#pragma unroll
                    for (int bj = 0; bj < 2; ++bj) *(u32x4*)(rowp + bj * 128) = pack8(acc[ai][bj][m][0] * sc, acc[ai][bj][m][1] * sc); }
        } else {
#pragma unroll
            for (int ai = 0; ai < 2; ++ai)
#pragma unroll
                for (int m = 0; m < 4; ++m) { const int row = row0 + ai * 128 + m * 16;
                    bf16_t* base; size_t ld;
                    if (row < NLAT) { base = Vt + (size_t)(row >> 14) * 1024 * SEQ + (row & (SEQ - 1)); ld = SEQ; }
                    else { const int rc = row - NLAT; base = Vtc + (size_t)(rc >> 8) * 1024 * CTXL + (rc & 255); ld = CTXL; }
#pragma unroll
                    for (int bj = 0; bj < 2; ++bj) { const int hc = col0 + bj * 128 - 2048;
                        const u32x4 w = pack8(acc[ai][bj][m][0], acc[ai][bj][m][1]);
                        bf16_t* p = base + (size_t)hc * ld;
                        p[0] = (bf16_t)(w.x & 0xffff); p[ld] = (bf16_t)(w.x >> 16); p[2 * ld] = (bf16_t)(w.y & 0xffff); p[3 * ld] = (bf16_t)(w.y >> 16);
                        p[4 * ld] = (bf16_t)(w.z & 0xffff); p[5 * ld] = (bf16_t)(w.z >> 16); p[6 * ld] = (bf16_t)(w.w & 0xffff); p[7 * ld] = (bf16_t)(w.w >> 16); } }
        }
    }
};
struct EpiMoe1 {
    bf16_t* ACT;
    __device__ __forceinline__ void operator()(const f32x4 (&acc)[2][2][4][2], const Unit& u, int wr, int wc, int fr, int fq) const {
        const int row0 = u.pm * 256 + wr * 64 + fr, col0 = u.pn * 128 + wc * 32 + 8 * fq;
#pragma unroll
        for (int ai = 0; ai < 2; ++ai)
#pragma unroll
            for (int m = 0; m < 4; ++m) { f32x4 o[2];
#pragma unroll
                for (int n = 0; n < 2; ++n)
#pragma unroll
                    for (int i = 0; i < 4; ++i) { const float g = acc[ai][0][m][n][i], up = acc[ai][1][m][n][i];
                        o[n][i] = g * __builtin_amdgcn_rcpf(1.f + __builtin_amdgcn_exp2f(-g * LOG2E)) * up; }
                *(u32x4*)(ACT + (size_t)(row0 + ai * 128 + m * 16) * 512 + col0) = pack8(o[0], o[1]); }
    }
};
struct EpiMoe2 {
    bf16_t* Y; const LAS int* tile_e; const LAS int* lcnt; const LAS int* lbase; const u32x2* list;
    __device__ __forceinline__ void operator()(const f32x4 (&acc)[2][2][4][2], const Unit& u, int wr, int wc, int fr, int fq) const {
        const int row0 = u.pm * 256 + wr * 64 + fr, col0 = u.pn * 256 + wc * 32 + 8 * fq;
        const int e = tile_e[u.pm], j0 = row0 - lbase[e], cnt = lcnt[e];
#pragma unroll
        for (int ai = 0; ai < 2; ++ai)
#pragma unroll
            for (int m = 0; m < 4; ++m) { const int j = j0 + ai * 128 + m * 16;
                if (j < cnt) { const u32x2 ri = list[(size_t)e * MROWS + j]; const float w = u2f(ri.y); bf16_t* rowp = Y + (size_t)ri.x * 1024 + col0;
#pragma unroll
                    for (int bj = 0; bj < 2; ++bj) *(u32x4*)(rowp + bj * 128) = pack8(acc[ai][bj][m][0] * w, acc[ai][bj][m][1] * w); } }
    }
};

__device__ __forceinline__ void ab_prep_phase(Frame& F, int li) {
    const bf16_t* P = (const bf16_t*)(F.ws + R_P);
    bf16_t* CQN = (bf16_t*)(F.ws + R_CQN); bf16_t* CKVN = (bf16_t*)(F.ws + R_CKVN); bf16_t* KR = (bf16_t*)(F.ws + R_KR);
    bf16_t* QB = (bf16_t*)(F.ws + R_QB); bf16_t* KB = (bf16_t*)(F.ws + R_KB); bf16_t* VB = (bf16_t*)(F.ws + R_VB);
    const f32x2* rope = (const f32x2*)(F.ws + WS_ROPE);
    const float* qn = F.in[11] + li * QLORA; const float* kvn = F.in[13] + li * KVLORA; const float* gqn = F.in[15] + li * 64; const float* gkn = F.in[16] + li * 64;
    const int l = F.lane;
    for (int m = F.gw; m < MROWS; m += F.NGW) {
        const bf16_t* p = P + (size_t)m * AB_INP;
        const bool lat = m < NLAT; const int t = m & (SEQ - 1), gr = t >> 6, gc = t & 63;
        const unsigned* pc = (const unsigned*)(p + 6 * l); const unsigned c0 = pc[0], c1 = pc[1], c2 = pc[2];
        const u32x2 kv = *(const u32x2*)(p + 384 + 4 * l);
        const unsigned krw = *(const unsigned*)(p + 640 + 2 * (l & 15));
        const u32x4 gq = *(const u32x4*)(p + 672 + 8 * l);
        const unsigned gkw = *(const unsigned*)(p + 1184 + 2 * l), gvw = *(const unsigned*)(p + 1312 + 2 * l);
        { float x[6] = {bf16lo(c0), bf16hi(c0), bf16lo(c1), bf16hi(c1), bf16lo(c2), bf16hi(c2)};
          float ss = 0.f;
#pragma unroll
          for (int i = 0; i < 6; ++i) ss += x[i] * x[i];
          const float rs = rsqrtf(wave_sum(ss) * (1.f / 384.f) + RMS_EPS);
          unsigned* o = (unsigned*)(CQN + (size_t)m * QLORA + 6 * l);
#pragma unroll
          for (int i = 0; i < 3; ++i) o[i] = cvt_pk_bf16(x[2 * i] * rs * qn[6 * l + 2 * i], x[2 * i + 1] * rs * qn[6 * l + 2 * i + 1]); }
        { float x[4] = {bf16lo(kv.x), bf16hi(kv.x), bf16lo(kv.y), bf16hi(kv.y)};
          const float ss = (x[0] * x[0] + x[1] * x[1]) + (x[2] * x[2] + x[3] * x[3]);
          const float rs = rsqrtf(wave_sum(ss) * (1.f / 256.f) + RMS_EPS);
          const f32x4 g = *(const f32x4*)(kvn + 4 * l);
          u32x2 w; w.x = cvt_pk_bf16(x[0] * rs * g.x, x[1] * rs * g.y); w.y = cvt_pk_bf16(x[2] * rs * g.z, x[3] * rs * g.w);
          *(u32x2*)(CKVN + (size_t)m * KVLORA + 4 * l) = w; }
        if (l < 16) { float x1 = bf16lo(krw), x2 = bf16hi(krw);
            if (lat) { const f32x2 cs = (l < 8) ? rope[gr * 8 + l] : rope[2048 + gc * 8 + (l - 8)]; const float a = x1 * cs.x - x2 * cs.y, b = x1 * cs.y + x2 * cs.x; x1 = a; x2 = b; }
            *(unsigned*)(KR + (size_t)m * 32 + 2 * l) = cvt_pk_bf16(x1, x2); }
        { float x[8] = {bf16lo(gq.x), bf16hi(gq.x), bf16lo(gq.y), bf16hi(gq.y), bf16lo(gq.z), bf16hi(gq.z), bf16lo(gq.w), bf16hi(gq.w)};
          float ss = 0.f;
#pragma unroll
          for (int i = 0; i < 8; ++i) ss += x[i] * x[i];
          ss += __shfl_xor(ss, 1); ss += __shfl_xor(ss, 2); ss += __shfl_xor(ss, 4);
          const float rs = rsqrtf(ss * (1.f / 64.f) + RMS_EPS);
          const int d0 = (l & 7) * 8;
          const f32x4 g0 = *(const f32x4*)(gqn + d0), g1 = *(const f32x4*)(gqn + d0 + 4);
          x[0] *= rs * g0.x; x[1] *= rs * g0.y; x[2] *= rs * g0.z; x[3] *= rs * g0.w; x[4] *= rs * g1.x; x[5] *= rs * g1.y; x[6] *= rs * g1.z; x[7] *= rs * g1.w;
          if (lat) { const int p0 = (l & 7) * 4; const f32x2* tp = (p0 < 16) ? rope + 2560 + gr * 16 + p0 : rope + 6656 + gc * 16 + (p0 - 16);
              const f32x4 cs0 = *(const f32x4*)tp, cs1 = *(const f32x4*)(tp + 2);
              float a;
              a = x[0] * cs0[0] - x[1] * cs0[1]; x[1] = x[0] * cs0[1] + x[1] * cs0[0]; x[0] = a;
              a = x[2] * cs0[2] - x[3] * cs0[3]; x[3] = x[2] * cs0[3] + x[3] * cs0[2]; x[2] = a;
              a = x[4] * cs1[0] - x[5] * cs1[1]; x[5] = x[4] * cs1[1] + x[5] * cs1[0]; x[4] = a;
              a = x[6] * cs1[2] - x[7] * cs1[3]; x[7] = x[6] * cs1[3] + x[7] * cs1[2]; x[6] = a; }
          u32x4 w; w.x = cvt_pk_bf16(x[0] * SC_B, x[1] * SC_B); w.y = cvt_pk_bf16(x[2] * SC_B, x[3] * SC_B); w.z = cvt_pk_bf16(x[4] * SC_B, x[5] * SC_B); w.w = cvt_pk_bf16(x[6] * SC_B, x[7] * SC_B);
          *(u32x4*)(QB + (size_t)m * 512 + 8 * l) = w; }
        { float x1 = bf16lo(gkw), x2 = bf16hi(gkw);
          float ss = x1 * x1 + x2 * x2;
          ss += __shfl_xor(ss, 1); ss += __shfl_xor(ss, 2); ss += __shfl_xor(ss, 4); ss += __shfl_xor(ss, 8); ss += __shfl_xor(ss, 16);
          const float rs = rsqrtf(ss * (1.f / 64.f) + RMS_EPS);
          const int pi = l & 31;
          x1 *= rs * gkn[2 * pi]; x2 *= rs * gkn[2 * pi + 1];
          if (lat) { const f32x2 cs = (pi < 16) ? rope[2560 + gr * 16 + pi] : rope[6656 + gc * 16 + (pi - 16)]; const float a = x1 * cs.x - x2 * cs.y, b = x1 * cs.y + x2 * cs.x; x1 = a; x2 = b; }
          *(unsigned*)(KB + (size_t)m * 128 + 2 * l) = cvt_pk_bf16(x1, x2);
          *(unsigned*)(VB + (size_t)m * 128 + 2 * l) = gvw; }
    }
}

namespace att {
constexpr int B_KN = 0, B_KR = 8192, B_V = 12288, BUF = 20480;
constexpr float THR2 = 8.f * LOG2E;
__device__ __forceinline__ int crow(int r, int hi) { return (r & 3) + 8 * (r >> 2) + 4 * hi; }
__device__ __forceinline__ int swz64(int row, int ch) { return row * 128 + ((ch ^ ((row >> 1) & 7)) << 4); }
__device__ __forceinline__ int swz32(int row, int ch) { return row * 64 + ((ch ^ ((row >> 2) & 3)) << 4); }
__device__ __forceinline__ int v_st(int k, int c) { const int kk = k;     return ((kk >> 3) * 2 + (c >> 5)) * 512 + ((kk & 7) * 32 + (c & 31)) * 2; }
__device__ __forceinline__ int v_rd_base(int lane) { return ((lane & 3) << 3) | (((lane >> 2) & 3) << 6) | (((lane >> 4) & 1) << 5) | (((lane >> 5) & 1) << 8); }
constexpr int v_rd_off(int d0, int ks, int half) { return d0 * 512 + ks * 2048 + half * 1024; }
template <int OFF> __device__ __forceinline__ s16x4 tr_read(unsigned vb) {
    s16x4 r; asm volatile("ds_read_b64_tr_b16 %0, %1 offset:%2" : "=&v"(r) : "v"(vb), "i"(OFF) : "memory"); return r;
}
__device__ __forceinline__ float psm_max(const f32x16& p0, const f32x16& p1) {
    float pmax = p0[0];
#pragma unroll
    for (int r = 1; r < 16; ++r) pmax = fmaxf(pmax, p0[r]);
#pragma unroll
    for (int r = 0; r < 16; ++r) pmax = fmaxf(pmax, p1[r]);
    { auto rr = __builtin_amdgcn_permlane32_swap(__float_as_uint(pmax), __float_as_uint(pmax), false, false);
      pmax = fmaxf(__uint_as_float(rr[0]), __uint_as_float(rr[1])); }
    return pmax;
}
template <bool FIRST> __device__ __forceinline__ void psm_apply(f32x16& p0, f32x16& p1, float pmax, float& m_reg, f32x16& negm, float& alpha) {
    alpha = 1.f;
    if (FIRST || !__builtin_expect(__all(pmax <= THR2), 1)) {
        const float delta = FIRST ? pmax : fmaxf(pmax, 0.f);
        if (!FIRST) alpha = __builtin_amdgcn_exp2f(-delta);
        m_reg += delta;
#pragma unroll
        for (int r = 0; r < 16; ++r) { p0[r] -= delta; p1[r] -= delta; negm[r] = -m_reg; }
    }
#pragma unroll
    for (int r = 0; r < 16; ++r) p0[r] = EXP_PROBE ? fmaf(p0[r], 0.001f, 1.f) : __builtin_amdgcn_exp2f(p0[r]);
}
template <bool FIRST> __device__ __forceinline__ void partialSM(f32x16& p0, f32x16& p1, float& m_reg, f32x16& negm, float& alpha) {
    const float pmax = psm_max(p0, p1); psm_apply<FIRST>(p0, p1, pmax, m_reg, negm, alpha);
}
#define ATT_PK4(P, BASE, OUT) do { unsigned a0 = cvt_pk_bf16(P[BASE + 0], P[BASE + 1]), a1 = cvt_pk_bf16(P[BASE + 2], P[BASE + 3]);   \
    unsigned b0 = cvt_pk_bf16(P[BASE + 4], P[BASE + 5]), b1 = cvt_pk_bf16(P[BASE + 6], P[BASE + 7]);                              \
    auto r0 = __builtin_amdgcn_permlane32_swap(a0, b0, false, false); auto r1 = __builtin_amdgcn_permlane32_swap(a1, b1, false, false); \
    u32x4 w = {r0[0], r1[0], r0[1], r1[1]}; OUT = __builtin_bit_cast(bf16x8, w); } while (0)
#define ATT_PKN(P, BASE, OUT) do { u32x4 w = {cvt_pk_bf16(P[BASE + 0], P[BASE + 1]), cvt_pk_bf16(P[BASE + 2], P[BASE + 3]), cvt_pk_bf16(P[BASE + 4], P[BASE + 5]), cvt_pk_bf16(P[BASE + 6], P[BASE + 7])}; \
    OUT = __builtin_bit_cast(bf16x8, w); } while (0)
__device__ __forceinline__ void finishSM(f32x16& p0, f32x16& p1, float alpha, float& l_reg, bf16x8& pa0, bf16x8& pa1, bf16x8& pa2, bf16x8& pa3) {
#pragma unroll
    for (int r = 0; r < 16; ++r) p1[r] = EXP_PROBE ? fmaf(p1[r], 0.001f, 1.f) : __builtin_amdgcn_exp2f(p1[r]);
    float ps = 0.f;
#pragma unroll
    for (int r = 0; r < 16; ++r) ps += p0[r];
#pragma unroll
    for (int r = 0; r < 16; ++r) ps += p1[r];
    { auto rr = __builtin_amdgcn_permlane32_swap(__float_as_uint(ps), __float_as_uint(ps), false, false);
      ps = __uint_as_float(rr[0]) + __uint_as_float(rr[1]); }
    l_reg = l_reg * alpha + ps;
    ATT_PKN(p0, 0, pa0); ATT_PKN(p0, 8, pa1); ATT_PKN(p1, 0, pa2); ATT_PKN(p1, 8, pa3);
}
template <int DQK> __device__ __forceinline__ void qkt(f32x16& p0, f32x16& p1, const LAS char* buf, const bf16x8* qr, int r32, int hi, const f32x16& negm) {
#pragma unroll
    for (int d0 = 0; d0 < 4; ++d0) { const int ch = d0 * 2 + hi;
        const bf16x8 b0 = *(const LAS bf16x8*)(buf + B_KN + swz64(r32, ch));
        const bf16x8 b1 = *(const LAS bf16x8*)(buf + B_KN + swz64(32 + r32, ch));
        p0 = __builtin_amdgcn_mfma_f32_32x32x16_bf16(b0, qr[d0], d0 == 0 ? negm : p0, 0, 0, 0);
        p1 = __builtin_amdgcn_mfma_f32_32x32x16_bf16(b1, qr[d0], d0 == 0 ? negm : p1, 0, 0, 0); }
    if constexpr (DQK == 96) {
#pragma unroll
        for (int d0 = 0; d0 < 2; ++d0) { const int ch = d0 * 2 + hi;
            const bf16x8 b0 = *(const LAS bf16x8*)(buf + B_KR + swz32(r32, ch));
            const bf16x8 b1 = *(const LAS bf16x8*)(buf + B_KR + swz32(32 + r32, ch));
            p0 = __builtin_amdgcn_mfma_f32_32x32x16_bf16(b0, qr[4 + d0], p0, 0, 0, 0);
            p1 = __builtin_amdgcn_mfma_f32_32x32x16_bf16(b1, qr[4 + d0], p1, 0, 0, 0); }
    }
}
template <int D0> __device__ __forceinline__ void pv_one(f32x16& od, unsigned vb, bf16x8 pa0, bf16x8 pa1, bf16x8 pa2, bf16x8 pa3) {
    const s16x4 l0 = tr_read<v_rd_off(D0, 0, 0)>(vb), h0 = tr_read<v_rd_off(D0, 0, 1)>(vb), l1 = tr_read<v_rd_off(D0, 1, 0)>(vb), h1 = tr_read<v_rd_off(D0, 1, 1)>(vb);
    const s16x4 l2 = tr_read<v_rd_off(D0, 2, 0)>(vb), h2 = tr_read<v_rd_off(D0, 2, 1)>(vb), l3 = tr_read<v_rd_off(D0, 3, 0)>(vb), h3 = tr_read<v_rd_off(D0, 3, 1)>(vb);
    asm volatile("s_waitcnt lgkmcnt(0)" ::: "memory"); SBAR();
#define ATT_PK(L, H) (bf16x8){L[0], L[1], L[2], L[3], H[0], H[1], H[2], H[3]}
    od = __builtin_amdgcn_mfma_f32_32x32x16_bf16(ATT_PK(l0, h0), pa0, od, 0, 0, 0);
    od = __builtin_amdgcn_mfma_f32_32x32x16_bf16(ATT_PK(l1, h1), pa1, od, 0, 0, 0);
    od = __builtin_amdgcn_mfma_f32_32x32x16_bf16(ATT_PK(l2, h2), pa2, od, 0, 0, 0);
    od = __builtin_amdgcn_mfma_f32_32x32x16_bf16(ATT_PK(l3, h3), pa3, od, 0, 0, 0);
#undef ATT_PK
}

#define ATT_PK(L, H) (bf16x8){L[0], L[1], L[2], L[3], H[0], H[1], H[2], H[3]}
template <bool FIXM> __device__ __forceinline__ void pv_psm(f32x16& o0, f32x16& o1, unsigned vb, bf16x8 pa0, bf16x8 pa1, bf16x8 pa2, bf16x8 pa3,
                                       f32x16& p0, f32x16& p1, float& m_reg, f32x16& negm, float& alpha) {
    { const s16x4 l0 = tr_read<v_rd_off(0, 0, 0)>(vb), h0 = tr_read<v_rd_off(0, 0, 1)>(vb), l1 = tr_read<v_rd_off(0, 1, 0)>(vb), h1 = tr_read<v_rd_off(0, 1, 1)>(vb);
      const s16x4 l2 = tr_read<v_rd_off(0, 2, 0)>(vb), h2 = tr_read<v_rd_off(0, 2, 1)>(vb), l3 = tr_read<v_rd_off(0, 3, 0)>(vb), h3 = tr_read<v_rd_off(0, 3, 1)>(vb);
      float pmax = 0.f; SBAR(); if (!FIXM) pmax = psm_max(p0, p1); else { _Pragma("unroll") for (int r = 0; r < 8; ++r) p0[r] = __builtin_amdgcn_exp2f(p0[r]); } SBAR();
      asm volatile("s_waitcnt lgkmcnt(0)" ::: "memory"); SBAR();
      o0 = __builtin_amdgcn_mfma_f32_32x32x16_bf16(ATT_PK(l0, h0), pa0, o0, 0, 0, 0);
      o0 = __builtin_amdgcn_mfma_f32_32x32x16_bf16(ATT_PK(l1, h1), pa1, o0, 0, 0, 0);
      o0 = __builtin_amdgcn_mfma_f32_32x32x16_bf16(ATT_PK(l2, h2), pa2, o0, 0, 0, 0);
      o0 = __builtin_amdgcn_mfma_f32_32x32x16_bf16(ATT_PK(l3, h3), pa3, o0, 0, 0, 0);
      SBAR();
      const s16x4 m0 = tr_read<v_rd_off(1, 0, 0)>(vb), n0 = tr_read<v_rd_off(1, 0, 1)>(vb), m1 = tr_read<v_rd_off(1, 1, 0)>(vb), n1 = tr_read<v_rd_off(1, 1, 1)>(vb);
      const s16x4 m2 = tr_read<v_rd_off(1, 2, 0)>(vb), n2 = tr_read<v_rd_off(1, 2, 1)>(vb), m3 = tr_read<v_rd_off(1, 3, 0)>(vb), n3 = tr_read<v_rd_off(1, 3, 1)>(vb);
      SBAR(); if (!FIXM) psm_apply<false>(p0, p1, pmax, m_reg, negm, alpha); else { alpha = 1.f; _Pragma("unroll") for (int r = 8; r < 16; ++r) p0[r] = __builtin_amdgcn_exp2f(p0[r]); } SBAR();
      asm volatile("s_waitcnt lgkmcnt(0)" ::: "memory"); SBAR();
      o1 = __builtin_amdgcn_mfma_f32_32x32x16_bf16(ATT_PK(m0, n0), pa0, o1, 0, 0, 0);
      o1 = __builtin_amdgcn_mfma_f32_32x32x16_bf16(ATT_PK(m1, n1), pa1, o1, 0, 0, 0);
      o1 = __builtin_amdgcn_mfma_f32_32x32x16_bf16(ATT_PK(m2, n2), pa2, o1, 0, 0, 0);
      o1 = __builtin_amdgcn_mfma_f32_32x32x16_bf16(ATT_PK(m3, n3), pa3, o1, 0, 0, 0); }
}
#undef ATT_PK
template <int DQK, bool FIXM>
__device__ __forceinline__ void attn_unit(const bf16_t* __restrict__ Qp, int ldq, const bf16_t* __restrict__ Knp, int ldk, const bf16_t* __restrict__ Krp,
                                          const bf16_t* __restrict__ Vp, int ldv, bf16_t* __restrict__ Op, int lat0, int nlt, int ctx0, int NT, LAS char* lds, const int tid, const f32x2* rope, int qtok0, float mfix) {
    constexpr int NQ = DQK / 16;
    const int wid = tid >> 6, lane = tid & 63, r32 = lane & 31, hi = lane >> 5;
    float m_reg = 0.f, l_reg = 0.f; f32x16 o0 = {}, o1 = {}, negm = {}; bf16x8 qr[NQ];
    if (FIXM) { _Pragma("unroll") for (int r = 0; r < 16; ++r) negm[r] = -mfix; }
    const bf16_t* Qw = Qp + (size_t)(wid * 32 + r32) * ldq + hi * 8;
#pragma unroll
    for (int d0 = 0; d0 < NQ; ++d0) qr[d0] = *(const bf16x8*)(Qw + d0 * 16);
    if constexpr (DQK == 96) { if (qtok0 >= 0) {
        const int t = qtok0 + wid * 32 + r32, gr = t >> 6, gc = t & 63;
#pragma unroll
        for (int e = 0; e < 2; ++e) { const f32x2* tp = (e == 0) ? rope + gr * 8 + hi * 4 : rope + 2048 + gc * 8 + hi * 4;
            const f32x4 cs0 = *(const f32x4*)tp, cs1 = *(const f32x4*)(tp + 2);
            const u32x4 w = __builtin_bit_cast(u32x4, qr[4 + e]); u32x4 o;
            { const float x1 = bf16lo(w.x), x2 = bf16hi(w.x); o.x = cvt_pk_bf16(x1 * cs0[0] - x2 * cs0[1], x1 * cs0[1] + x2 * cs0[0]); }
            { const float x1 = bf16lo(w.y), x2 = bf16hi(w.y); o.y = cvt_pk_bf16(x1 * cs0[2] - x2 * cs0[3], x1 * cs0[3] + x2 * cs0[2]); }
            { const float x1 = bf16lo(w.z), x2 = bf16hi(w.z); o.z = cvt_pk_bf16(x1 * cs1[0] - x2 * cs1[1], x1 * cs1[1] + x2 * cs1[0]); }
            { const float x1 = bf16lo(w.w), x2 = bf16hi(w.w); o.w = cvt_pk_bf16(x1 * cs1[2] - x2 * cs1[3], x1 * cs1[3] + x2 * cs1[2]); }
            qr[4 + e] = __builtin_bit_cast(bf16x8, o); } } }
    const int sr = tid >> 3, c8 = tid & 7, sr2 = (tid >> 2) & 63, c4 = tid & 3;
    const bool krw = (DQK == 96) && (tid < 256);
    const int kn_st = B_KN + swz64(sr, c8), v_stw = B_V + v_st(sr, c8 * 8), kr_st = B_KR + swz32(sr2, c4);
    const unsigned vb0 = (unsigned)(uintptr_t)lds + B_V + v_rd_base(lane);
    bf16x8 skn[2], sv[2], skr[2];
#define KROW(j) ((j) < nlt ? lat0 + 64 * (j) : ctx0 + 64 * ((j) - nlt))
#define SLOAD(i, j) do { const int _row = KROW(j); skn[i] = *(const bf16x8*)(Knp + (size_t)(_row + sr) * ldk + c8 * 8); sv[i] = *(const bf16x8*)(Vp + (size_t)(_row + sr) * ldv + c8 * 8); \
        if (krw) skr[i] = *(const bf16x8*)(Krp + (size_t)(_row + sr2) * 32 + c4 * 8); } while (0)
#define SWRITE(b, i) do { *(LAS bf16x8*)(lds + (b) * BUF + kn_st) = skn[i]; *(LAS bf16x8*)(lds + (b) * BUF + v_stw) = sv[i]; if (krw) *(LAS bf16x8*)(lds + (b) * BUF + kr_st) = skr[i]; } while (0)
#define SWRITEO(boff, i) do { *(LAS bf16x8*)(lds + (boff) + kn_st) = skn[i]; *(LAS bf16x8*)(lds + (boff) + v_stw) = sv[i]; if (krw) *(LAS bf16x8*)(lds + (boff) + kr_st) = skr[i]; } while (0)
#define PVO(boff) do { pv_one<0>(o0, vb0 + (boff), pa0, pa1, pa2, pa3); pv_one<1>(o1, vb0 + (boff), pa0, pa1, pa2, pa3); } while (0)
#define SWAIT() asm volatile("s_waitcnt vmcnt(2)" ::: "memory")
#define RESC(a) do { if (__any((a) < 1.f)) { _Pragma("unroll") for (int r = 0; r < 16; ++r) { o0[r] *= (a); o1[r] *= (a); } } } while (0)
#define PV(bufi) do { pv_one<0>(o0, vb0 + (bufi) * BUF, pa0, pa1, pa2, pa3); pv_one<1>(o1, vb0 + (bufi) * BUF, pa0, pa1, pa2, pa3); } while (0)
    f32x16 pA0, pA1, pB0, pB1; float alA, alB; bf16x8 pa0, pa1, pa2, pa3;
    int bV = 0, bK = BUF, bW = 2 * BUF;
#define ROT() do { const int _t = bV; bV = bK; bK = bW; bW = _t; } while (0)
    __syncthreads();
    SLOAD(0, 0); asm volatile("s_waitcnt vmcnt(0)" ::: "memory"); SWRITE(0, 0);
    SLOAD(1, 1); if (2 < NT) SLOAD(0, 2);
    __syncthreads();
    qkt<DQK>(pA0, pA1, lds, qr, r32, hi, negm);
    if (FIXM) { alA = 1.f; _Pragma("unroll") for (int r = 0; r < 16; ++r) pA0[r] = __builtin_amdgcn_exp2f(pA0[r]); } else partialSM<true>(pA0, pA1, m_reg, negm, alA);
    SWAIT(); SWRITEO(BUF, 1);
    for (int j = 1; j + 1 < NT; j += 2) {
        if (!NOBAR_PROBE) __syncthreads();
        SBAR(); qkt<DQK>(pB0, pB1, lds + bK, qr, r32, hi, negm);
        finishSM(pA0, pA1, alA, l_reg, pa0, pa1, pa2, pa3); SBAR();
        SLOAD(1, j + 2); SBAR();
        if constexpr (FIXM) pv_psm<true>(o0, o1, vb0 + bV, pa0, pa1, pa2, pa3, pB0, pB1, m_reg, negm, alB); else { PVO(bV); partialSM<false>(pB0, pB1, m_reg, negm, alB); }
        SWAIT(); SWRITEO(bW, 0);
        if (!FIXM) RESC(alB); ROT();
        if (!NOBAR_PROBE) __syncthreads();
        SBAR(); qkt<DQK>(pA0, pA1, lds + bK, qr, r32, hi, negm);
        finishSM(pB0, pB1, alB, l_reg, pa0, pa1, pa2, pa3); SBAR();
        if (j + 3 < NT) SLOAD(0, j + 3); SBAR();
        if constexpr (FIXM) pv_psm<true>(o0, o1, vb0 + bV, pa0, pa1, pa2, pa3, pA0, pA1, m_reg, negm, alA); else { PVO(bV); partialSM<false>(pA0, pA1, m_reg, negm, alA); }
        SWAIT(); SWRITEO(bW, 1);
        if (!FIXM) RESC(alA); ROT();
    }
    __syncthreads();
    SBAR(); qkt<DQK>(pB0, pB1, lds + bK, qr, r32, hi, negm);
    finishSM(pA0, pA1, alA, l_reg, pa0, pa1, pa2, pa3); SBAR();
    if constexpr (FIXM) pv_psm<true>(o0, o1, vb0 + bV, pa0, pa1, pa2, pa3, pB0, pB1, m_reg, negm, alB); else { PVO(bV); partialSM<false>(pB0, pB1, m_reg, negm, alB); }
    if (!FIXM) RESC(alB);
    finishSM(pB0, pB1, alB, l_reg, pa0, pa1, pa2, pa3); SBAR();
    PVO(bK);
#undef ROT
    const float inv = __builtin_amdgcn_rcpf(l_reg);
    bf16_t* Ow = Op + (size_t)(wid * 32 + r32) * 1024 + 4 * hi;
#pragma unroll
    for (int g = 0; g < 4; ++g) {
        u32x2 w0, w1;
        w0.x = cvt_pk_bf16(o0[4 * g] * inv, o0[4 * g + 1] * inv); w0.y = cvt_pk_bf16(o0[4 * g + 2] * inv, o0[4 * g + 3] * inv);
        w1.x = cvt_pk_bf16(o1[4 * g] * inv, o1[4 * g + 1] * inv); w1.y = cvt_pk_bf16(o1[4 * g + 2] * inv, o1[4 * g + 3] * inv);
        *(u32x2*)(Ow + 8 * g) = w0; *(u32x2*)(Ow + 32 + 8 * g) = w1;
    }
#undef KROW
#undef SLOAD
#undef SWRITE
#undef SWAIT
#undef SWRITEO
#undef PVO
#undef RESC
#undef PV
}
}

__device__ __forceinline__ void attn_phase(Frame& F, int li) {
    const bf16_t* QA = (const bf16_t*)(F.ws + R_QA); const bf16_t* KVA = (const bf16_t*)(F.ws + R_KVA); const bf16_t* KR = (const bf16_t*)(F.ws + R_KR);
    const bf16_t* QB = (const bf16_t*)(F.ws + R_QB); const bf16_t* KB = (const bf16_t*)(F.ws + R_KB); const bf16_t* VB = (const bf16_t*)(F.ws + R_VB);
    bf16_t* O = (bf16_t*)(F.ws + R_O);
    LAS char* lds = (LAS char*)F.lds;
    float mfixB; { float gq = 0.f, gk = 0.f; const float* a = F.in[15] + li * 64; const float* b = F.in[16] + li * 64;
        for (int i = 0; i < 64; ++i) { gq = fmaxf(gq, fabsf(a[i])); gk = fmaxf(gk, fabsf(b[i])); } mfixB = 64.f * gq * gk * SC_B * 1.02f; }
    constexpr int NU = 2048 + 32;
    for (int u = F.vcu; u < NU; u += F.G) {
        if (u < 1024 || (u >= 2048 && u < 2064)) {
            const bool isctx = u >= 2048; const int uu = isctx ? u - 2048 : u;
            const int b = isctx ? (uu >> 3) : (uu >> 9), h = isctx ? (uu & 7) : ((uu >> 6) & 7), qb = uu & 63;
            const int q0 = isctx ? NLAT + b * CTXL : b * SEQ + qb * 256;
            att::attn_unit<96, false>(QA + (size_t)q0 * 768 + h * 96, 768, KVA + h * 128, 1024, KR, KVA + h * 128 + 64, 1024, O + (size_t)q0 * 1024 + h * 64,
                               b * SEQ, isctx ? 0 : 256, NLAT + b * CTXL, isctx ? 4 : 260, lds, F.tid, (const f32x2*)(F.ws + WS_ROPE), isctx ? -1 : qb * 256, 0.f);
        } else {
            const bool isctx = u >= 2064; const int uu = isctx ? u - 2064 : u - 1024;
            const int b = isctx ? (uu >> 3) : (uu >> 9), h = isctx ? (uu & 7) : ((uu >> 6) & 7), qb = uu & 63, kvh = h >> 2;
            const int q0 = isctx ? NLAT + b * CTXL : b * SEQ + qb * 256;
            att::attn_unit<64, true>(QB + (size_t)q0 * 512 + h * 64, 512, KB + kvh * 64, 128, nullptr, VB + kvh * 64, 128, O + (size_t)q0 * 1024 + 512 + h * 64,
                               b * SEQ, isctx ? 0 : 256, NLAT + b * CTXL, isctx ? 4 : 260, lds, F.tid, nullptr, -1, mfixB);
        }
    }
}

namespace na {
constexpr int TABH = 528;
constexpr int L_KC = 0, L_VC = 32768, VC_LD = 528, L_TAB = L_VC + 64 * VC_LD, L_END = L_TAB + TABH * 4;
struct Tile { bf16x8 kf[4]; bf16x8 vf[2][2]; };
__device__ __forceinline__ void load_tile(Tile& T, const bf16_t* kbase, const bf16_t* vbase, size_t vld, int r32, int hi) {
#pragma unroll
    for (int d0 = 0; d0 < 4; ++d0) T.kf[d0] = *(const bf16x8*)(kbase + (size_t)r32 * 2048 + d0 * 16 + hi * 8);
#pragma unroll
    for (int dv = 0; dv < 2; ++dv)
#pragma unroll
        for (int ks = 0; ks < 2; ++ks) T.vf[dv][ks] = *(const bf16x8*)(vbase + (size_t)(32 * dv + r32) * vld + 16 * ks + 8 * hi);
}
__device__ __forceinline__ void load_tile_lds(Tile& T, const LAS char* lds, int t, int r32, int hi) {
#pragma unroll
    for (int d0 = 0; d0 < 4; ++d0) T.kf[d0] = *(const LAS bf16x8*)(lds + L_KC + att::swz64(32 * t + r32, d0 * 2 + hi));
#pragma unroll
    for (int dv = 0; dv < 2; ++dv)
#pragma unroll
        for (int ks = 0; ks < 2; ++ks) T.vf[dv][ks] = *(const LAS bf16x8*)(lds + L_VC + (32 * dv + r32) * VC_LD + (32 * t + 16 * ks + 8 * hi) * 2);
}
constexpr int L_WST = L_END, WST_K = 0, WST_V = 4096, WST_VLD = 80, WST_BYTES = 4096 + 64 * 80;
struct RawTile { bf16x8 k[4], v[4]; };
__device__ __forceinline__ void load_raw(RawTile& T, const bf16_t* kbase, const bf16_t* vbase, int lane) {
#pragma unroll
    for (int i = 0; i < 4; ++i) { T.k[i] = *(const bf16x8*)(kbase + (size_t)(i * 8 + (lane >> 3)) * 2048 + (lane & 7) * 8);
                                  T.v[i] = *(const bf16x8*)(vbase + (size_t)(i * 16 + (lane >> 2)) * SEQ + (lane & 3) * 8); }
}
__device__ __forceinline__ void stage_raw(const RawTile& T, LAS char* w, int lane) {
#pragma unroll
    for (int i = 0; i < 4; ++i) { *(LAS bf16x8*)(w + WST_K + att::swz64(i * 8 + (lane >> 3), lane & 7)) = T.k[i];
                                  *(LAS bf16x8*)(w + WST_V + (i * 16 + (lane >> 2)) * WST_VLD + (lane & 3) * 16) = T.v[i]; }
}
__device__ __forceinline__ void load_tile_wst(Tile& T, const LAS char* w, int r32, int hi) {
#pragma unroll
    for (int d0 = 0; d0 < 4; ++d0) T.kf[d0] = *(const LAS bf16x8*)(w + WST_K + att::swz64(r32, d0 * 2 + hi));
#pragma unroll
    for (int dv = 0; dv < 2; ++dv)
#pragma unroll
        for (int ks = 0; ks < 2; ++ks) T.vf[dv][ks] = *(const LAS bf16x8*)(w + WST_V + (32 * dv + r32) * WST_VLD + (16 * ks + 8 * hi) * 2);
}
template <bool NBR> __device__ __forceinline__ void tile_step(const Tile& cur, const bf16x8 (&qr)[4], float& m_reg, float& l_reg, f32x16& o0, f32x16& o1,
                                                              bool vr, int dlt, const LAS float* tr, int hi) {
    f32x16 p = {};
#pragma unroll
    for (int d0 = 0; d0 < 4; ++d0) p = __builtin_amdgcn_mfma_f32_32x32x16_bf16(cur.kf[d0], qr[d0], p, 0, 0, 0);
    if (NBR) {
#pragma unroll
        for (int r = 0; r < 16; ++r) { const int kcl = (r & 3) + 8 * (r >> 2) + 4 * hi;
            const bool ok = vr && (kcl >= dlt) && (kcl < dlt + 16);
            p[r] = ok ? p[r] + tr[(r & 3) + 8 * (r >> 2)] : -3.0e38f; }
    }
    float pmax = p[0];
#pragma unroll
    for (int r = 1; r < 16; ++r) pmax = fmaxf(pmax, p[r]);
    { auto rr = __builtin_amdgcn_permlane32_swap(__float_as_uint(pmax), __float_as_uint(pmax), false, false);
      pmax = fmaxf(__uint_as_float(rr[0]), __uint_as_float(rr[1])); }
    if (!__all(pmax - m_reg <= att::THR2)) {
        const float mn = fmaxf(m_reg, pmax), alpha = __builtin_amdgcn_exp2f(m_reg - mn); m_reg = mn; l_reg *= alpha;
#pragma unroll
        for (int r = 0; r < 16; ++r) { o0[r] *= alpha; o1[r] *= alpha; }
    }
    float ps = 0.f;
#pragma unroll
    for (int r = 0; r < 16; ++r) { p[r] = __builtin_amdgcn_exp2f(p[r] - m_reg); ps += p[r]; }
    { auto rr = __builtin_amdgcn_permlane32_swap(__float_as_uint(ps), __float_as_uint(ps), false, false);
      ps = __uint_as_float(rr[0]) + __uint_as_float(rr[1]); }
    l_reg += ps;
    bf16x8 pa0, pa1;
    ATT_PK4(p, 0, pa0); ATT_PK4(p, 8, pa1);
    o0 = __builtin_amdgcn_mfma_f32_32x32x16_bf16(cur.vf[0][0], pa0, o0, 0, 0, 0);
    o0 = __builtin_amdgcn_mfma_f32_32x32x16_bf16(cur.vf[0][1], pa1, o0, 0, 0, 0);
    o1 = __builtin_amdgcn_mfma_f32_32x32x16_bf16(cur.vf[1][0], pa0, o1, 0, 0, 0);
    o1 = __builtin_amdgcn_mfma_f32_32x32x16_bf16(cur.vf[1][1], pa1, o1, 0, 0, 0);
}
__device__ __forceinline__ void store_o(bf16_t* Ow, const f32x16& o0, const f32x16& o1, float inv) {
#pragma unroll
    for (int g = 0; g < 4; ++g) {
        u32x2 w0, w1;
        w0.x = cvt_pk_bf16(o0[4 * g] * inv, o0[4 * g + 1] * inv); w0.y = cvt_pk_bf16(o0[4 * g + 2] * inv, o0[4 * g + 3] * inv);
        w1.x = cvt_pk_bf16(o1[4 * g] * inv, o1[4 * g + 1] * inv); w1.y = cvt_pk_bf16(o1[4 * g + 2] * inv, o1[4 * g + 3] * inv);
        *(u32x2*)(Ow + 8 * g) = w0; *(u32x2*)(Ow + 32 + 8 * g) = w1;
    }
}
__device__ __forceinline__ void na_phase(Frame& F, int li, bool need_ctx) {
    const bf16_t* QK = (const bf16_t*)(F.ws + R_QK); const bf16_t* Vt = (const bf16_t*)(F.ws + R_VT); const bf16_t* Vtc = (const bf16_t*)(F.ws + R_VTC);
    bf16_t* ON = (bf16_t*)(F.ws + R_ON);
    LAS char* lds = (LAS char*)F.lds; LAS float* tab = (LAS float*)(lds + L_TAB);
    const int r32 = F.lane & 31, hi = F.lane >> 5;
    for (int bi = F.vcu; bi < 256; bi += F.G) {
        const int bh = bi >> 3, b = bh >> 4, h = bh & 15, sub = bi & 7;
        __syncthreads();
        { const float* rpb = F.in[19] + ((size_t)li * 16 + h) * 465;
          for (int i = F.tid; i < TABH; i += NTHREADS) { const int j = i - 16; tab[i] = (j >= 0 && j < 465) ? rpb[j] * LOG2E : 0.f; }
          const bf16_t* ksrc = QK + (size_t)(NLAT + b * CTXL) * 2048 + 1024 + h * 64; const bf16_t* vsrc = Vtc + (size_t)(b * 16 + h) * 64 * CTXL;
#pragma unroll
          for (int i = 0; i < 4; ++i) { const int c = F.tid + NTHREADS * i;
              *(LAS bf16x8*)(lds + L_KC + att::swz64(c >> 3, c & 7)) = *(const bf16x8*)(ksrc + (size_t)(c >> 3) * 2048 + (c & 7) * 8);
              *(LAS bf16x8*)(lds + L_VC + (c >> 5) * VC_LD + (c & 31) * 16) = *(const bf16x8*)(vsrc + (size_t)(c >> 5) * CTXL + (c & 31) * 8); } }
        __syncthreads();
        for (int pi = F.wave; pi < 64; pi += NWAVES) {
            const int patch = sub * 64 + pi, R = 2 * (patch >> 2), C = 16 * (patch & 3);
            const int qrow = R + (r32 >> 4), qcol = C + (r32 & 15), mq = b * SEQ + qrow * 64 + qcol;
            const int krow_lo = min(max(R - 4, 0), 248), krow_hi = min(max(R - 3, 0), 248) + 7, nn = krow_hi - krow_lo + 1, kc0 = min(max(C - 8, 0), 32);
            const int rsq = min(max(qrow - 4, 0), 248), dlt = min(max(qcol - 8, 0), 48) - kc0;
            const LAS float* tb = tab + 16 + (kc0 - qcol + 15);
            bf16x8 qr[4];
#pragma unroll
            for (int d0 = 0; d0 < 4; ++d0) qr[d0] = *(const bf16x8*)(QK + (size_t)mq * 2048 + h * 64 + d0 * 16 + hi * 8);
            const bf16_t* kn_base = QK + (size_t)(b * SEQ + krow_lo * 64 + kc0) * 2048 + 1024 + h * 64;
            const bf16_t* vn_base = Vt + (size_t)(b * 16 + h) * 64 * SEQ + krow_lo * 64 + kc0;
            float m_reg = -1e30f, l_reg = 0.f; f32x16 o0 = {}, o1 = {};
            Tile cur; RawTile nb;
            LAS char* wst = lds + L_WST + F.wave * WST_BYTES;
            load_raw(nb, kn_base, vn_base, F.lane);
#pragma unroll 2
            for (int t = 0; t < 8; ++t) { load_tile_lds(cur, lds, t, r32, hi); tile_step<false>(cur, qr, m_reg, l_reg, o0, o1, false, 0, tb, hi); }
            for (int t = 0; t < nn; ++t) {
                stage_raw(nb, wst, F.lane);
                if (t + 1 < nn) load_raw(nb, kn_base + (size_t)(t + 1) * 64 * 2048, vn_base + (t + 1) * 64, F.lane);
                load_tile_wst(cur, wst, r32, hi);
                const int kr = krow_lo + t; const bool vr = (kr >= rsq) && (kr < rsq + 8); const int rt = min(max(kr - qrow + 7, 0), 14);
                tile_step<true>(cur, qr, m_reg, l_reg, o0, o1, vr, dlt, tb + rt * 31 + 4 * hi, hi);
            }
            store_o(ON + (size_t)mq * 1024 + h * 64 + 4 * hi, o0, o1, __builtin_amdgcn_rcpf(l_reg));
        }
    }
    if (need_ctx) {
        for (int it = F.gw; it < 2 * 16 * 8; it += F.NGW) {
            const int bh = it >> 3, b = bh >> 4, h = bh & 15, mq = NLAT + b * CTXL + (it & 7) * 32 + r32;
            bf16x8 qr[4];
#pragma unroll
            for (int d0 = 0; d0 < 4; ++d0) qr[d0] = *(const bf16x8*)(QK + (size_t)mq * 2048 + h * 64 + d0 * 16 + hi * 8);
            const bf16_t* kc_base = QK + (size_t)(NLAT + b * CTXL) * 2048 + 1024 + h * 64; const bf16_t* vc_base = Vtc + (size_t)(b * 16 + h) * 64 * CTXL;
            float m_reg = -1e30f, l_reg = 0.f; f32x16 o0 = {}, o1 = {};
            Tile cur, nxt;
            load_tile(cur, kc_base, vc_base, CTXL, r32, hi);
            for (int t = 0; t < 8; ++t) {
                if (t + 1 < 8) load_tile(nxt, kc_base + (size_t)(t + 1) * 32 * 2048, vc_base + (t + 1) * 32, CTXL, r32, hi);
                tile_step<false>(cur, qr, m_reg, l_reg, o0, o1, false, 0, tab, hi);
                cur = nxt;
            }
            store_o(ON + (size_t)mq * 1024 + h * 64 + 4 * hi, o0, o1, __builtin_amdgcn_rcpf(l_reg));
        }
    }
}
}


__device__ __forceinline__ void dbg_mean_abs(Frame& F, const bf16_t* p, int nrows, int ld, int ncols, int slot) {
    float s = 0.f;
    for (int r = F.gw; r < nrows; r += F.NGW)
        for (int c = F.lane * 8; c < ncols; c += 512) { const u32x4 w = *(const u32x4*)(p + (size_t)r * ld + c);
            s += fabsf(bf16lo(w.x)) + fabsf(bf16hi(w.x)) + fabsf(bf16lo(w.y)) + fabsf(bf16hi(w.y)) + fabsf(bf16lo(w.z)) + fabsf(bf16hi(w.z)) + fabsf(bf16lo(w.w)) + fabsf(bf16hi(w.w)); }
    s = wave_sum(s);
    if (F.lane == 0) atomicAdd((float*)(F.ctl + CW_DBG + slot), s / ((float)nrows * (float)ncols));
}

__device__ __forceinline__ void dbg_ri(Frame& F, int slot) {
    const u32x2* RI = (const u32x2*)(F.ws + R_RI); float s = 0.f;
    for (int r = F.gw * 64 + F.lane; r < 65536; r += F.NGW * 64) { const u32x2 ri = RI[r]; if (ri.x != 0xffffffffu) s += 0.5f + u2f(ri.y); }
    s = wave_sum(s);
    if (F.lane == 0) atomicAdd((float*)(F.ctl + CW_DBG + slot), s / 65536.f);
}

__device__ __forceinline__ void dbg_listw(Frame& F, int slot) {
    const u32x2* listw = (const u32x2*)(F.ws + WS_LIST); float s = 0.f;
    for (int e = 0; e < 32; ++e) { const int c = (int)__hip_atomic_load(F.ctl + CW_CNT + e * 64, RLX_AGENT);
        for (int j = F.gw * 64 + F.lane; j < c; j += F.NGW * 64) s += u2f(listw[(size_t)e * MROWS + j].y); }
    s = wave_sum(s);
    if (F.lane == 0) atomicAdd((float*)(F.ctl + CW_DBG + slot), s / 66560.f);
}

#ifndef DBG_CHECK
#define DBG_CHECK 0
#endif
#if DBG_CHECK
__device__ __forceinline__ unsigned hash_u(unsigned x) { x ^= x >> 16; x *= 0x7feb352du; x ^= x >> 15; x *= 0x846ca68bu; x ^= x >> 16; return x; }
__device__ __forceinline__ float bf2f(bf16_t v) { return u2f((unsigned)v << 16); }
__device__ __forceinline__ void dbg_max(Frame& F, int slot, float err) { if (F.lane == 0) atomicMax(F.ctl + CW_DBG + slot, __builtin_bit_cast(unsigned, err)); }
__device__ __forceinline__ void rope_ref(float& x1, float& x2, int i, int n, int gr, int gc) {
    const int ii = i < n ? i : i - n; const float inv = powf(10000.f, -(float)ii / (float)n), ang = (float)(i < n ? gr : gc) * inv;
    float sn, cs; sincosf(ang, &sn, &cs); const float a = x1 * cs - x2 * sn, b = x1 * sn + x2 * cs; x1 = a; x2 = b;
}
__device__ __forceinline__ void check_gemm(Frame& F, int slot, const bf16_t* A, int lda, const float* W, int K, int N, const bf16_t* C, int ldc, float scale, int M, int ns) {
    float worst = 0.f;
    for (int i = F.gw; i < ns; i += F.NGW) { const unsigned hsh = hash_u(i * 2654435761u + slot); const int row = hsh % (unsigned)M, col = (hsh >> 8) % (unsigned)N;
        float a = 0.f; for (int k = F.lane; k < K; k += 64) a += bf2f(A[(size_t)row * lda + k]) * W[(size_t)k * N + col];
        const float ref = wave_sum(a) * scale, got = bf2f(C[(size_t)row * ldc + col]); worst = fmaxf(worst, fabsf(got - ref) / (0.1f + fabsf(ref))); }
    dbg_max(F, slot, worst);
}
__device__ __forceinline__ void check_out0(Frame& F, int slot, int ns) {
    const float* X = (const float*)(F.ws + WS_X); const bf16_t* O = (const bf16_t*)(F.ws + R_O); const float* W = F.in[10]; const float* mod = (const float*)(F.ws + WS_MOD);
    float worst = 0.f;
    for (int i = F.gw; i < ns; i += F.NGW) { const unsigned hsh = hash_u(i * 2654435761u + slot); const int row = hsh % (unsigned)MROWS, col = (hsh >> 8) & 1023;
        float a = 0.f; for (int k = F.lane; k < 1024; k += 64) a += bf2f(O[(size_t)row * 1024 + k]) * W[(size_t)k * 1024 + col];
        const float xin = row < NLAT ? F.in[0][(size_t)row * 1024 + col] : F.in[2][(size_t)(row - NLAT) * 1024 + col];
        const float g1 = mod[(size_t)row_class(row) * 6144 + 2 * 1024 + col];
        const float ref = xin + g1 * wave_sum(a), got = X[(size_t)row * 1024 + col]; worst = fmaxf(worst, fabsf(got - ref) / (0.1f + fabsf(ref))); }
    dbg_max(F, slot, worst);
}
__device__ __forceinline__ void check_prep(Frame& F, int slot, int li, int ns) {
    const bf16_t* P = (const bf16_t*)(F.ws + R_P);
    const bf16_t* CQN = (const bf16_t*)(F.ws + R_CQN); const bf16_t* CKVN = (const bf16_t*)(F.ws + R_CKVN); const bf16_t* KR = (const bf16_t*)(F.ws + R_KR);
    const bf16_t* QB = (const bf16_t*)(F.ws + R_QB); const bf16_t* KB = (const bf16_t*)(F.ws + R_KB); const bf16_t* VB = (const bf16_t*)(F.ws + R_VB);
    const float* qn = F.in[11] + li * QLORA; const float* kvn = F.in[13] + li * KVLORA; const float* gqn = F.in[15] + li * 64; const float* gkn = F.in[16] + li * 64;
    float worst = 0.f;
#define CHK(got, ref) worst = fmaxf(worst, fabsf(bf2f(got) - (ref)) / (0.1f + fabsf(ref)))
    for (int i = F.gw; i < ns; i += F.NGW) { const unsigned hsh = hash_u(i * 2654435761u + slot); const int m = (i & 7) == 7 ? NLAT + hsh % NCTX : hsh % NLAT;
        const bf16_t* p = P + (size_t)m * AB_INP; const bool lat = m < NLAT; const int t = m & (SEQ - 1), gr = t >> 6, gc = t & 63;
        float s = 0.f; for (int c = F.lane; c < 384; c += 64) { const float v = bf2f(p[c]); s += v * v; }
        const float rq = rsqrtf(wave_sum(s) / 384.f + RMS_EPS);
        for (int c = F.lane; c < 384; c += 64) CHK(CQN[(size_t)m * 384 + c], bf2f(p[c]) * rq * qn[c]);
        s = 0.f; for (int c = F.lane; c < 256; c += 64) { const float v = bf2f(p[384 + c]); s += v * v; }
        const float rk = rsqrtf(wave_sum(s) / 256.f + RMS_EPS);
        for (int c = F.lane; c < 256; c += 64) CHK(CKVN[(size_t)m * 256 + c], bf2f(p[384 + c]) * rk * kvn[c]);
        if (F.lane < 16) { float x1 = bf2f(p[640 + 2 * F.lane]), x2 = bf2f(p[641 + 2 * F.lane]); if (lat) rope_ref(x1, x2, F.lane, 8, gr, gc);
            CHK(KR[(size_t)m * 32 + 2 * F.lane], x1); CHK(KR[(size_t)m * 32 + 2 * F.lane + 1], x2); }
        for (int pr = F.lane; pr < 256; pr += 64) { const int h = pr >> 5, i2 = pr & 31; float ss = 0.f;
            for (int d = 0; d < 64; ++d) { const float v = bf2f(p[672 + h * 64 + d]); ss += v * v; }
            const float r = rsqrtf(ss / 64.f + RMS_EPS);
            float x1 = bf2f(p[672 + h * 64 + 2 * i2]) * r * gqn[2 * i2], x2 = bf2f(p[672 + h * 64 + 2 * i2 + 1]) * r * gqn[2 * i2 + 1]; if (lat) rope_ref(x1, x2, i2, 16, gr, gc);
            CHK(QB[(size_t)m * 512 + h * 64 + 2 * i2], x1 * SC_B); CHK(QB[(size_t)m * 512 + h * 64 + 2 * i2 + 1], x2 * SC_B); }
        { const int h = F.lane >> 5, i2 = F.lane & 31; float ss = 0.f;
            for (int d = 0; d < 64; ++d) { const float v = bf2f(p[1184 + h * 64 + d]); ss += v * v; }
            const float r = rsqrtf(ss / 64.f + RMS_EPS);
            float x1 = bf2f(p[1184 + h * 64 + 2 * i2]) * r * gkn[2 * i2], x2 = bf2f(p[1184 + h * 64 + 2 * i2 + 1]) * r * gkn[2 * i2 + 1]; if (lat) rope_ref(x1, x2, i2, 16, gr, gc);
            CHK(KB[(size_t)m * 128 + h * 64 + 2 * i2], x1); CHK(KB[(size_t)m * 128 + h * 64 + 2 * i2 + 1], x2);
            CHK(VB[(size_t)m * 128 + 2 * F.lane], bf2f(p[1312 + 2 * F.lane])); CHK(VB[(size_t)m * 128 + 2 * F.lane + 1], bf2f(p[1313 + 2 * F.lane])); }
    }
#undef CHK
    dbg_max(F, slot, worst);
}
__device__ __forceinline__ void check_attn(Frame& F, int slot, int type, int ns) {
    const bf16_t* QA = (const bf16_t*)(F.ws + R_QA); const bf16_t* KVA = (const bf16_t*)(F.ws + R_KVA); const bf16_t* KR = (const bf16_t*)(F.ws + R_KR);
    const bf16_t* QB = (const bf16_t*)(F.ws + R_QB); const bf16_t* KB = (const bf16_t*)(F.ws + R_KB); const bf16_t* VB = (const bf16_t*)(F.ws + R_VB);
    const bf16_t* O = (const bf16_t*)(F.ws + R_O);
    LAS float* qs = (LAS float*)(F.lds + F.wave * 512);
    float worst = 0.f;
    for (int i = F.gw; i < ns; i += F.NGW) { const unsigned hsh = hash_u(i * 2654435761u + slot); const bool qctx = (i & 7) == 7;
        const int b = hsh & 1, h = (hsh >> 1) & 7, tq = qctx ? (hsh >> 4) % CTXL : (hsh >> 4) % SEQ, mq = qctx ? NLAT + b * CTXL + tq : b * SEQ + tq;
        const int DQ = type == 0 ? 96 : 64;
        for (int d = F.lane; d < DQ; d += 64) qs[d] = type == 0 ? bf2f(QA[(size_t)mq * 768 + h * 96 + d]) : bf2f(QB[(size_t)mq * 512 + h * 64 + d]);
        LDS_WAIT();
        if (type == 0 && !qctx && F.lane < 16) { float x1 = qs[64 + 2 * F.lane], x2 = qs[65 + 2 * F.lane]; rope_ref(x1, x2, F.lane, 8, tq >> 6, tq & 63); qs[64 + 2 * F.lane] = x1; qs[65 + 2 * F.lane] = x2; }
        LDS_WAIT();
        const int nk = qctx ? CTXL : SEQ + CTXL;
        float mx = -3.0e38f, emax = 0.f, rmax = 0.f;
        for (int pass = 0; pass < 5; ++pass) {
            float l = 0.f, o[16];
#pragma unroll
            for (int d = 0; d < 16; ++d) o[d] = 0.f;
            const int dv0 = (pass - 1) * 16;
            for (int j = F.lane; j < nk; j += 64) { const int kr = (qctx || j >= SEQ) ? NLAT + b * CTXL + (qctx ? j : j - SEQ) : b * SEQ + j;
                float sc = 0.f;
                if (type == 0) { const bf16_t* kp = KVA + (size_t)kr * 1024 + h * 128; const bf16_t* rp = KR + (size_t)kr * 32;
                    for (int d = 0; d < 64; ++d) sc += qs[d] * bf2f(kp[d]); for (int d = 0; d < 32; ++d) sc += qs[64 + d] * bf2f(rp[d]); }
                else { const bf16_t* kp = KB + (size_t)kr * 128 + (h >> 2) * 64; for (int d = 0; d < 64; ++d) sc += qs[d] * bf2f(kp[d]); }
                if (pass == 0) mx = fmaxf(mx, sc);
                else { const float pw = exp2f(sc - mx); l += pw; const bf16_t* vp = (type == 0 ? KVA + (size_t)kr * 1024 + h * 128 + 64 : VB + (size_t)kr * 128 + (h >> 2) * 64) + dv0;
#pragma unroll
                    for (int d = 0; d < 16; ++d) o[d] += pw * bf2f(vp[d]); } }
            if (pass == 0) { for (int s2 = 1; s2 < 64; s2 <<= 1) mx = fmaxf(mx, __shfl_xor(mx, s2)); }
            else { l = wave_sum(l);
#pragma unroll
                for (int d = 0; d < 16; ++d) { const float ref = wave_sum(o[d]) / l, got = bf2f(O[(size_t)mq * 1024 + (type == 0 ? 0 : 512) + h * 64 + dv0 + d]); emax = fmaxf(emax, fabsf(got - ref)); rmax = fmaxf(rmax, fabsf(ref)); } }
        }
        worst = fmaxf(worst, emax / (rmax + 1e-9f));
    }
    dbg_max(F, slot, worst);
}
__device__ __forceinline__ void check_na(Frame& F, int slot, int li, bool need_ctx, int ns) {
    const bf16_t* QK = (const bf16_t*)(F.ws + R_QK); const bf16_t* Vt = (const bf16_t*)(F.ws + R_VT); const bf16_t* Vtc = (const bf16_t*)(F.ws + R_VTC); const bf16_t* ON = (const bf16_t*)(F.ws + R_ON);
    const float* rpb = F.in[19] + (size_t)li * 16 * 465;
    LAS float* qs = (LAS float*)(F.lds + F.wave * 512);
    float worst = 0.f;
    for (int i = F.gw; i < ns; i += F.NGW) { const unsigned hsh = hash_u(i * 2654435761u + slot); const bool qctx = need_ctx && (i & 7) == 7;
        const int b = hsh & 1, h = (hsh >> 1) & 15; int tq = qctx ? (hsh >> 5) % CTXL : (hsh >> 5) % SEQ;
        if (!qctx && (i & 7) == 1) tq = ((hsh >> 5) & 7) * 64 + ((hsh >> 9) & 63) + ((hsh >> 20) & 1) * (SEQ - 512);
        const int mq = qctx ? NLAT + b * CTXL + tq : b * SEQ + tq, r = tq >> 6, c = tq & 63;
        if (F.lane < 64) qs[F.lane] = bf2f(QK[(size_t)mq * 2048 + h * 64 + F.lane]);
        LDS_WAIT();
        const int rs = min(max(r - 4, 0), GRIDH - 8), cs = min(max(c - 8, 0), GRIDW - 16);
        const int nk = qctx ? CTXL : 128 + CTXL;
        float mx = -3.0e38f;
        for (int pass = 0; pass < 2; ++pass) {
            float l = 0.f, o[64];
#pragma unroll
            for (int d = 0; d < 64; ++d) o[d] = 0.f;
            for (int j = F.lane; j < nk; j += 64) { const bool nb = !qctx && j < 128;
                const int kr_ = rs + (j >> 4), kc_ = cs + (j & 15);
                const int krow = nb ? b * SEQ + kr_ * 64 + kc_ : NLAT + b * CTXL + (qctx ? j : j - 128);
                const bf16_t* kp = QK + (size_t)krow * 2048 + 1024 + h * 64; float sc = 0.f;
                for (int d = 0; d < 64; ++d) sc += qs[d] * bf2f(kp[d]);
                if (nb) sc += rpb[h * 465 + (kr_ - r + 7) * 31 + (kc_ - c + 15)] * LOG2E;
                if (pass == 0) mx = fmaxf(mx, sc);
                else { const float pw = exp2f(sc - mx); l += pw;
#pragma unroll
                    for (int d = 0; d < 64; ++d) o[d] += pw * (nb ? bf2f(Vt[((size_t)(b * 16 + h) * 64 + d) * SEQ + kr_ * 64 + kc_]) : bf2f(Vtc[((size_t)(b * 16 + h) * 64 + d) * CTXL + (qctx ? j : j - 128)])); } }
            if (pass == 0) { for (int s2 = 1; s2 < 64; s2 <<= 1) mx = fmaxf(mx, __shfl_xor(mx, s2)); }
            else { l = wave_sum(l); float emax = 0.f, rmax = 0.f;
#pragma unroll
                for (int d = 0; d < 64; ++d) { const float ref = wave_sum(o[d]) / l, got = bf2f(ON[(size_t)mq * 1024 + h * 64 + d]); emax = fmaxf(emax, fabsf(got - ref)); rmax = fmaxf(rmax, fabsf(ref)); }
                worst = fmaxf(worst, emax / (rmax + 1e-9f)); } }
    }
    dbg_max(F, slot, worst);
}
#endif

constexpr int PH_PER_LAYER = 12, NPH = 2 + DEPTH * PH_PER_LAYER;
__global__ void __launch_bounds__(NTHREADS, 2) fwd(Args args) {
    extern __shared__ __attribute__((aligned(16))) unsigned char lds_raw[];
    Frame F;
    F.lds = (LAS unsigned char*)lds_raw; F.ws = args.ws; F.ctl = (unsigned*)(args.ws + WS_CTL); F.in = args.in;
    F.tid = threadIdx.x; F.lane = F.tid & 63; F.wave = __builtin_amdgcn_readfirstlane(F.tid >> 6);
    F.G = gridDim.x; { const int bx = blockIdx.x; F.vcu = (F.G % 8 == 0) ? (bx % 8) * (F.G / 8) + bx / 8 : bx; }
    F.gw = F.vcu * NWAVES + F.wave; F.NGW = F.G * NWAVES;
    volatile LAS unsigned* MISC = (volatile LAS unsigned*)(F.lds + MISC_OFF);
    if (F.tid < 16) MISC[F.tid] = 0u;
    __syncthreads();
    const int lo = args.ph_lo, hi = args.ph_hi;
    XcdBarrier bar; bar.bar = F.ctl + CW_BAR; bar.x = 0; bar.st = MISC;
    if (hi - lo > 1) bar = xcd_barrier_post(F.ctl + CW_BAR, MISC);
#define OPAQUE_V(x) asm volatile("" : "+v"(x))
#define OPAQUE_S(x) asm volatile("" : "+s"(x))
#define PHASE_BEGIN() do { GAS unsigned char* _ws = (GAS unsigned char*)args.ws; OPAQUE_S(_ws); F.ws = (unsigned char*)_ws; F.ctl = (unsigned*)(F.ws + WS_CTL); int _t = threadIdx.x; OPAQUE_V(_t); F.tid = _t; F.lane = _t & 63; \
    F.wave = __builtin_amdgcn_readfirstlane(_t >> 6); int _bx = blockIdx.x; OPAQUE_S(_bx); bx = _bx; F.vcu = (F.G % 8 == 0) ? (_bx % 8) * (F.G / 8) + _bx / 8 : _bx; F.gw = F.vcu * NWAVES + F.wave; \
    mod = (const float*)(F.ws + WS_MOD); } while (0)
#define RUN(k) ((k) >= lo && (k) < hi)
#define SEAM(k) do { if ((k) + 1 < hi) xcd_barrier(bar); } while (0)
    LAS unsigned char* ring = F.lds;
    const float* mod; int bx;

    if (RUN(0)) { PHASE_BEGIN(); if (EN_P0) for (int rep_ = 0; rep_ < REP_P0; ++rep_) { p0_prologue(F); __syncthreads(); } SEAM(0); }


#if DBG_CHECK == 2
#define CHECK_E2(l, li)
#define CHECK_PREP(l, li)
#define CHECK_UP(l, li)
#define CHECK_ATT(l, li) { check_attn(F, 32 + (l), 0, 2048); check_attn(F, 36 + (l), 1, 2048); __syncthreads(); }
#define CHECK_OUT(l, li)
#define CHECK_NA(l, li, nc)
#elif DBG_CHECK
#define CHECK_E2(l, li) { check_gemm(F, 16 + (l), (const bf16_t*)(F.ws + WS_H), 1024, F.in[9] + (size_t)(li) * 1024 * 1440, 1024, 1440, (const bf16_t*)(F.ws + R_P), AB_INP, 1.f, MROWS, 4096); }
#define CHECK_PREP(l, li) { check_prep(F, 20 + (l), li, 2048); }
#define CHECK_UP(l, li) { check_gemm(F, 24 + (l), (const bf16_t*)(F.ws + R_CQN), 384, F.in[12] + (size_t)(li) * 384 * 768, 384, 768, (const bf16_t*)(F.ws + R_QA), 768, SC_A, MROWS, 4096); \
                          check_gemm(F, 28 + (l), (const bf16_t*)(F.ws + R_CKVN), 256, F.in[14] + (size_t)(li) * 256 * 1024, 256, 1024, (const bf16_t*)(F.ws + R_KVA), 1024, 1.f, MROWS, 4096); }
#define CHECK_ATT(l, li) { check_attn(F, 32 + (l), 0, 2048); check_attn(F, 36 + (l), 1, 2048); __syncthreads(); }
#define CHECK_OUT(l, li) { if ((l) == 0) check_out0(F, 40, 4096); }
#define CHECK_NA(l, li, nc) { check_na(F, 44 + (l), li, nc, 4096); __syncthreads(); }
#else
#define CHECK_E2(l, li)
#define CHECK_PREP(l, li)
#define CHECK_UP(l, li)
#define CHECK_ATT(l, li)
#define CHECK_OUT(l, li)
#define CHECK_NA(l, li, nc)
#endif
#define LAYER_BODY(LL) { constexpr int l = (LL); \
        const int pb = 1 + l * PH_PER_LAYER, li = l >> 1; \
        if (RUN(pb)) { PHASE_BEGIN(); if (EN_NORM) mix_norm_phase(F, l); SEAM(pb); } \
        if ((l & 1) == 0) { \
            if (RUN(pb + 1)) { PHASE_BEGIN(); \
                pg8::Gemm g{(const bf16_t*)(F.ws + WS_H), (const bf16_t*)(F.ws + WS_WIN) + (size_t)li * AB_INP * 1024, 1024, 1024}; \
                pg8::StaticOrder S; S.init(MROWS / 256, AB_INP / 256, F.G, bx); \
                EpiStore E{(bf16_t*)(F.ws + R_P), AB_INP}; \
                if (EN_GEMM & 1) { pg8::gemm_phase<EpiStore, pg8::StaticOrder, true>(ring, g, S, E, F.tid); if (REP_IN >= 2) pg8::gemm_phase<EpiStore, pg8::StaticOrder, true>(ring, g, S, E, F.tid); if (REP_IN >= 3) pg8::gemm_phase<EpiStore, pg8::StaticOrder, true>(ring, g, S, E, F.tid); } \
                SEAM(pb + 1); CHECK_E2(l, li) \
            } \
            if (RUN(pb + 2)) { PHASE_BEGIN(); if (EN_PREP) for (int rep_ = 0; rep_ < REP_PREP; ++rep_) ab_prep_phase(F, li); SEAM(pb + 2); CHECK_PREP(l, li) } \
            if (RUN(pb + 3)) { PHASE_BEGIN(); \
                { pg8::Gemm g{(const bf16_t*)(F.ws + R_CQN), (const bf16_t*)(F.ws + WS_WQUP) + (size_t)li * 768 * 384, QLORA, QLORA}; \
                  pg8::StaticOrder S; S.init(MROWS / 256, 3, F.G, bx); \
                  EpiStore E{(bf16_t*)(F.ws + R_QA), 768}; \
                  if (EN_GEMM & 2) { pg8::gemm_phase<EpiStore, pg8::StaticOrder, true>(ring, g, S, E, F.tid); if (REP_UP >= 2) pg8::gemm_phase<EpiStore, pg8::StaticOrder, true>(ring, g, S, E, F.tid); } } \
                { pg8::Gemm g{(const bf16_t*)(F.ws + R_CKVN), (const bf16_t*)(F.ws + WS_WKVUP) + (size_t)li * 1024 * 256, KVLORA, KVLORA}; \
                  pg8::StaticOrder S; S.init(MROWS / 256, 4, F.G, (bx + 134) % F.G); \
                  EpiStore E{(bf16_t*)(F.ws + R_KVA), 1024}; \
                  if (EN_GEMM & 4) { pg8::gemm_phase<EpiStore, pg8::StaticOrder, true>(ring, g, S, E, F.tid); if (REP_UP >= 2) pg8::gemm_phase<EpiStore, pg8::StaticOrder, true>(ring, g, S, E, F.tid); } } \
                SEAM(pb + 3); CHECK_UP(l, li) \
            } \
            if (RUN(pb + 4)) { PHASE_BEGIN(); if (EN_ATT) for (int rep_ = 0; rep_ < REP_ATT; ++rep_) { attn_phase(F, li); if (rep_ + 1 < REP_ATT) __syncthreads(); } SEAM(pb + 4); CHECK_ATT(l, li) } \
            if (RUN(pb + 5)) { PHASE_BEGIN(); \
                pg8::Gemm g{(const bf16_t*)(F.ws + R_O), (const bf16_t*)(F.ws + WS_WOUT) + (size_t)li * 1024 * 1024, 1024, 1024}; \
                pg8::StaticOrder S; S.init(MROWS / 256, 4, F.G, bx); \
                EpiOut E{(float*)(F.ws + WS_X), mod + (size_t)l * 3 * 6144, l == 0 ? F.in[0] : (const float*)(F.ws + WS_X), l == 0 ? F.in[2] : (const float*)(F.ws + WS_X) + (size_t)NLAT * 1024}; \
                if (EN_GEMM & 8) pg8::gemm_phase<EpiOut, pg8::StaticOrder, true>(ring, g, S, E, F.tid); \
                SEAM(pb + 5); CHECK_OUT(l, li) \
            } \
        } else { \
            const bool last = (l == DEPTH - 1); \
            if (RUN(pb + 1)) { PHASE_BEGIN(); \
                pg8::Gemm g{(const bf16_t*)(F.ws + WS_H), (const bf16_t*)(F.ws + WS_NIN) + (size_t)li * 3072 * 1024, 1024, 1024}; \
                pg8::StaticOrder S; S.init(MROWS / 256, 12, F.G, bx); \
                EpiNaIn E{(bf16_t*)(F.ws + R_QK), (bf16_t*)(F.ws + R_VT), (bf16_t*)(F.ws + R_VTC)}; \
                if (EN_GEMM & 16) { pg8::gemm_phase<EpiNaIn, pg8::StaticOrder, true>(ring, g, S, E, F.tid); if (REP_IN >= 2) pg8::gemm_phase<EpiNaIn, pg8::StaticOrder, true>(ring, g, S, E, F.tid); if (REP_IN >= 3) pg8::gemm_phase<EpiNaIn, pg8::StaticOrder, true>(ring, g, S, E, F.tid); } \
                SEAM(pb + 1); \
            } \
            if (RUN(pb + 4)) { PHASE_BEGIN(); if (EN_NA) for (int rep_ = 0; rep_ < REP_NA; ++rep_) { na::na_phase(F, li, !last); if (rep_ + 1 < REP_NA) __syncthreads(); } SEAM(pb + 4); CHECK_NA(l, li, !last) } \
            if (RUN(pb + 5)) { PHASE_BEGIN(); \
                pg8::Gemm g{(const bf16_t*)(F.ws + R_ON), (const bf16_t*)(F.ws + WS_NOUT) + (size_t)li * 1024 * 1024, 1024, 1024}; \
                pg8::StaticOrder S; S.init((last ? NLAT : MROWS) / 256, 4, F.G, bx); \
                EpiOut E{(float*)(F.ws + WS_X), mod + (size_t)l * 3 * 6144, (const float*)(F.ws + WS_X), (const float*)(F.ws + WS_X) + (size_t)NLAT * 1024}; \
                if (EN_GEMM & 32) pg8::gemm_phase<EpiOut, pg8::StaticOrder, true>(ring, g, S, E, F.tid); \
                SEAM(pb + 5); \
            } \
        } \
        if (RUN(pb + 6)) { PHASE_BEGIN(); if (EN_ROUTE) ffn_norm_route_phase(F, l); SEAM(pb + 6); } \
                if (RUN(pb + 8)) { PHASE_BEGIN(); \
            moe_tile_map(F, l); \
            if (DBG_SEL == 0 && l == 0 && blockIdx.x == 0 && F.tid == 0) F.ctl[CW_DBG + 0] = __builtin_bit_cast(unsigned, 0.001f * (float)*(const LAS int*)(F.lds + MOE_NT_OFF)); \
            pg8::Gemm g{(const bf16_t*)(F.ws + WS_H), (const bf16_t*)(F.ws + WS_MOEW + (size_t)l * MOEW_LAYER), 1024, 1024}; \
            pg8::MoeGatherOrder S; S.tile_e = (const LAS int*)(F.lds + TILE_E_OFF); S.nT = *(const LAS int*)(F.lds + MOE_NT_OFF); S.G = F.G; S.c = bx; S.estride = (size_t)1024 * 1024; \
            S.lcnt = (const LAS int*)(F.lds + CNTL_OFF); S.lbase = S.lcnt + 32; S.list = (const u32x2*)(F.ws + WS_LIST); \
            EpiMoe1 E{(bf16_t*)(F.ws + R_ACT)}; \
            if (EN_GEMM & 64) { pg8::gemm_phase<EpiMoe1, pg8::MoeGatherOrder, true>(ring, g, S, E, F.tid); if (REP_MOE >= 2) pg8::gemm_phase<EpiMoe1, pg8::MoeGatherOrder, true>(ring, g, S, E, F.tid); if (REP_MOE >= 3) pg8::gemm_phase<EpiMoe1, pg8::MoeGatherOrder, true>(ring, g, S, E, F.tid); } \
            SEAM(pb + 8); if (DBG_SEL == 2 && l == 0) dbg_mean_abs(F, (const bf16_t*)(F.ws + R_ACT), 65536, 512, 512, 2); \
        } \
        if (RUN(pb + 9)) { PHASE_BEGIN(); \
            moe_tile_map(F, l); \
            pg8::Gemm g{(const bf16_t*)(F.ws + R_ACT), (const bf16_t*)(F.ws + WS_MOEW + (size_t)l * MOEW_LAYER + MOEW_DN), 512, 512}; \
            pg8::MoeOrder S{(const LAS int*)(F.lds + TILE_E_OFF), *(const LAS int*)(F.lds + MOE_NT_OFF), F.G, bx, (size_t)1024 * 512}; \
            EpiMoe2 E{(bf16_t*)(F.ws + R_Y), (const LAS int*)(F.lds + TILE_E_OFF), (const LAS int*)(F.lds + CNTL_OFF), (const LAS int*)(F.lds + CNTL_OFF) + 32, (const u32x2*)(F.ws + WS_LIST)}; if (DBG_SEL == 4 && l == 0) dbg_ri(F, 4); if (DBG_SEL == 6 && l == 0) dbg_listw(F, 6); if (DBG_SEL == 5 && l == 0) dbg_mean_abs(F, (const bf16_t*)(F.ws + WS_MOEW + MOEW_DN), 32768, 512, 512, 5); \
            if (EN_GEMM & 128) { pg8::gemm_phase<EpiMoe2, pg8::MoeOrder, true>(ring, g, S, E, F.tid); if (REP_MOE >= 2) pg8::gemm_phase<EpiMoe2, pg8::MoeOrder, true>(ring, g, S, E, F.tid); if (REP_MOE >= 3) pg8::gemm_phase<EpiMoe2, pg8::MoeOrder, true>(ring, g, S, E, F.tid); } \
            SEAM(pb + 9); if (DBG_SEL == 1 && l == 0) dbg_mean_abs(F, (const bf16_t*)(F.ws + R_Y), 65536, 1024, 1024, 1); \
        } \
    }
    LAYER_BODY(0)
    LAYER_BODY(1)
    LAYER_BODY(2)
    LAYER_BODY(3)
#undef LAYER_BODY
    if (RUN(NPH - 1)) { PHASE_BEGIN(); if (EN_FINAL) final_phase(F, args.out); }
#undef RUN
#undef SEAM
}

extern "C" void kernel_launch(void* const* d_in, const int* in_sizes, int n_in, void* d_out, int out_size, void* d_ws, size_t ws_size, hipStream_t stream) {
    static int grid = 0;
    if (grid == 0) {
        if (n_in != 27 || out_size != NLAT * DM || ws_size < WS_END) { fprintf(stderr, "kernel_launch: unexpected shapes: n_in %d out %d ws %zu (need %zu)\n", n_in, out_size, ws_size, (size_t)WS_END); grid = -1; return; }
        int dev = 0, cus = 0, per_cu = 0;
        if (hipGetDevice(&dev) != hipSuccess || hipDeviceGetAttribute(&cus, hipDeviceAttributeMultiprocessorCount, dev) != hipSuccess) { grid = -1; return; }
        if (hipFuncSetAttribute((const void*)fwd, hipFuncAttributeMaxDynamicSharedMemorySize, LDS_BYTES) != hipSuccess) { fprintf(stderr, "kernel_launch: hipFuncSetAttribute failed\n"); grid = -1; return; }
        if (hipOccupancyMaxActiveBlocksPerMultiprocessor(&per_cu, (const void*)fwd, NTHREADS, LDS_BYTES) != hipSuccess || per_cu < 1)
            fprintf(stderr, "kernel_launch: occupancy query reports %d workgroups per CU\n", per_cu);
        (void)hipGetLastError();
        grid = cus;
    }
    if (grid < 0) return;
    if (hipMemsetAsync((char*)d_ws + WS_CTL, 0, CTL_ZERO_BYTES, stream) != hipSuccess) return;
    Args a{};
    for (int i = 0; i < 27; ++i) a.in[i] = (const float*)d_in[i];
    a.out = (float*)d_out; a.ws = (unsigned char*)d_ws;
#if MK_PER_PHASE
    for (int p = 0; p < NPH; ++p) { a.ph_lo = p; a.ph_hi = p + 1; hipLaunchKernelGGL(fwd, dim3(grid), dim3(NTHREADS), LDS_BYTES, stream, a); }
#else
    a.ph_lo = 0; a.ph_hi = NPH;
    hipLaunchKernelGGL(fwd, dim3(grid), dim3(NTHREADS), LDS_BYTES, stream, a);
#endif
    const hipError_t le = hipPeekAtLastError();
    if (le != hipSuccess) fprintf(stderr, "kernel_launch: launch failed: %s\n", hipGetErrorName(le));
}
```

```cpp
#include <hip/hip_runtime.h>
#include <cstdio>
#include <cstdint>

#ifndef MK_PER_PHASE
#define MK_PER_PHASE 0
#endif


#ifndef EN_P0
#define EN_P0 1
#endif
#ifndef EN_NORM
#define EN_NORM 1
#endif
#ifndef EN_PREP
#define EN_PREP 1
#endif
#ifndef EN_ATT
#define EN_ATT 1
#endif
#ifndef EN_NA
#define EN_NA 1
#endif
#ifndef EN_ROUTE
#define EN_ROUTE 1
#endif
#ifndef EN_GATHER
#define EN_GATHER 1
#endif
#ifndef EN_FINAL
#define EN_FINAL 1
#endif
#ifndef EN_GEMM
#define EN_GEMM 255
#endif
#ifndef REP_PREP
#define REP_PREP 1
#endif
#ifndef REP_GATHER
#define REP_GATHER 1
#endif
#ifndef REP_UP
#define REP_UP 1
#endif
#ifndef REP_ATT
#define REP_ATT 1
#endif
#ifndef REP_NA
#define REP_NA 1
#endif
#ifndef REP_P0
#define REP_P0 1
#endif
#ifndef REP_MOE
#define REP_MOE 1
#endif
#ifndef REP_IN
#define REP_IN 1
#endif
#ifndef NOBAR_PROBE
#define NOBAR_PROBE 0
#endif
#ifndef EXP_PROBE
#define EXP_PROBE 0
#endif
#ifndef DBG_SEL
#define DBG_SEL -1
#endif
#ifndef W_CONST
#define W_CONST 0.f
#endif
#ifndef MOE_ALPHA
#define MOE_ALPHA 1.f
#endif
#define GAS __attribute__((address_space(1)))
#define LAS __attribute__((address_space(3)))
typedef unsigned short bf16_t;
typedef short bf16x8 __attribute__((ext_vector_type(8)));
typedef short s16x4 __attribute__((ext_vector_type(4)));
typedef float f32x4 __attribute__((ext_vector_type(4)));
typedef float f32x2 __attribute__((ext_vector_type(2)));
typedef float f32x16 __attribute__((ext_vector_type(16)));
typedef unsigned u32x4 __attribute__((ext_vector_type(4)));
typedef unsigned u32x2 __attribute__((ext_vector_type(2)));

constexpr int DM = 1024, SEQ = 16384, NLAT = 32768, CTXL = 256, NCTX = 512, MROWS = NLAT + NCTX;
constexpr int DEPTH = 4, GRIDW = 64, GRIDH = 256;
constexpr int AB_IN = 1440, AB_INP = 1536, QLORA = 384, KVLORA = 256;
constexpr int NEXP = 32, DEXP = 512;
constexpr float LOG2E = 1.4426950408889634f;
constexpr float SC_A = 0.10206207261596577f * LOG2E;
constexpr float SC_B = 0.125f * LOG2E;
constexpr float RMS_EPS = 1e-6f;
constexpr int NWAVES = 8, NTHREADS = 512;

constexpr size_t MiB = 1u << 20;
constexpr size_t WS_CTL = 0, CTL_ZERO_BYTES = 1 * MiB;
constexpr size_t WS_MOD = 1 * MiB;
constexpr size_t WS_ROPE = WS_MOD + 512 * 1024;
constexpr size_t WS_WIN = 2 * MiB;
constexpr size_t WS_WQUP = 8 * MiB;
constexpr size_t WS_WKVUP = 10 * MiB;
constexpr size_t WS_WOUT = 11 * MiB;
constexpr size_t WS_NIN = 15 * MiB;
constexpr size_t WS_NOUT = 27 * MiB;
constexpr size_t WS_LIST = 31 * MiB;
constexpr size_t WS_X = 41 * MiB;
constexpr size_t WS_H = 171 * MiB;
constexpr size_t WS_R = 236 * MiB;
constexpr size_t R_P = WS_R;
constexpr size_t R_CQN = R_P + 98 * MiB;
constexpr size_t R_CKVN = R_CQN + 25 * MiB;
constexpr size_t R_QA = R_CKVN + 17 * MiB;
constexpr size_t R_KVA = R_QA + 49 * MiB;
constexpr size_t R_KR = R_KVA + 65 * MiB;
constexpr size_t R_QB = R_KR + 3 * MiB;
constexpr size_t R_KB = R_QB + 33 * MiB;
constexpr size_t R_VB = R_KB + 9 * MiB;
constexpr size_t R_O = R_P;
constexpr size_t R_EVEN_END = R_VB + 9 * MiB;
constexpr size_t R_QK = WS_R;
constexpr size_t R_VT = R_QK + 130 * MiB;
constexpr size_t R_VTC = R_VT + 64 * MiB;
constexpr size_t R_ON = R_VTC + 1 * MiB;
constexpr size_t R_ODD_END = R_ON + 65 * MiB;
constexpr int MOE_MAXT = 292;
constexpr size_t R_XB = WS_R;
constexpr size_t R_ACT = R_XB + 146 * MiB;
constexpr size_t R_RI = R_ACT + 73 * MiB;
constexpr size_t R_Y = R_RI + 1 * MiB;
constexpr size_t R_MOE_END = R_Y + 130 * MiB;
constexpr size_t WS_MOEW = 606 * MiB;
constexpr size_t MOEW_LAYER = 96 * MiB, MOEW_DN = 64 * MiB;
constexpr size_t WS_END = WS_MOEW + 4 * MOEW_LAYER;
static_assert(R_EVEN_END <= WS_MOEW && R_ODD_END <= WS_MOEW && R_MOE_END <= WS_MOEW, "overlay region");
static_assert(WS_END <= 1024 * MiB, "workspace");

constexpr int CW_BAR = 4096;
constexpr int CW_DBG = 8192;
constexpr int CW_CNT = 16384;
static_assert((CW_CNT + 4 * 32 * 64) * 4 <= (int)CTL_ZERO_BYTES, "ctl");

constexpr int RING_BYTES = 131072;
constexpr int TAB_LD = 1028;
constexpr int LDS_TAB = 36 * TAB_LD * 4;
constexpr int MISC_OFF = LDS_TAB;
constexpr int TILE_E_OFF = MISC_OFF + 64;
constexpr int MOE_NT_OFF = TILE_E_OFF + 1280;
constexpr int CNTL_OFF = MOE_NT_OFF + 16;
constexpr int REC_OFF = CNTL_OFF + 256;
constexpr int LDS_BYTES = REC_OFF + 3328;
static_assert(LDS_BYTES <= 163840, "LDS");

#define RLX_AGENT __ATOMIC_RELAXED, __HIP_MEMORY_SCOPE_AGENT
#define LDS_WAIT() asm volatile("s_waitcnt lgkmcnt(0)" ::: "memory")
#define VM_WAIT() asm volatile("s_waitcnt vmcnt(0)" ::: "memory")
#define SBAR() __builtin_amdgcn_sched_barrier(0)

__device__ __forceinline__ unsigned cvt_pk_bf16(float lo, float hi) { unsigned r; asm volatile("v_cvt_pk_bf16_f32 %0, %1, %2" : "=v"(r) : "v"(lo), "v"(hi)); return r; }
__device__ __forceinline__ float u2f(unsigned u) { return __builtin_bit_cast(float, u); }
__device__ __forceinline__ float bf16lo(unsigned w) { return __builtin_bit_cast(float, w << 16); }
__device__ __forceinline__ float bf16hi(unsigned w) { return __builtin_bit_cast(float, w & 0xffff0000u); }
__device__ __forceinline__ float wave_sum(float v) {
    v += __builtin_bit_cast(float, __builtin_amdgcn_update_dpp(0, __builtin_bit_cast(int, v), 0xB1, 0xF, 0xF, true));
    v += __builtin_bit_cast(float, __builtin_amdgcn_update_dpp(0, __builtin_bit_cast(int, v), 0x4E, 0xF, 0xF, true));
    v += __builtin_bit_cast(float, __builtin_amdgcn_update_dpp(0, __builtin_bit_cast(int, v), 0x141, 0xF, 0xF, true));
    v += __builtin_bit_cast(float, __builtin_amdgcn_update_dpp(0, __builtin_bit_cast(int, v), 0x140, 0xF, 0xF, true));
    { auto rr = __builtin_amdgcn_permlane16_swap(__float_as_uint(v), __float_as_uint(v), false, false); v = __uint_as_float(rr[0]) + __uint_as_float(rr[1]); }
    { auto rr = __builtin_amdgcn_permlane32_swap(__float_as_uint(v), __float_as_uint(v), false, false); v = __uint_as_float(rr[0]) + __uint_as_float(rr[1]); }
    return v;
}
__device__ __forceinline__ int row_class(int m) { return m < SEQ ? 0 : (m < NLAT ? 1 : 2); }

namespace pg8 {
constexpr int BM = 256, BK = 64, HALF = 128, HTB = HALF * BK * 2, STAGE_BYTES = 8 * HTB, NXCD = 8, WGM = 8;
__host__ __device__ __forceinline__ int lds_byte(int r, int c) { const int st = (r >> 4) * 2 + (c >> 5), rr = r & 15, cc = c & 31, ob = rr * 64 + cc * 2; return st * 1024 + (ob ^ (((ob >> 9) & 1) << 5)); }
__host__ __device__ __forceinline__ void stage_rc(int b, int& R, int& C) { const int st = b / 1024, sb = b % 1024, swz = sb ^ (((sb >> 9) & 1) << 5); R = (st >> 1) * 16 + swz / 64; C = (st & 1) * 32 + (swz % 64) / 2; }
__host__ __device__ __forceinline__ int perm32(int rho) { const int n = rho >> 4, i = rho & 15; return 8 * (i >> 2) + 4 * n + (i & 3); }

struct Unit { int pm, pn; };
struct Gemm { const bf16_t* A; const bf16_t* Bt; int lda, K; };

struct StaticOrder {
    static constexpr bool GATHER = false;
    int nM, nN, nwg, G, c;
    __device__ void init(int nM_, int nN_, int G_, int c_) { nM = nM_; nN = nN_; nwg = nM * nN; G = G_; c = c_; }
    __device__ bool next(int i, Unit& u) const {
        const long L = (long)i * G + c; if (L >= nwg) return false;
        int wgid = (int)L; { const int q = nwg / NXCD, r = nwg % NXCD, xcd = wgid % NXCD, off = wgid / NXCD; wgid = (xcd < r ? xcd * (q + 1) : r * (q + 1) + (xcd - r) * q) + off; }
        const int nig = WGM * nN, gid = wgid / nig, fm = gid * WGM, gsz = (nM - fm) < WGM ? (nM - fm) : WGM;
        u.pm = fm + ((wgid % nig) % gsz); u.pn = (wgid % nig) / gsz; return true;
    }
    __device__ __forceinline__ size_t boff(const Unit&) const { return 0; }
};
struct MoeOrder {
    static constexpr bool GATHER = false;
    const LAS int* tile_e; int nT, G, c; size_t estride;
    __device__ bool next(int i, Unit& u) const { const int L = i * G + c; u.pm = L >> 2; u.pn = L & 3; return u.pm < nT; }
    __device__ __forceinline__ size_t boff(const Unit& u) const { return (size_t)tile_e[u.pm] * estride; }
};
struct MoeGatherOrder : MoeOrder {
    static constexpr bool GATHER = true;
    const LAS int* lcnt; const LAS int* lbase; const u32x2* list;
    __device__ __forceinline__ unsigned rowoff(int r, int C, int lda) const { const int e = tile_e[r >> 8], j = r - lbase[e];
        unsigned tok = 0u; if (j < lcnt[e]) tok = list[(size_t)e * MROWS + j].x >> 1; return (tok * (unsigned)lda + (unsigned)C) * 2u; }
};

template <class Epi, class Sched, bool ALIGN_EPI = false>
__device__ __forceinline__ void gemm_phase(LAS unsigned char* lds, const Gemm g, const Sched& S, const Epi& E, const int tid) {
    const int wid = __builtin_amdgcn_readfirstlane(tid >> 6), lane = tid & 63, wr = wid >> 2, wc = wid & 3, fr = lane & 15, fq = lane >> 4;
    const int K = g.K, nt = K / BK;
    constexpr bool GA = Sched::GATHER;
    unsigned voffA[2], voffB[2]; int sR[2], sC[2];
#pragma unroll
    for (int i = 0; i < 2; ++i) { int R, C; stage_rc(tid * 16 + i * 8192, R, C); const int Rb = (R & ~31) + perm32(R & 31); sR[i] = R; sC[i] = C;
        voffA[i] = (unsigned)(R * g.lda + C) * 2u; voffB[i] = (unsigned)(Rb * K + C) * 2u; }
    unsigned ra[2][2], rn[2][2];
    const size_t kstep = (size_t)(BK * 2);
    const size_t hstepA = (size_t)HALF * g.lda * 2, hstepB = (size_t)HALF * K * 2;
    const size_t tstepA = 2 * hstepA, tstepB = 2 * hstepB;
    const unsigned ldsw = (unsigned)wid * 1024u;
    const int aoff = lds_byte(wr * 64 + fr, fq * 8), boff = lds_byte(wc * 32 + fr, fq * 8);
#define PG8_SA(b, h) (((b) * 2 + (h)) * HTB)
#define PG8_SB(b, h) ((4 + (b) * 2 + (h)) * HTB)
#define PG8_STAGE(bufoff, gbase, voff) do { _Pragma("unroll") for (int _i = 0; _i < 2; ++_i) \
        __builtin_amdgcn_global_load_lds((const unsigned*)((const char*)(gbase) + (voff)[_i]), (LAS unsigned*)(lds + (bufoff) + ldsw + _i * 8192), 16, 0, 0); } while (0)
#define PG8_ROWS(dst, u) do { if constexpr (GA) { _Pragma("unroll") for (int _h = 0; _h < 2; ++_h) _Pragma("unroll") for (int _i = 0; _i < 2; ++_i) dst[_h][_i] = S.rowoff((u).pm * 256 + _h * 128 + sR[_i], sC[_i], g.lda); } } while (0)
#define PG8_STAGE_A(bufoff, gbase, R, h) do { if constexpr (GA) { _Pragma("unroll") for (int _i = 0; _i < 2; ++_i) \
        __builtin_amdgcn_global_load_lds((const unsigned*)((const char*)(gbase) + (R)[h][_i]), (LAS unsigned*)(lds + (bufoff) + ldsw + _i * 8192), 16, 0, 0); } \
        else PG8_STAGE(bufoff, (gbase) + (h) * hstepA, voffA); } while (0)
#define PG8_LDA(dst, b, h) do { _Pragma("unroll") for (int m = 0; m < 4; ++m) _Pragma("unroll") for (int k = 0; k < 2; ++k) dst[m][k] = *(const LAS bf16x8*)(lds + PG8_SA(b, h) + aoff + m * 2048 + k * 1024); } while (0)
#define PG8_LDB(dst, b, h) do { _Pragma("unroll") for (int n = 0; n < 2; ++n) _Pragma("unroll") for (int k = 0; k < 2; ++k) dst[n][k] = *(const LAS bf16x8*)(lds + PG8_SB(b, h) + boff + n * 2048 + k * 1024); } while (0)
#define PG8_MMA(ai, bj, At, Bt) do { __builtin_amdgcn_s_setprio(1); _Pragma("unroll") for (int m = 0; m < 4; ++m) _Pragma("unroll") for (int n = 0; n < 2; ++n) _Pragma("unroll") for (int k = 0; k < 2; ++k) \
        acc[ai][bj][m][n] = __builtin_amdgcn_mfma_f32_16x16x32_bf16(Bt[n][k], At[m][k], acc[ai][bj][m][n], 0, 0, 0); __builtin_amdgcn_s_setprio(0); } while (0)
#define PG8_WAIT_V(n) asm volatile("s_waitcnt vmcnt(" #n ")" ::: "memory")
#define PG8_WAIT_L(n) asm volatile("s_waitcnt lgkmcnt(" #n ")" ::: "memory")
#define PG8_BAR __builtin_amdgcn_s_barrier()
#define PG8_SCHED __builtin_amdgcn_sched_barrier(0)
    Unit cur, nxt; int ui = 0;
    if (!S.next(0, cur)) return;
    f32x4 acc[2][2][4][2];
#pragma unroll
    for (int a = 0; a < 2; ++a)
#pragma unroll
        for (int b = 0; b < 2; ++b)
#pragma unroll
            for (int m = 0; m < 4; ++m)
#pragma unroll
                for (int n = 0; n < 2; ++n) acc[a][b][m][n] = (f32x4){0.f, 0.f, 0.f, 0.f};
    bf16x8 At[4][2], B0[2][2], B1[2][2];
    const char* cA = (const char*)g.A + (GA ? (size_t)0 : (size_t)cur.pm * tstepA); const char* cB = (const char*)g.Bt + S.boff(cur) * 2 + (size_t)cur.pn * tstepB;
    PG8_ROWS(ra, cur);
    PG8_STAGE(PG8_SB(0, 0), cB, voffB); PG8_STAGE(PG8_SB(0, 1), cB + hstepB, voffB); PG8_STAGE_A(PG8_SA(0, 0), cA, ra, 0); PG8_STAGE_A(PG8_SA(0, 1), cA, ra, 1);
    if (wr == 1) PG8_BAR;
    PG8_WAIT_V(2); PG8_BAR;
    PG8_STAGE(PG8_SB(1, 0), cB + kstep, voffB); PG8_STAGE_A(PG8_SA(1, 0), cA + kstep, ra, 0); PG8_STAGE(PG8_SB(1, 1), cB + hstepB + kstep, voffB);
    PG8_WAIT_V(6); PG8_BAR;
    for (;;) {
        const bool has_next = S.next(ui + 1, nxt);
        if constexpr (GA) { if (has_next) PG8_ROWS(rn, nxt); else { _Pragma("unroll") for (int _h = 0; _h < 2; ++_h) _Pragma("unroll") for (int _i = 0; _i < 2; ++_i) rn[_h][_i] = ra[_h][_i]; } }
        const char* nA = (has_next && !GA) ? (const char*)g.A + (size_t)nxt.pm * tstepA : cA; const char* nB = has_next ? (const char*)g.Bt + S.boff(nxt) * 2 + (size_t)nxt.pn * tstepB : cB;
        for (int t = 0; t < nt; t += 2) {
            const bool last = (t == nt - 2);
            const char* a1 = cA + (size_t)(t + 1) * kstep;
            const char* a2 = last ? nA : cA + (size_t)(t + 2) * kstep; const char* b2 = last ? nB : cB + (size_t)(t + 2) * kstep;
            const char* a3 = a2 + kstep; const char* b3 = b2 + kstep;
            unsigned rs[2][2];
            if constexpr (GA) { _Pragma("unroll") for (int _h = 0; _h < 2; ++_h) _Pragma("unroll") for (int _i = 0; _i < 2; ++_i) rs[_h][_i] = last ? rn[_h][_i] : ra[_h][_i]; }
            PG8_LDB(B0, 0, 0); PG8_LDB(B1, 0, 1); PG8_SCHED; PG8_LDA(At, 0, 0); PG8_STAGE_A(PG8_SA(1, 1), a1, ra, 1);
            PG8_WAIT_V(8); PG8_WAIT_L(0); PG8_BAR; PG8_MMA(0, 0, At, B0); PG8_MMA(0, 1, At, B1); PG8_BAR; PG8_SCHED;
            PG8_LDA(At, 0, 1); PG8_STAGE(PG8_SB(0, 0), b2, voffB); PG8_STAGE(PG8_SB(0, 1), b2 + hstepB, voffB); PG8_STAGE_A(PG8_SA(0, 0), a2, rs, 0);
            PG8_WAIT_V(8); PG8_WAIT_L(0); PG8_BAR; PG8_MMA(1, 0, At, B0); PG8_MMA(1, 1, At, B1); PG8_BAR; PG8_SCHED;
            PG8_LDB(B0, 1, 0); PG8_LDB(B1, 1, 1); PG8_SCHED; PG8_LDA(At, 1, 0); PG8_STAGE_A(PG8_SA(0, 1), a2, rs, 1);
            PG8_WAIT_V(8); PG8_WAIT_L(0); PG8_BAR; PG8_MMA(0, 0, At, B0); PG8_MMA(0, 1, At, B1); PG8_BAR; PG8_SCHED;
            PG8_LDA(At, 1, 1); PG8_STAGE(PG8_SB(1, 0), b3, voffB); PG8_STAGE(PG8_SB(1, 1), b3 + hstepB, voffB); PG8_STAGE_A(PG8_SA(1, 0), a3, rs, 0);
            PG8_WAIT_V(8); PG8_WAIT_L(0); PG8_BAR; PG8_MMA(1, 0, At, B0); PG8_MMA(1, 1, At, B1); PG8_BAR; PG8_SCHED;
        }
        if constexpr (ALIGN_EPI) { if (wr == 0) PG8_BAR; }
        E(acc, cur, wr, wc, fr, fq);
        if (!has_next) break;
#pragma unroll
        for (int a = 0; a < 2; ++a)
#pragma unroll
            for (int b = 0; b < 2; ++b)
#pragma unroll
                for (int m = 0; m < 4; ++m)
#pragma unroll
                    for (int n = 0; n < 2; ++n) acc[a][b][m][n] = (f32x4){0.f, 0.f, 0.f, 0.f};
        cur = nxt; cA = nA; cB = nB; ++ui;
        if constexpr (GA) { _Pragma("unroll") for (int _h = 0; _h < 2; ++_h) _Pragma("unroll") for (int _i = 0; _i < 2; ++_i) ra[_h][_i] = rn[_h][_i]; }
        if constexpr (ALIGN_EPI) { if (wr == 1) PG8_BAR; }
    }
    PG8_WAIT_V(0);
    if constexpr (!ALIGN_EPI) { if (wr == 0) PG8_BAR; }
    PG8_BAR;
#undef PG8_SA
#undef PG8_SB
#undef PG8_STAGE
#undef PG8_LDA
#undef PG8_ROWS
#undef PG8_STAGE_A
#undef PG8_LDB
#undef PG8_MMA
#undef PG8_WAIT_V
#undef PG8_WAIT_L
#undef PG8_BAR
#undef PG8_SCHED
}
}

#define XB_TMO      128
#define XB_XCNT(j)  (256  + 64 * (j))
#define XB_XSUB(j)  (1280 + 64 * (j))
#define XB_XGEN(j)  (2304 + 64 * (j))
#define XB_TOP      3328
#define XB_TOPGEN   3392
#define XCD_BAR_WORDS 3456
#define XB_SPIN_CAP (1u << 18)

__device__ __forceinline__ unsigned xb_ld(unsigned* p)              { return __hip_atomic_load(p, __ATOMIC_RELAXED, __HIP_MEMORY_SCOPE_AGENT); }
__device__ __forceinline__ unsigned xb_add(unsigned* p, unsigned v) { return __hip_atomic_fetch_add(p, v, __ATOMIC_RELAXED, __HIP_MEMORY_SCOPE_AGENT); }
__device__ __forceinline__ unsigned xb_xcc_id() { return (unsigned)__builtin_amdgcn_s_getreg((3 << 11) | 20) & 0xFu; }
#define XB_SPIN(cond, bar) do { unsigned _sp = 0; while (cond) { __builtin_amdgcn_s_sleep(1); \
    if ((++_sp & 255u) == 0u) { if (xb_ld(&(bar)[XB_TMO])) break; if (_sp > XB_SPIN_CAP) { atomicAdd(&(bar)[XB_TMO], 1u); break; } } } } while (0)

struct XcdBarrier {
    unsigned* bar; unsigned x;
    volatile LAS unsigned* st;
};
__device__ __forceinline__ XcdBarrier xcd_barrier_post(unsigned* bar, volatile LAS unsigned* st) {
    XcdBarrier b; b.bar = bar; b.x = xb_xcc_id(); b.st = st;
    if (threadIdx.x == 0) (void)xb_add(&bar[XB_XCNT(b.x)], 1u);
    return b;
}
__device__ __forceinline__ void xcd_barrier_complete(unsigned* bar, unsigned x, unsigned& nloc, unsigned& nx) {
    const unsigned G = gridDim.x * gridDim.y * gridDim.z;
    unsigned sum, cnt, mine, sp = 0u;
    for (;;) {
        sum = 0u; cnt = 0u; mine = 0u;
#pragma unroll
        for (unsigned j = 0; j < 16; ++j) { const unsigned c = xb_ld(&bar[XB_XCNT(j)]); sum += c; cnt += (c > 0u) ? 1u : 0u; mine = (j == x) ? c : mine; }
        if (sum == G) break;
        __builtin_amdgcn_s_sleep(1);
        if ((++sp & 255u) == 0u) { if (xb_ld(&bar[XB_TMO])) break; if (sp > XB_SPIN_CAP) { atomicAdd(&bar[XB_TMO], 1u); break; } }
    }
    nloc = mine > 0u ? mine : 1u; nx = cnt > 0u ? cnt : 1u;
}
__device__ __forceinline__ void xcd_barrier(const XcdBarrier& b) {
    asm volatile("s_waitcnt vmcnt(0)" ::: "memory");
    __syncthreads();
    if (threadIdx.x == 0) {
        unsigned* bar = b.bar;
        __builtin_amdgcn_s_waitcnt(0);
        unsigned nloc = b.st[0], nx = b.st[1];
        if (nloc == 0u) { xcd_barrier_complete(bar, b.x, nloc, nx); b.st[0] = nloc; b.st[1] = nx; }
        const unsigned old = xb_add(&bar[XB_XSUB(b.x)], 1u);
        const unsigned gen = old / nloc;
        if (old + 1u == (gen + 1u) * nloc) {
            __builtin_amdgcn_fence(__ATOMIC_RELEASE, "agent");
            asm volatile("s_waitcnt vmcnt(0)" ::: "memory");
            const unsigned og = xb_add(&bar[XB_TOP], 1u);
            const unsigned tg = og / nx;
            if (og + 1u == (tg + 1u) * nx) xb_add(&bar[XB_TOPGEN], 1u);
            else XB_SPIN(xb_ld(&bar[XB_TOPGEN]) == tg, bar);
            __builtin_amdgcn_fence(__ATOMIC_ACQUIRE, "agent");
            xb_add(&bar[XB_XGEN(b.x)], 1u);
            asm volatile("s_waitcnt vmcnt(0)" ::: "memory");
        } else {
            XB_SPIN(xb_ld(&bar[XB_XGEN(b.x)]) == gen, bar);
            __builtin_amdgcn_fence(__ATOMIC_ACQUIRE, "agent");
            asm volatile("s_waitcnt vmcnt(0)" ::: "memory");
        }
    }
    __syncthreads();
}

struct Args { const float* in[27]; float* out; unsigned char* ws; int ph_lo, ph_hi; };
struct Frame {
    LAS unsigned char* lds;
    unsigned char* ws;
    unsigned* ctl;
    const float* const* in;
    int tid, lane, wave, vcu, G, gw, NGW;
};

__device__ __forceinline__ void p0_transpose_item(const float* W, int K, int N, bf16_t* WT, int mode, LAS unsigned* scr, int item, int lane, float scale = 1.f) {
    const int nblk = (N + 63) / 64, kb = item / nblk, nb = item % nblk, k0 = 64 * kb, n0 = 64 * nb;
    const int drow0 = mode == 0 ? n0 : ((n0 >> 7) * 256 + (n0 & 127) + (mode == 2 ? 128 : 0));
    const int r = lane >> 4, n4 = lane & 15; const bool okc = n0 + 4 * n4 < N;
    f32x4 la[8], lb[8];
#pragma unroll
    for (int st = 0; st < 8; ++st) { const float* p = W + (size_t)(k0 + st * 8 + 2 * r) * N + n0 + 4 * n4;
        la[st] = okc ? __builtin_nontemporal_load((const f32x4*)p) : (f32x4){0.f, 0.f, 0.f, 0.f}; lb[st] = okc ? __builtin_nontemporal_load((const f32x4*)(p + N)) : (f32x4){0.f, 0.f, 0.f, 0.f}; }
#pragma unroll
    for (int st = 0; st < 8; ++st)
#pragma unroll
        for (int q = 0; q < 4; ++q) scr[(4 * n4 + q) * 33 + st * 4 + r] = cvt_pk_bf16(la[st][q] * scale, lb[st][q] * scale);
    LDS_WAIT(); asm volatile("" ::: "memory");
    const int c = lane & 7;
#pragma unroll
    for (int st = 0; st < 8; ++st) { const int n = st * 8 + (lane >> 3); const LAS unsigned* sp = scr + n * 33 + 4 * c;
        const u32x4 o = {sp[0], sp[1], sp[2], sp[3]};
        if (n0 + n < N) *(u32x4*)(WT + (size_t)(drow0 + n) * K + k0 + 8 * c) = o; }
    LDS_WAIT(); asm volatile("" ::: "memory");
}
__device__ __forceinline__ float silu_f(float x) { return x / (1.f + __expf(-x)); }

__device__ __forceinline__ void p0_prologue(Frame& F) {
    {
        LAS float* sv = (LAS float*)F.lds;
        LAS float* red = (LAS float*)(F.lds + 12288);
        const float* c = F.in[1]; const float* cc = F.in[3];
        for (int i = F.tid; i < 3072; i += NTHREADS) { const float x = i < 2048 ? c[i] : cc[i - 2048]; sv[i] = silu_f(x); }
        __syncthreads();
        const float* wada = F.in[4]; const float* bada = F.in[5]; float* mod = (float*)(F.ws + WS_MOD);
        for (int it = F.vcu; it < 4 * 96; it += F.G) {
            const int l = it / 96, n = (it % 96) * 64 + F.lane;
            const float* wp = wada + ((size_t)l * 1024 + F.wave * 128) * 6144 + n;
            float a0 = 0.f, a1 = 0.f, a2 = 0.f;
#pragma unroll 16
            for (int k = 0; k < 128; ++k) { const float w = wp[(size_t)k * 6144]; const int kk = F.wave * 128 + k; a0 += sv[kk] * w; a1 += sv[1024 + kk] * w; a2 += sv[2048 + kk] * w; }
            red[(F.wave * 3 + 0) * 64 + F.lane] = a0; red[(F.wave * 3 + 1) * 64 + F.lane] = a1; red[(F.wave * 3 + 2) * 64 + F.lane] = a2;
            __syncthreads();
            if (F.wave < 3) { float s = bada[l * 6144 + n];
#pragma unroll
                for (int w = 0; w < 8; ++w) s += red[(w * 3 + F.wave) * 64 + F.lane];
                mod[(size_t)(l * 3 + F.wave) * 6144 + n] = s; }
            __syncthreads();
        }
    }
    {
        f32x2* rope = (f32x2*)(F.ws + WS_ROPE);
        for (int e = F.vcu * NTHREADS + F.tid; e < 7680; e += F.G * NTHREADS) {
            int pos, i, n;
            if (e < 2048) { pos = e >> 3; i = e & 7; n = 8; } else if (e < 2560) { pos = (e - 2048) >> 3; i = e & 7; n = 8; }
            else if (e < 6656) { pos = (e - 2560) >> 4; i = (e - 2560) & 15; n = 16; } else { pos = (e - 6656) >> 4; i = (e - 6656) & 15; n = 16; }
            const float inv = powf(10000.f, -(float)i / (float)n);
            const float ang = (float)pos * inv; float s, co; sincosf(ang, &s, &co);
            rope[e] = (f32x2){co, s};
        }
    }
    {
        bf16_t* winT = (bf16_t*)(F.ws + WS_WIN);
        for (int e = F.vcu * NTHREADS + F.tid; e < 2 * 96 * 128; e += F.G * NTHREADS) { const int i = e / (96 * 128), r = (e / 128) % 96, c8 = e % 128;
            *(u32x4*)(winT + ((size_t)i * AB_INP + AB_IN + r) * 1024 + c8 * 8) = (u32x4){0u, 0u, 0u, 0u}; }
    }
    {
        LAS unsigned* scr = (LAS unsigned*)(F.lds + F.wave * 16384);
        constexpr int I_WIN = 16 * 23, I_QUP = 6 * 12, I_KVUP = 4 * 16, I_OUT = 16 * 16, I_NIN = 16 * 48, I_NOUT = 16 * 16;
        constexpr int I_SMALL = I_WIN + I_QUP + I_KVUP + I_OUT + I_NIN + I_NOUT;
        constexpr int NITEMS = 2 * I_SMALL + 128 * 384;
        for (int it = F.gw; it < NITEMS; it += F.NGW) {
            if (it < 2 * I_SMALL) {
                const int i = it / I_SMALL; int r = it % I_SMALL;
                if (r < I_WIN) { p0_transpose_item(F.in[9] + (size_t)i * 1024 * 1440, 1024, 1440, (bf16_t*)(F.ws + WS_WIN) + (size_t)i * AB_INP * 1024, 0, scr, r, F.lane); continue; } r -= I_WIN;
                if (r < I_QUP) { p0_transpose_item(F.in[12] + (size_t)i * 384 * 768, 384, 768, (bf16_t*)(F.ws + WS_WQUP) + (size_t)i * 768 * 384, 0, scr, r, F.lane, SC_A); continue; } r -= I_QUP;
                if (r < I_KVUP) { p0_transpose_item(F.in[14] + (size_t)i * 256 * 1024, 256, 1024, (bf16_t*)(F.ws + WS_WKVUP) + (size_t)i * 1024 * 256, 0, scr, r, F.lane); continue; } r -= I_KVUP;
                if (r < I_OUT) { p0_transpose_item(F.in[10] + (size_t)i * 1024 * 1024, 1024, 1024, (bf16_t*)(F.ws + WS_WOUT) + (size_t)i * 1024 * 1024, 0, scr, r, F.lane); continue; } r -= I_OUT;
                if (r < I_NIN) { p0_transpose_item(F.in[17] + (size_t)i * 1024 * 3072, 1024, 3072, (bf16_t*)(F.ws + WS_NIN) + (size_t)i * 3072 * 1024, 0, scr, r, F.lane); continue; } r -= I_NIN;
                p0_transpose_item(F.in[18] + (size_t)i * 1024 * 1024, 1024, 1024, (bf16_t*)(F.ws + WS_NOUT) + (size_t)i * 1024 * 1024, 0, scr, r, F.lane);
            } else {
                const int r = it - 2 * I_SMALL, le = r / 384, q = r % 384, kind = q >> 7, sub = q & 127, l = le >> 5, e = le & 31;
                bf16_t* gu = (bf16_t*)(F.ws + WS_MOEW + (size_t)l * MOEW_LAYER) + (size_t)e * 1024 * 1024;
                bf16_t* dn = (bf16_t*)(F.ws + WS_MOEW + (size_t)l * MOEW_LAYER + MOEW_DN) + (size_t)e * 1024 * 512;
                if (kind == 0) p0_transpose_item(F.in[24] + (size_t)le * 1024 * 512, 1024, 512, gu, 1, scr, sub, F.lane);
                else if (kind == 1) p0_transpose_item(F.in[25] + (size_t)le * 1024 * 512, 1024, 512, gu, 2, scr, sub, F.lane);
                else p0_transpose_item(F.in[26] + (size_t)le * 512 * 1024, 512, 1024, dn, 0, scr, sub, F.lane);
            }
        }
    }
}

__device__ __forceinline__ void store_bf16_row(bf16_t* orow, int lane, const f32x4 (&h)[4]) {
#pragma unroll
    for (int j = 0; j < 4; ++j) { u32x2 w; w.x = cvt_pk_bf16(h[j].x, h[j].y); w.y = cvt_pk_bf16(h[j].z, h[j].w); *(u32x2*)(orow + 256 * j + 4 * lane) = w; }
}
__device__ __forceinline__ void combine_row(f32x4 (&x)[4], const bf16_t* y0, const float* g2, int lane) {
#pragma unroll
    for (int j = 0; j < 4; ++j) {
        const u32x2 a = *(const u32x2*)(y0 + 256 * j + 4 * lane), b = *(const u32x2*)(y0 + 1024 + 256 * j + 4 * lane);
        const f32x4 g = *(const f32x4*)(g2 + 256 * j + 4 * lane) * MOE_ALPHA;
        x[j].x += g.x * (bf16lo(a.x) + bf16lo(b.x)); x[j].y += g.y * (bf16hi(a.x) + bf16hi(b.x));
        x[j].z += g.z * (bf16lo(a.y) + bf16lo(b.y)); x[j].w += g.w * (bf16hi(a.y) + bf16hi(b.y));
    }
}
__device__ __forceinline__ float row_rs(const f32x4 (&x)[4]) {
    float s = 0.f;
#pragma unroll
    for (int j = 0; j < 4; ++j) s += (x[j].x * x[j].x + x[j].y * x[j].y) + (x[j].z * x[j].z + x[j].w * x[j].w);
    return rsqrtf(wave_sum(s) * (1.f / 1024.f) + RMS_EPS);
}
__device__ __forceinline__ void modulate_row(const f32x4 (&x)[4], f32x4 (&h)[4], float rs, const float* gain, const float* sh, const float* sc, int lane) {
#pragma unroll
    for (int j = 0; j < 4; ++j) {
        const f32x4 g = *(const f32x4*)(gain + 256 * j + 4 * lane), s1 = *(const f32x4*)(sc + 256 * j + 4 * lane), s0 = *(const f32x4*)(sh + 256 * j + 4 * lane);
        h[j] = (x[j] * rs) * g * (s1 + 1.f) + s0;
    }
}

struct RowVec { f32x4 a[4], b[4], g[4]; };
__device__ __forceinline__ void load_rowvec(RowVec& V, const float* gain, const float* sh, const float* sc, const float* g2, int lane) {
#pragma unroll
    for (int j = 0; j < 4; ++j) { const int c = 256 * j + 4 * lane;
        const f32x4 g = *(const f32x4*)(gain + c), s1 = *(const f32x4*)(sc + c); V.a[j] = g * (s1 + 1.f); V.b[j] = *(const f32x4*)(sh + c);
        V.g[j] = g2 ? *(const f32x4*)(g2 + c) * MOE_ALPHA : (f32x4){0.f, 0.f, 0.f, 0.f}; }
}
struct RowRaw { f32x4 x[4]; u32x2 y0[4], y1[4]; };
__device__ __forceinline__ void load_rowraw(RowRaw& R, const float* xrow, const bf16_t* yrow, int lane) {
#pragma unroll
    for (int j = 0; j < 4; ++j) R.x[j] = *(const f32x4*)(xrow + 256 * j + 4 * lane);
    if (yrow) {
#pragma unroll
        for (int j = 0; j < 4; ++j) { R.y0[j] = *(const u32x2*)(yrow + 256 * j + 4 * lane); R.y1[j] = *(const u32x2*)(yrow + 1024 + 256 * j + 4 * lane); } }
}
__device__ __forceinline__ void combine_raw(RowRaw& R, const RowVec& V) {
#pragma unroll
    for (int j = 0; j < 4; ++j) { const u32x2 a = R.y0[j], b = R.y1[j];
        R.x[j].x += V.g[j].x * (bf16lo(a.x) + bf16lo(b.x)); R.x[j].y += V.g[j].y * (bf16hi(a.x) + bf16hi(b.x));
        R.x[j].z += V.g[j].z * (bf16lo(a.y) + bf16lo(b.y)); R.x[j].w += V.g[j].w * (bf16hi(a.y) + bf16hi(b.y)); }
}
__device__ __forceinline__ int chunk_lo(int gw, int M, int NGW) { return (int)(((long)gw * M) / NGW); }

__device__ __forceinline__ void mix_norm_phase(Frame& F, int l) {
    float* X = (float*)(F.ws + WS_X); bf16_t* H = (bf16_t*)(F.ws + WS_H);
    const float* mod = (const float*)(F.ws + WS_MOD); const bf16_t* Y = (const bf16_t*)(F.ws + R_Y);
    const float* gain = F.in[6] + l * 1024;
    const int r0 = chunk_lo(F.gw, MROWS, F.NGW), r1 = chunk_lo(F.gw + 1, MROWS, F.NGW);
    RowVec V; RowRaw cur, nxt; int vcur = -1;
#define SRC(m) ((l == 0) ? ((m) < NLAT ? F.in[0] + (size_t)(m) * 1024 : F.in[2] + (size_t)((m) - NLAT) * 1024) : X + (size_t)(m) * 1024)
    if (r0 < r1) load_rowraw(nxt, SRC(r0), l > 0 ? Y + (size_t)r0 * 2048 : nullptr, F.lane);
    for (int m = r0; m < r1; ++m) {
        cur = nxt;
        if (m + 1 < r1) load_rowraw(nxt, SRC(m + 1), l > 0 ? Y + (size_t)(m + 1) * 2048 : nullptr, F.lane);
        const int v = row_class(m);
        if (v != vcur) { vcur = v; const float* mv = mod + (size_t)(l * 3 + v) * 6144;
            load_rowvec(V, gain, mv, mv + 1024, l > 0 ? mod + ((size_t)((l - 1) * 3 + v) * 6 + 5) * 1024 : nullptr, F.lane); }
        if (l > 0) combine_raw(cur, V);
        if (l > 0) {
#pragma unroll
        for (int j = 0; j < 4; ++j) *(f32x4*)(X + (size_t)m * 1024 + 256 * j + 4 * F.lane) = cur.x[j]; }
        const float rs = row_rs(cur.x);
        f32x4 h[4];
#pragma unroll
        for (int j = 0; j < 4; ++j) h[j] = (cur.x[j] * rs) * V.a[j] + V.b[j];
        store_bf16_row(H + (size_t)m * 1024, F.lane, h);
    }
#undef SRC
}
__device__ __forceinline__ void final_phase(Frame& F, float* out) {
    const float* X = (const float*)(F.ws + WS_X); const float* mod = (const float*)(F.ws + WS_MOD); const bf16_t* Y = (const bf16_t*)(F.ws + R_Y);
    const float* gain = F.in[8];
    const int r0 = chunk_lo(F.gw, NLAT, F.NGW), r1 = chunk_lo(F.gw + 1, NLAT, F.NGW);
    RowVec V; RowRaw cur, nxt; int vcur = -1;
    if (r0 < r1) load_rowraw(nxt, X + (size_t)r0 * 1024, Y + (size_t)r0 * 2048, F.lane);
    for (int m = r0; m < r1; ++m) {
        cur = nxt;
        if (m + 1 < r1) load_rowraw(nxt, X + (size_t)(m + 1) * 1024, Y + (size_t)(m + 1) * 2048, F.lane);
        const int v = row_class(m);
        if (v != vcur) { vcur = v; const float* mv = mod + (size_t)(3 * 3 + v) * 6144; load_rowvec(V, gain, mv, mv + 1024, mv + 5 * 1024, F.lane); }
        combine_raw(cur, V);
        float rs = row_rs(cur.x);
        if (DBG_SEL >= 0 && DBG_SEL < 100) rs *= 1.f + (DBG_SEL >= 16 ? 10.f : 1.f) * fminf(u2f(__hip_atomic_load(F.ctl + CW_DBG + DBG_SEL, RLX_AGENT)), 0.3f);
        if (DBG_SEL == 101) { float code = 0.f;
            for (int g = 0; g < 8; ++g) { float e = 0.f; for (int q = 0; q < 4; ++q) e = fmaxf(e, u2f(__hip_atomic_load(F.ctl + CW_DBG + 16 + 4 * g + q, RLX_AGENT))); if (e > 0.05f) code += 0.1f * (float)(1 << g); }
            rs *= 1.f + code; }
#pragma unroll
        for (int j = 0; j < 4; ++j) { const f32x4 g = *(const f32x4*)(gain + 256 * j + 4 * F.lane); *(f32x4*)(out + (size_t)m * 1024 + 256 * j + 4 * F.lane) = (cur.x[j] * rs) * g; }
    }
}

__device__ __forceinline__ void ffn_norm_route_phase(Frame& F, int l) {
    const int M = (l == DEPTH - 1) ? NLAT : MROWS;
    const float* X = (const float*)(F.ws + WS_X); bf16_t* H = (bf16_t*)(F.ws + WS_H);
    const float* mod = (const float*)(F.ws + WS_MOD);
    const float* gain = F.in[7] + l * 1024;
    LAS float* tab = (LAS float*)F.lds;
    LAS int* lcnt = (LAS int*)(F.lds + CNTL_OFF); LAS int* lbase = lcnt + 32;
    LAS int* rec = (LAS int*)(F.lds + REC_OFF);
    {
        const float* wrg = F.in[20] + (size_t)l * 4096; const float* wre = F.in[22] + (size_t)l * 32768;
        for (int i = F.tid; i < 4096; i += NTHREADS) tab[(i & 3) * TAB_LD + (i >> 2)] = wrg[i];
        for (int i = F.tid; i < 32768; i += NTHREADS) tab[(4 + (i & 31)) * TAB_LD + (i >> 5)] = wre[i];
        if (F.tid < 32) lcnt[F.tid] = 0;
    }
    __syncthreads();
    const float* brg = F.in[21] + l * 4; const float* bre = F.in[23] + l * 32;
    const int r0 = chunk_lo(F.gw, M, F.NGW), r1 = chunk_lo(F.gw + 1, M, F.NGW);
    RowVec V; RowRaw cur, nxt; int vcur = -1;
    if (r0 < r1) load_rowraw(nxt, X + (size_t)r0 * 1024, nullptr, F.lane);
    float keep[36];
#pragma unroll
    for (int o = 0; o < 36; ++o) keep[o] = 0.f;
    int it = 0;
    for (int m = r0; m < r1; ++m, ++it) {
        cur = nxt;
        if (m + 1 < r1) load_rowraw(nxt, X + (size_t)(m + 1) * 1024, nullptr, F.lane);
        const int v = row_class(m);
        if (v != vcur) { vcur = v; const float* mv = mod + (size_t)(l * 3 + v) * 6144; load_rowvec(V, gain, mv + 3 * 1024, mv + 4 * 1024, nullptr, F.lane); }
        const float rs = row_rs(cur.x);
        f32x4 h[4];
#pragma unroll
        for (int j = 0; j < 4; ++j) h[j] = (cur.x[j] * rs) * V.a[j] + V.b[j];
        store_bf16_row(H + (size_t)m * 1024, F.lane, h);
        float lg[36];
#pragma unroll
        for (int o = 0; o < 36; ++o) {
            f32x2 a2 = {0.f, 0.f};
#pragma unroll
            for (int j = 0; j < 4; ++j) { const f32x4 w = *(const LAS f32x4*)(tab + o * TAB_LD + 256 * j + 4 * F.lane);
                a2 = __builtin_elementwise_fma((f32x2){h[j].x, h[j].y}, (f32x2){w.x, w.y}, a2); a2 = __builtin_elementwise_fma((f32x2){h[j].z, h[j].w}, (f32x2){w.z, w.w}, a2); }
            lg[o] = a2.x + a2.y;
        }
#pragma unroll
        for (int o = 0; o < 36; ++o) { const float tot = wave_sum(lg[o]); keep[o] = (F.lane == it) ? tot : keep[o]; }
    }
    if (F.lane < r1 - r0) {
        float g0 = keep[0] + brg[0], g1 = keep[1] + brg[1], g2 = keep[2] + brg[2], g3 = keep[3] + brg[3];
        int gs = 0; float gm = g0;
        if (g1 > gm) { gm = g1; gs = 1; } if (g2 > gm) { gm = g2; gs = 2; } if (g3 > gm) { gm = g3; gs = 3; }
        const float pg = 1.f / (__expf(g0 - gm) + __expf(g1 - gm) + __expf(g2 - gm) + __expf(g3 - gm));
        float se[8];
#pragma unroll
        for (int j = 0; j < 8; ++j) { const float a0 = keep[4 + j] + bre[j], a1 = keep[12 + j] + bre[8 + j], a2 = keep[20 + j] + bre[16 + j], a3 = keep[28 + j] + bre[24 + j];
            se[j] = gs == 0 ? a0 : (gs == 1 ? a1 : (gs == 2 ? a2 : a3)); }
        int i0 = 0; float m0 = se[0];
#pragma unroll
        for (int j = 1; j < 8; ++j) if (se[j] > m0) { m0 = se[j]; i0 = j; }
        int i1 = -1; float m1 = -3.0e38f;
#pragma unroll
        for (int j = 0; j < 8; ++j) if (j != i0 && se[j] > m1) { m1 = se[j]; i1 = j; }
        const float e1 = __expf(m1 - m0), w0 = pg / (1.f + e1), w1 = pg * e1 / (1.f + e1);
        const int ea = gs * 8 + i0, eb = gs * 8 + i1;
        const int lra = atomicAdd((int*)(lcnt + ea), 1), lrb = atomicAdd((int*)(lcnt + eb), 1);
        LAS int* r = rec + ((F.lane * 8 + F.wave) * 2) * 3;
        r[0] = ea; r[1] = lra; r[2] = __builtin_bit_cast(int, W_CONST > 0.f ? W_CONST : w0);
        r[3] = eb; r[4] = lrb; r[5] = __builtin_bit_cast(int, W_CONST > 0.f ? W_CONST : w1);
    }
    __syncthreads();
    if (F.tid < 32) lbase[F.tid] = (int)__hip_atomic_fetch_add(F.ctl + CW_CNT + (l * 32 + F.tid) * 64, (unsigned)lcnt[F.tid], RLX_AGENT);
    __syncthreads();
    u32x2* list = (u32x2*)(F.ws + WS_LIST);
    it = 0;
    for (int m = r0; m < r1; ++m, ++it) {
        if (F.lane < 2) { const LAS int* r = rec + ((it * 8 + F.wave) * 2 + F.lane) * 3; const int e = r[0], pos = lbase[e] + r[1];
            list[(size_t)e * MROWS + pos] = (u32x2){(unsigned)(2 * m + F.lane), (unsigned)r[2]}; }
    }
}

__device__ __forceinline__ void moe_tile_map(Frame& F, int l) {
    LAS int* tile_e = (LAS int*)(F.lds + TILE_E_OFF); LAS int* nt = (LAS int*)(F.lds + MOE_NT_OFF);
    LAS int* lcnt = (LAS int*)(F.lds + CNTL_OFF); LAS int* lbase = lcnt + 32;
    __syncthreads();
    if (F.tid < 32) lcnt[F.tid] = (int)__hip_atomic_load(F.ctl + CW_CNT + (l * 32 + F.tid) * 64, RLX_AGENT);
    __syncthreads();
    if (F.tid == 0) {
        int t0 = 0;
        for (int e = 0; e < 32; ++e) { const int c = lcnt[e], n = (c + 255) >> 8; lbase[e] = t0 * 256; for (int t = 0; t < n && t0 + t < 320; ++t) tile_e[t0 + t] = e; t0 += n; }
        nt[0] = t0 < MOE_MAXT ? t0 : MOE_MAXT;
    }
    __syncthreads();
}
__device__ __forceinline__ void moe_gather_phase(Frame& F, int l) {
    moe_tile_map(F, l);
    const LAS int* tile_e = (const LAS int*)(F.lds + TILE_E_OFF); const int nT = *(const LAS int*)(F.lds + MOE_NT_OFF);
    const LAS int* lcnt = (const LAS int*)(F.lds + CNTL_OFF); const LAS int* lbase = lcnt + 32;
    const bf16_t* H = (const bf16_t*)(F.ws + WS_H); bf16_t* XB = (bf16_t*)(F.ws + R_XB); u32x2* RI = (u32x2*)(F.ws + R_RI);
    const u32x2* list = (const u32x2*)(F.ws + WS_LIST);
    const int nrows = nT * 256;
    for (int rb = F.gw * 4; rb < nrows; rb += F.NGW * 4) {
        u32x2 ri[4]; u32x4 a[4], b[4];
#pragma unroll
        for (int q = 0; q < 4; ++q) { const int r = rb + q; const int e = tile_e[r >> 8], j = r - lbase[e];
            ri[q] = (u32x2){0xffffffffu, 0u};
            if (j < lcnt[e]) ri[q] = list[(size_t)e * MROWS + j]; }
#pragma unroll
        for (int q = 0; q < 4; ++q) { a[q] = (u32x4){0u, 0u, 0u, 0u}; b[q] = a[q];
            if (ri[q].x != 0xffffffffu) { const bf16_t* src = H + (size_t)(ri[q].x >> 1) * 1024; a[q] = *(const u32x4*)(src + F.lane * 8); b[q] = *(const u32x4*)(src + 512 + F.lane * 8); } }
#pragma unroll
        for (int q = 0; q < 4; ++q) { const int r = rb + q;
            *(u32x4*)(XB + (size_t)r * 1024 + F.lane * 8) = a[q]; *(u32x4*)(XB + (size_t)r * 1024 + 512 + F.lane * 8) = b[q];
            if (F.lane == 0) RI[r] = ri[q]; }
    }
}

using pg8::Unit;
__device__ __forceinline__ u32x4 pack8(const f32x4 v0, const f32x4 v1) { u32x4 w; w.x = cvt_pk_bf16(v0[0], v0[1]); w.y = cvt_pk_bf16(v0[2], v0[3]); w.z = cvt_pk_bf16(v1[0], v1[1]); w.w = cvt_pk_bf16(v1[2], v1[3]); return w; }

struct EpiStore {
    bf16_t* O; int ldc;
    __device__ __forceinline__ void operator()(const f32x4 (&acc)[2][2][4][2], const Unit& u, int wr, int wc, int fr, int fq) const {
        const int row0 = u.pm * 256 + wr * 64 + fr, col0 = u.pn * 256 + wc * 32 + 8 * fq;
#pragma unroll
        for (int ai = 0; ai < 2; ++ai)
#pragma unroll
            for (int m = 0; m < 4; ++m) { bf16_t* rowp = O + (size_t)(row0 + ai * 128 + m * 16) * ldc + col0;
#pragma unroll
                for (int bj = 0; bj < 2; ++bj) *(u32x4*)(rowp + bj * 128) = pack8(acc[ai][bj][m][0], acc[ai][bj][m][1]); }
    }
};
struct EpiOut {
    float* X; const float* modl;
    const float* Xs; const float* Xc;
    __device__ __forceinline__ void operator()(const f32x4 (&acc)[2][2][4][2], const Unit& u, int wr, int wc, int fr, int fq) const {
        const int row0 = u.pm * 256 + wr * 64 + fr, col0 = u.pn * 256 + wc * 32 + 8 * fq;
        const int v = u.pm < 64 ? 0 : (u.pm < 128 ? 1 : 2);
        const float* g1 = modl + (size_t)v * 6144 + 2 * 1024 + col0;
        f32x4 g[2][2];
#pragma unroll
        for (int bj = 0; bj < 2; ++bj) { g[bj][0] = *(const f32x4*)(g1 + bj * 128); g[bj][1] = *(const f32x4*)(g1 + bj * 128 + 4); }
#pragma unroll
        for (int ai = 0; ai < 2; ++ai)
#pragma unroll
            for (int m = 0; m < 4; ++m) { const int row = row0 + ai * 128 + m * 16; float* rowp = X + (size_t)row * 1024 + col0;
                const float* srcp = (u.pm < 128 ? Xs + (size_t)row * 1024 : Xc + (size_t)(row - NLAT) * 1024) + col0;
#pragma unroll
                for (int bj = 0; bj < 2; ++bj) { f32x4* p = (f32x4*)(rowp + bj * 128); const f32x4* q = (const f32x4*)(srcp + bj * 128);
                    const f32x4 a = q[0], b = q[1];
                    p[0] = a + g[bj][0] * acc[ai][bj][m][0]; p[1] = b + g[bj][1] * acc[ai][bj][m][1]; } }
    }
};
struct EpiNaIn {
    bf16_t* QK; bf16_t* Vt; bf16_t* Vtc;
    __device__ __forceinline__ void operator()(const f32x4 (&acc)[2][2][4][2], const Unit& u, int wr, int wc, int fr, int fq) const {
        const int row0 = u.pm * 256 + wr * 64 + fr, col0 = u.pn * 256 + wc * 32 + 8 * fq;
        if (u.pn < 8) {
            const float sc = u.pn < 4 ? SC_B : 1.f;
#pragma unroll
            for (int ai = 0; ai < 2; ++ai)
#pragma unroll
                for (int m = 0; m < 4; ++m) { bf16_t* rowp = QK + (size_t)(row0 + ai * 128 + m * 16) * 2048 + col0;
#pragma unroll
                    for (int bj = 0; bj < 2; ++bj) *(u32x4*)(rowp + bj * 128) = pack8(acc[ai][bj][m][0] * sc, acc[ai][bj][m][1] * sc); }
        } else {
#pragma unroll
            for (int ai = 0; ai < 2; ++ai)
#pragma unroll
                for (int m = 0; m < 4; ++m) { const int row = row0 + ai * 128 + m * 16;
                    bf16_t* base; size_t ld;
                    if (row < NLAT) { base = Vt + (size_t)(row >> 14) * 1024 * SEQ + (row & (SEQ - 1)); ld = SEQ; }
                    else { const int rc = row - NLAT; base = Vtc + (size_t)(rc >> 8) * 1024 * CTXL + (rc & 255); ld = CTXL; }
#pragma unroll
                    for (int bj = 0; bj < 2; ++bj) { const int hc = col0 + bj * 128 - 2048;
                        const u32x4 w = pack8(acc[ai][bj][m][0], acc[ai][bj][m][1]);
                        bf16_t* p = base + (size_t)hc * ld;
                        p[0] = (bf16_t)(w.x & 0xffff); p[ld] = (bf16_t)(w.x >> 16); p[2 * ld] = (bf16_t)(w.y & 0xffff); p[3 * ld] = (bf16_t)(w.y >> 16);
                        p[4 * ld] = (bf16_t)(w.z & 0xffff); p[5 * ld] = (bf16_t)(w.z >> 16); p[6 * ld] = (bf16_t)(w.w & 0xffff); p[7 * ld] = (bf16_t)(w.w >> 16); } }
        }
    }
};
struct EpiMoe1 {
    bf16_t* ACT;
    __device__ __forceinline__ void operator()(const f32x4 (&acc)[2][2][4][2], const Unit& u, int wr, int wc, int fr, int fq) const {
        const int row0 = u.pm * 256 + wr * 64 + fr, col0 = u.pn * 128 + wc * 32 + 8 * fq;
#pragma unroll
        for (int ai = 0; ai < 2; ++ai)
#pragma unroll
            for (int m = 0; m < 4; ++m) { f32x4 o[2];
#pragma unroll
                for (int n = 0; n < 2; ++n)
#pragma unroll
                    for (int i = 0; i < 4; ++i) { const float g = acc[ai][0][m][n][i], up = acc[ai][1][m][n][i];
                        o[n][i] = g * __builtin_amdgcn_rcpf(1.f + __builtin_amdgcn_exp2f(-g * LOG2E)) * up; }
                *(u32x4*)(ACT + (size_t)(row0 + ai * 128 + m * 16) * 512 + col0) = pack8(o[0], o[1]); }
    }
};
struct EpiMoe2 {
    bf16_t* Y; const LAS int* tile_e; const LAS int* lcnt; const LAS int* lbase; const u32x2* list;
    __device__ __forceinline__ void operator()(const f32x4 (&acc)[2][2][4][2], const Unit& u, int wr, int wc, int fr, int fq) const {
        const int row0 = u.pm * 256 + wr * 64 + fr, col0 = u.pn * 256 + wc * 32 + 8 * fq;
        const int e = tile_e[u.pm], j0 = row0 - lbase[e], cnt = lcnt[e];
#pragma unroll
        for (int ai = 0; ai < 2; ++ai)
#pragma unroll
            for (int m = 0; m < 4; ++m) { const int j = j0 + ai * 128 + m * 16;
                if (j < cnt) { const u32x2 ri = list[(size_t)e * MROWS + j]; const float w = u2f(ri.y); bf16_t* rowp = Y + (size_t)ri.x * 1024 + col0;
#pragma unroll
                    for (int bj = 0; bj < 2; ++bj) *(u32x4*)(rowp + bj * 128) = pack8(acc[ai][bj][m][0] * w, acc[ai][bj][m][1] * w); } }
    }
};

__device__ __forceinline__ void ab_prep_phase(Frame& F, int li) {
    const bf16_t* P = (const bf16_t*)(F.ws + R_P);
    bf16_t* CQN = (bf16_t*)(F.ws + R_CQN); bf16_t* CKVN = (bf16_t*)(F.ws + R_CKVN); bf16_t* KR = (bf16_t*)(F.ws + R_KR);
    bf16_t* QB = (bf16_t*)(F.ws + R_QB); bf16_t* KB = (bf16_t*)(F.ws + R_KB); bf16_t* VB = (bf16_t*)(F.ws + R_VB);
    const f32x2* rope = (const f32x2*)(F.ws + WS_ROPE);
    const float* qn = F.in[11] + li * QLORA; const float* kvn = F.in[13] + li * KVLORA; const float* gqn = F.in[15] + li * 64; const float* gkn = F.in[16] + li * 64;
    const int l = F.lane;
    for (int m = F.gw; m < MROWS; m += F.NGW) {
        const bf16_t* p = P + (size_t)m * AB_INP;
        const bool lat = m < NLAT; const int t = m & (SEQ - 1), gr = t >> 6, gc = t & 63;
        const unsigned* pc = (const unsigned*)(p + 6 * l); const unsigned c0 = pc[0], c1 = pc[1], c2 = pc[2];
        const u32x2 kv = *(const u32x2*)(p + 384 + 4 * l);
        const unsigned krw = *(const unsigned*)(p + 640 + 2 * (l & 15));
        const u32x4 gq = *(const u32x4*)(p + 672 + 8 * l);
        const unsigned gkw = *(const unsigned*)(p + 1184 + 2 * l), gvw = *(const unsigned*)(p + 1312 + 2 * l);
        { float x[6] = {bf16lo(c0), bf16hi(c0), bf16lo(c1), bf16hi(c1), bf16lo(c2), bf16hi(c2)};
          float ss = 0.f;
#pragma unroll
          for (int i = 0; i < 6; ++i) ss += x[i] * x[i];
          const float rs = rsqrtf(wave_sum(ss) * (1.f / 384.f) + RMS_EPS);
          unsigned* o = (unsigned*)(CQN + (size_t)m * QLORA + 6 * l);
#pragma unroll
          for (int i = 0; i < 3; ++i) o[i] = cvt_pk_bf16(x[2 * i] * rs * qn[6 * l + 2 * i], x[2 * i + 1] * rs * qn[6 * l + 2 * i + 1]); }
        { float x[4] = {bf16lo(kv.x), bf16hi(kv.x), bf16lo(kv.y), bf16hi(kv.y)};
          const float ss = (x[0] * x[0] + x[1] * x[1]) + (x[2] * x[2] + x[3] * x[3]);
          const float rs = rsqrtf(wave_sum(ss) * (1.f / 256.f) + RMS_EPS);
          const f32x4 g = *(const f32x4*)(kvn + 4 * l);
          u32x2 w; w.x = cvt_pk_bf16(x[0] * rs * g.x, x[1] * rs * g.y); w.y = cvt_pk_bf16(x[2] * rs * g.z, x[3] * rs * g.w);
          *(u32x2*)(CKVN + (size_t)m * KVLORA + 4 * l) = w; }
        if (l < 16) { float x1 = bf16lo(krw), x2 = bf16hi(krw);
            if (lat) { const f32x2 cs = (l < 8) ? rope[gr * 8 + l] : rope[2048 + gc * 8 + (l - 8)]; const float a = x1 * cs.x - x2 * cs.y, b = x1 * cs.y + x2 * cs.x; x1 = a; x2 = b; }
            *(unsigned*)(KR + (size_t)m * 32 + 2 * l) = cvt_pk_bf16(x1, x2); }
        { float x[8] = {bf16lo(gq.x), bf16hi(gq.x), bf16lo(gq.y), bf16hi(gq.y), bf16lo(gq.z), bf16hi(gq.z), bf16lo(gq.w), bf16hi(gq.w)};
          float ss = 0.f;
#pragma unroll
          for (int i = 0; i < 8; ++i) ss += x[i] * x[i];
          ss += __shfl_xor(ss, 1); ss += __shfl_xor(ss, 2); ss += __shfl_xor(ss, 4);
          const float rs = rsqrtf(ss * (1.f / 64.f) + RMS_EPS);
          const int d0 = (l & 7) * 8;
          const f32x4 g0 = *(const f32x4*)(gqn + d0), g1 = *(const f32x4*)(gqn + d0 + 4);
          x[0] *= rs * g0.x; x[1] *= rs * g0.y; x[2] *= rs * g0.z; x[3] *= rs * g0.w; x[4] *= rs * g1.x; x[5] *= rs * g1.y; x[6] *= rs * g1.z; x[7] *= rs * g1.w;
          if (lat) { const int p0 = (l & 7) * 4; const f32x2* tp = (p0 < 16) ? rope + 2560 + gr * 16 + p0 : rope + 6656 + gc * 16 + (p0 - 16);
              const f32x4 cs0 = *(const f32x4*)tp, cs1 = *(const f32x4*)(tp + 2);
              float a;
              a = x[0] * cs0[0] - x[1] * cs0[1]; x[1] = x[0] * cs0[1] + x[1] * cs0[0]; x[0] = a;
              a = x[2] * cs0[2] - x[3] * cs0[3]; x[3] = x[2] * cs0[3] + x[3] * cs0[2]; x[2] = a;
              a = x[4] * cs1[0] - x[5] * cs1[1]; x[5] = x[4] * cs1[1] + x[5] * cs1[0]; x[4] = a;
              a = x[6] * cs1[2] - x[7] * cs1[3]; x[7] = x[6] * cs1[3] + x[7] * cs1[2]; x[6] = a; }
          u32x4 w; w.x = cvt_pk_bf16(x[0] * SC_B, x[1] * SC_B); w.y = cvt_pk_bf16(x[2] * SC_B, x[3] * SC_B); w.z = cvt_pk_bf16(x[4] * SC_B, x[5] * SC_B); w.w = cvt_pk_bf16(x[6] * SC_B, x[7] * SC_B);
          *(u32x4*)(QB + (size_t)m * 512 + 8 * l) = w; }
        { float x1 = bf16lo(gkw), x2 = bf16hi(gkw);
          float ss = x1 * x1 + x2 * x2;
          ss += __shfl_xor(ss, 1); ss += __shfl_xor(ss, 2); ss += __shfl_xor(ss, 4); ss += __shfl_xor(ss, 8); ss += __shfl_xor(ss, 16);
          const float rs = rsqrtf(ss * (1.f / 64.f) + RMS_EPS);
          const int pi = l & 31;
          x1 *= rs * gkn[2 * pi]; x2 *= rs * gkn[2 * pi + 1];
          if (lat) { const f32x2 cs = (pi < 16) ? rope[2560 + gr * 16 + pi] : rope[6656 + gc * 16 + (pi - 16)]; const float a = x1 * cs.x - x2 * cs.y, b = x1 * cs.y + x2 * cs.x; x1 = a; x2 = b; }
          *(unsigned*)(KB + (size_t)m * 128 + 2 * l) = cvt_pk_bf16(x1, x2);
          *(unsigned*)(VB + (size_t)m * 128 + 2 * l) = gvw; }
    }
}

namespace att {
constexpr int B_KN = 0, B_KR = 8192, B_V = 12288, BUF = 20480;
constexpr float THR2 = 8.f * LOG2E;
__device__ __forceinline__ int crow(int r, int hi) { return (r & 3) + 8 * (r >> 2) + 4 * hi; }
__device__ __forceinline__ int swz64(int row, int ch) { return row * 128 + ((ch ^ ((row >> 1) & 7)) << 4); }
__device__ __forceinline__ int swz32(int row, int ch) { return row * 64 + ((ch ^ ((row >> 2) & 3)) << 4); }
__device__ __forceinline__ int v_st(int k, int c) { const int kk = k;     return ((kk >> 3) * 2 + (c >> 5)) * 512 + ((kk & 7) * 32 + (c & 31)) * 2; }
__device__ __forceinline__ int v_rd_base(int lane) { return ((lane & 3) << 3) | (((lane >> 2) & 3) << 6) | (((lane >> 4) & 1) << 5) | (((lane >> 5) & 1) << 8); }
constexpr int v_rd_off(int d0, int ks, int half) { return d0 * 512 + ks * 2048 + half * 1024; }
template <int OFF> __device__ __forceinline__ s16x4 tr_read(unsigned vb) {
    s16x4 r; asm volatile("ds_read_b64_tr_b16 %0, %1 offset:%2" : "=&v"(r) : "v"(vb), "i"(OFF) : "memory"); return r;
}
__device__ __forceinline__ float psm_max(const f32x16& p0, const f32x16& p1) {
    float pmax = p0[0];
#pragma unroll
    for (int r = 1; r < 16; ++r) pmax = fmaxf(pmax, p0[r]);
#pragma unroll
    for (int r = 0; r < 16; ++r) pmax = fmaxf(pmax, p1[r]);
    { auto rr = __builtin_amdgcn_permlane32_swap(__float_as_uint(pmax), __float_as_uint(pmax), false, false);
      pmax = fmaxf(__uint_as_float(rr[0]), __uint_as_float(rr[1])); }
    return pmax;
}
template <bool FIRST> __device__ __forceinline__ void psm_apply(f32x16& p0, f32x16& p1, float pmax, float& m_reg, f32x16& negm, float& alpha) {
    alpha = 1.f;
    if (FIRST || !__builtin_expect(__all(pmax <= THR2), 1)) {
        const float delta = FIRST ? pmax : fmaxf(pmax, 0.f);
        if (!FIRST) alpha = __builtin_amdgcn_exp2f(-delta);
        m_reg += delta;
#pragma unroll
        for (int r = 0; r < 16; ++r) { p0[r] -= delta; p1[r] -= delta; negm[r] = -m_reg; }
    }
#pragma unroll
    for (int r = 0; r < 16; ++r) p0[r] = EXP_PROBE ? fmaf(p0[r], 0.001f, 1.f) : __builtin_amdgcn_exp2f(p0[r]);
}
template <bool FIRST> __device__ __forceinline__ void partialSM(f32x16& p0, f32x16& p1, float& m_reg, f32x16& negm, float& alpha) {
    const float pmax = psm_max(p0, p1); psm_apply<FIRST>(p0, p1, pmax, m_reg, negm, alpha);
}
#define ATT_PK4(P, BASE, OUT) do { unsigned a0 = cvt_pk_bf16(P[BASE + 0], P[BASE + 1]), a1 = cvt_pk_bf16(P[BASE + 2], P[BASE + 3]);   \
    unsigned b0 = cvt_pk_bf16(P[BASE + 4], P[BASE + 5]), b1 = cvt_pk_bf16(P[BASE + 6], P[BASE + 7]);                              \
    auto r0 = __builtin_amdgcn_permlane32_swap(a0, b0, false, false); auto r1 = __builtin_amdgcn_permlane32_swap(a1, b1, false, false); \
    u32x4 w = {r0[0], r1[0], r0[1], r1[1]}; OUT = __builtin_bit_cast(bf16x8, w); } while (0)
#define ATT_PKN(P, BASE, OUT) do { u32x4 w = {cvt_pk_bf16(P[BASE + 0], P[BASE + 1]), cvt_pk_bf16(P[BASE + 2], P[BASE + 3]), cvt_pk_bf16(P[BASE + 4], P[BASE + 5]), cvt_pk_bf16(P[BASE + 6], P[BASE + 7])}; \
    OUT = __builtin_bit_cast(bf16x8, w); } while (0)
__device__ __forceinline__ void finishSM(f32x16& p0, f32x16& p1, float alpha, float& l_reg, bf16x8& pa0, bf16x8& pa1, bf16x8& pa2, bf16x8& pa3) {
#pragma unroll
    for (int r = 0; r < 16; ++r) p1[r] = EXP_PROBE ? fmaf(p1[r], 0.001f, 1.f) : __builtin_amdgcn_exp2f(p1[r]);
    float ps = 0.f;
#pragma unroll
    for (int r = 0; r < 16; ++r) ps += p0[r];
#pragma unroll
    for (int r = 0; r < 16; ++r) ps += p1[r];
    { auto rr = __builtin_amdgcn_permlane32_swap(__float_as_uint(ps), __float_as_uint(ps), false, false);
      ps = __uint_as_float(rr[0]) + __uint_as_float(rr[1]); }
    l_reg = l_reg * alpha + ps;
    ATT_PKN(p0, 0, pa0); ATT_PKN(p0, 8, pa1); ATT_PKN(p1, 0, pa2); ATT_PKN(p1, 8, pa3);
}
template <int DQK> __device__ __forceinline__ void qkt(f32x16& p0, f32x16& p1, const LAS char* buf, const bf16x8* qr, int r32, int hi, const f32x16& negm) {
#pragma unroll
    for (int d0 = 0; d0 < 4; ++d0) { const int ch = d0 * 2 + hi;
        const bf16x8 b0 = *(const LAS bf16x8*)(buf + B_KN + swz64(r32, ch));
        const bf16x8 b1 = *(const LAS bf16x8*)(buf + B_KN + swz64(32 + r32, ch));
        p0 = __builtin_amdgcn_mfma_f32_32x32x16_bf16(b0, qr[d0], d0 == 0 ? negm : p0, 0, 0, 0);
        p1 = __builtin_amdgcn_mfma_f32_32x32x16_bf16(b1, qr[d0], d0 == 0 ? negm : p1, 0, 0, 0); }
    if constexpr (DQK == 96) {
#pragma unroll
        for (int d0 = 0; d0 < 2; ++d0) { const int ch = d0 * 2 + hi;
            const bf16x8 b0 = *(const LAS bf16x8*)(buf + B_KR + swz32(r32, ch));
            const bf16x8 b1 = *(const LAS bf16x8*)(buf + B_KR + swz32(32 + r32, ch));
            p0 = __builtin_amdgcn_mfma_f32_32x32x16_bf16(b0, qr[4 + d0], p0, 0, 0, 0);
            p1 = __builtin_amdgcn_mfma_f32_32x32x16_bf16(b1, qr[4 + d0], p1, 0, 0, 0); }
    }
}
template <int D0> __device__ __forceinline__ void pv_one(f32x16& od, unsigned vb, bf16x8 pa0, bf16x8 pa1, bf16x8 pa2, bf16x8 pa3) {
    const s16x4 l0 = tr_read<v_rd_off(D0, 0, 0)>(vb), h0 = tr_read<v_rd_off(D0, 0, 1)>(vb), l1 = tr_read<v_rd_off(D0, 1, 0)>(vb), h1 = tr_read<v_rd_off(D0, 1, 1)>(vb);
    const s16x4 l2 = tr_read<v_rd_off(D0, 2, 0)>(vb), h2 = tr_read<v_rd_off(D0, 2, 1)>(vb), l3 = tr_read<v_rd_off(D0, 3, 0)>(vb), h3 = tr_read<v_rd_off(D0, 3, 1)>(vb);
    asm volatile("s_waitcnt lgkmcnt(0)" ::: "memory"); SBAR();
#define ATT_PK(L, H) (bf16x8){L[0], L[1], L[2], L[3], H[0], H[1], H[2], H[3]}
    od = __builtin_amdgcn_mfma_f32_32x32x16_bf16(ATT_PK(l0, h0), pa0, od, 0, 0, 0);
    od = __builtin_amdgcn_mfma_f32_32x32x16_bf16(ATT_PK(l1, h1), pa1, od, 0, 0, 0);
    od = __builtin_amdgcn_mfma_f32_32x32x16_bf16(ATT_PK(l2, h2), pa2, od, 0, 0, 0);
    od = __builtin_amdgcn_mfma_f32_32x32x16_bf16(ATT_PK(l3, h3), pa3, od, 0, 0, 0);
#undef ATT_PK
}

#define ATT_PK(L, H) (bf16x8){L[0], L[1], L[2], L[3], H[0], H[1], H[2], H[3]}
template <bool FIXM> __device__ __forceinline__ void pv_psm(f32x16& o0, f32x16& o1, unsigned vb, bf16x8 pa0, bf16x8 pa1, bf16x8 pa2, bf16x8 pa3,
                                       f32x16& p0, f32x16& p1, float& m_reg, f32x16& negm, float& alpha) {
    { const s16x4 l0 = tr_read<v_rd_off(0, 0, 0)>(vb), h0 = tr_read<v_rd_off(0, 0, 1)>(vb), l1 = tr_read<v_rd_off(0, 1, 0)>(vb), h1 = tr_read<v_rd_off(0, 1, 1)>(vb);
      const s16x4 l2 = tr_read<v_rd_off(0, 2, 0)>(vb), h2 = tr_read<v_rd_off(0, 2, 1)>(vb), l3 = tr_read<v_rd_off(0, 3, 0)>(vb), h3 = tr_read<v_rd_off(0, 3, 1)>(vb);
      float pmax = 0.f; SBAR(); if (!FIXM) pmax = psm_max(p0, p1); else { _Pragma("unroll") for (int r = 0; r < 8; ++r) p0[r] = __builtin_amdgcn_exp2f(p0[r]); } SBAR();
      asm volatile("s_waitcnt lgkmcnt(0)" ::: "memory"); SBAR();
      o0 = __builtin_amdgcn_mfma_f32_32x32x16_bf16(ATT_PK(l0, h0), pa0, o0, 0, 0, 0);
      o0 = __builtin_amdgcn_mfma_f32_32x32x16_bf16(ATT_PK(l1, h1), pa1, o0, 0, 0, 0);
      o0 = __builtin_amdgcn_mfma_f32_32x32x16_bf16(ATT_PK(l2, h2), pa2, o0, 0, 0, 0);
      o0 = __builtin_amdgcn_mfma_f32_32x32x16_bf16(ATT_PK(l3, h3), pa3, o0, 0, 0, 0);
      SBAR();
      const s16x4 m0 = tr_read<v_rd_off(1, 0, 0)>(vb), n0 = tr_read<v_rd_off(1, 0, 1)>(vb), m1 = tr_read<v_rd_off(1, 1, 0)>(vb), n1 = tr_read<v_rd_off(1, 1, 1)>(vb);
      const s16x4 m2 = tr_read<v_rd_off(1, 2, 0)>(vb), n2 = tr_read<v_rd_off(1, 2, 1)>(vb), m3 = tr_read<v_rd_off(1, 3, 0)>(vb), n3 = tr_read<v_rd_off(1, 3, 1)>(vb);
      SBAR(); if (!FIXM) psm_apply<false>(p0, p1, pmax, m_reg, negm, alpha); else { alpha = 1.f; _Pragma("unroll") for (int r = 8; r < 16; ++r) p0[r] = __builtin_amdgcn_exp2f(p0[r]); } SBAR();
      asm volatile("s_waitcnt lgkmcnt(0)" ::: "memory"); SBAR();
      o1 = __builtin_amdgcn_mfma_f32_32x32x16_bf16(ATT_PK(m0, n0), pa0, o1, 0, 0, 0);
      o1 = __builtin_amdgcn_mfma_f32_32x32x16_bf16(ATT_PK(m1, n1), pa1, o1, 0, 0, 0);
      o1 = __builtin_amdgcn_mfma_f32_32x32x16_bf16(ATT_PK(m2, n2), pa2, o1, 0, 0, 0);
      o1 = __builtin_amdgcn_mfma_f32_32x32x16_bf16(ATT_PK(m3, n3), pa3, o1, 0, 0, 0); }
}
#undef ATT_PK
template <int DQK, bool FIXM>
__device__ __forceinline__ void attn_unit(const bf16_t* __restrict__ Qp, int ldq, const bf16_t* __restrict__ Knp, int ldk, const bf16_t* __restrict__ Krp,
                                          const bf16_t* __restrict__ Vp, int ldv, bf16_t* __restrict__ Op, int lat0, int nlt, int ctx0, int NT, LAS char* lds, const int tid, const f32x2* rope, int qtok0, float mfix) {
    constexpr int NQ = DQK / 16;
    const int wid = tid >> 6, lane = tid & 63, r32 = lane & 31, hi = lane >> 5;
    float m_reg = 0.f, l_reg = 0.f; f32x16 o0 = {}, o1 = {}, negm = {}; bf16x8 qr[NQ];
    if (FIXM) { _Pragma("unroll") for (int r = 0; r < 16; ++r) negm[r] = -mfix; }
    const bf16_t* Qw = Qp + (size_t)(wid * 32 + r32) * ldq + hi * 8;
#pragma unroll
    for (int d0 = 0; d0 < NQ; ++d0) qr[d0] = *(const bf16x8*)(Qw + d0 * 16);
    if constexpr (DQK == 96) { if (qtok0 >= 0) {
        const int t = qtok0 + wid * 32 + r32, gr = t >> 6, gc = t & 63;
#pragma unroll
        for (int e = 0; e < 2; ++e) { const f32x2* tp = (e == 0) ? rope + gr * 8 + hi * 4 : rope + 2048 + gc * 8 + hi * 4;
            const f32x4 cs0 = *(const f32x4*)tp, cs1 = *(const f32x4*)(tp + 2);
            const u32x4 w = __builtin_bit_cast(u32x4, qr[4 + e]); u32x4 o;
            { const float x1 = bf16lo(w.x), x2 = bf16hi(w.x); o.x = cvt_pk_bf16(x1 * cs0[0] - x2 * cs0[1], x1 * cs0[1] + x2 * cs0[0]); }
            { const float x1 = bf16lo(w.y), x2 = bf16hi(w.y); o.y = cvt_pk_bf16(x1 * cs0[2] - x2 * cs0[3], x1 * cs0[3] + x2 * cs0[2]); }
            { const float x1 = bf16lo(w.z), x2 = bf16hi(w.z); o.z = cvt_pk_bf16(x1 * cs1[0] - x2 * cs1[1], x1 * cs1[1] + x2 * cs1[0]); }
            { const float x1 = bf16lo(w.w), x2 = bf16hi(w.w); o.w = cvt_pk_bf16(x1 * cs1[2] - x2 * cs1[3], x1 * cs1[3] + x2 * cs1[2]); }
            qr[4 + e] = __builtin_bit_cast(bf16x8, o); } } }
    const int sr = tid >> 3, c8 = tid & 7, sr2 = (tid >> 2) & 63, c4 = tid & 3;
    const bool krw = (DQK == 96) && (tid < 256);
    const int kn_st = B_KN + swz64(sr, c8), v_stw = B_V + v_st(sr, c8 * 8), kr_st = B_KR + swz32(sr2, c4);
    const unsigned vb0 = (unsigned)(uintptr_t)lds + B_V + v_rd_base(lane);
    bf16x8 skn[2], sv[2], skr[2];
#define KROW(j) ((j) < nlt ? lat0 + 64 * (j) : ctx0 + 64 * ((j) - nlt))
#define SLOAD(i, j) do { const int _row = KROW(j); skn[i] = *(const bf16x8*)(Knp + (size_t)(_row + sr) * ldk + c8 * 8); sv[i] = *(const bf16x8*)(Vp + (size_t)(_row + sr) * ldv + c8 * 8); \
        if (krw) skr[i] = *(const bf16x8*)(Krp + (size_t)(_row + sr2) * 32 + c4 * 8); } while (0)
#define SWRITE(b, i) do { *(LAS bf16x8*)(lds + (b) * BUF + kn_st) = skn[i]; *(LAS bf16x8*)(lds + (b) * BUF + v_stw) = sv[i]; if (krw) *(LAS bf16x8*)(lds + (b) * BUF + kr_st) = skr[i]; } while (0)
#define SWRITEO(boff, i) do { *(LAS bf16x8*)(lds + (boff) + kn_st) = skn[i]; *(LAS bf16x8*)(lds + (boff) + v_stw) = sv[i]; if (krw) *(LAS bf16x8*)(lds + (boff) + kr_st) = skr[i]; } while (0)
#define PVO(boff) do { pv_one<0>(o0, vb0 + (boff), pa0, pa1, pa2, pa3); pv_one<1>(o1, vb0 + (boff), pa0, pa1, pa2, pa3); } while (0)
#define SWAIT() asm volatile("s_waitcnt vmcnt(2)" ::: "memory")
#define RESC(a) do { if (__any((a) < 1.f)) { _Pragma("unroll") for (int r = 0; r < 16; ++r) { o0[r] *= (a); o1[r] *= (a); } } } while (0)
#define PV(bufi) do { pv_one<0>(o0, vb0 + (bufi) * BUF, pa0, pa1, pa2, pa3); pv_one<1>(o1, vb0 + (bufi) * BUF, pa0, pa1, pa2, pa3); } while (0)
    f32x16 pA0, pA1, pB0, pB1; float alA, alB; bf16x8 pa0, pa1, pa2, pa3;
    int bV = 0, bK = BUF, bW = 2 * BUF;
#define ROT() do { const int _t = bV; bV = bK; bK = bW; bW = _t; } while (0)
    __syncthreads();
    SLOAD(0, 0); asm volatile("s_waitcnt vmcnt(0)" ::: "memory"); SWRITE(0, 0);
    SLOAD(1, 1); if (2 < NT) SLOAD(0, 2);
    __syncthreads();
    qkt<DQK>(pA0, pA1, lds, qr, r32, hi, negm);
    if (FIXM) { alA = 1.f; _Pragma("unroll") for (int r = 0; r < 16; ++r) pA0[r] = __builtin_amdgcn_exp2f(pA0[r]); } else partialSM<true>(pA0, pA1, m_reg, negm, alA);
    SWAIT(); SWRITEO(BUF, 1);
    for (int j = 1; j + 1 < NT; j += 2) {
        if (!NOBAR_PROBE) __syncthreads();
        SBAR(); qkt<DQK>(pB0, pB1, lds + bK, qr, r32, hi, negm);
        finishSM(pA0, pA1, alA, l_reg, pa0, pa1, pa2, pa3); SBAR();
        SLOAD(1, j + 2); SBAR();
        if constexpr (FIXM) pv_psm<true>(o0, o1, vb0 + bV, pa0, pa1, pa2, pa3, pB0, pB1, m_reg, negm, alB); else { PVO(bV); partialSM<false>(pB0, pB1, m_reg, negm, alB); }
        SWAIT(); SWRITEO(bW, 0);
        if (!FIXM) RESC(alB); ROT();
        if (!NOBAR_PROBE) __syncthreads();
        SBAR(); qkt<DQK>(pA0, pA1, lds + bK, qr, r32, hi, negm);
        finishSM(pB0, pB1, alB, l_reg, pa0, pa1, pa2, pa3); SBAR();
        if (j + 3 < NT) SLOAD(0, j + 3); SBAR();
        if constexpr (FIXM) pv_psm<true>(o0, o1, vb0 + bV, pa0, pa1, pa2, pa3, pA0, pA1, m_reg, negm, alA); else { PVO(bV); partialSM<false>(pA0, pA1, m_reg, negm, alA); }
        SWAIT(); SWRITEO(bW, 1);
        if (!FIXM) RESC(alA); ROT();
    }
    __syncthreads();
    SBAR(); qkt<DQK>(pB0, pB1, lds + bK, qr, r32, hi, negm);
    finishSM(pA0, pA1, alA, l_reg, pa0, pa1, pa2, pa3); SBAR();
    if constexpr (FIXM) pv_psm<true>(o0, o1, vb0 + bV, pa0, pa1, pa2, pa3, pB0, pB1, m_reg, negm, alB); else { PVO(bV); partialSM<false>(pB0, pB1, m_reg, negm, alB); }
    if (!FIXM) RESC(alB);
    finishSM(pB0, pB1, alB, l_reg, pa0, pa1, pa2, pa3); SBAR();
    PVO(bK);
#undef ROT
    const float inv = __builtin_amdgcn_rcpf(l_reg);
    bf16_t* Ow = Op + (size_t)(wid * 32 + r32) * 1024 + 4 * hi;
#pragma unroll
    for (int g = 0; g < 4; ++g) {
        u32x2 w0, w1;
        w0.x = cvt_pk_bf16(o0[4 * g] * inv, o0[4 * g + 1] * inv); w0.y = cvt_pk_bf16(o0[4 * g + 2] * inv, o0[4 * g + 3] * inv);
        w1.x = cvt_pk_bf16(o1[4 * g] * inv, o1[4 * g + 1] * inv); w1.y = cvt_pk_bf16(o1[4 * g + 2] * inv, o1[4 * g + 3] * inv);
        *(u32x2*)(Ow + 8 * g) = w0; *(u32x2*)(Ow + 32 + 8 * g) = w1;
    }
#undef KROW
#undef SLOAD
#undef SWRITE
#undef SWAIT
#undef SWRITEO
#undef PVO
#undef RESC
#undef PV
}
}

__device__ __forceinline__ void attn_phase(Frame& F, int li) {
    const bf16_t* QA = (const bf16_t*)(F.ws + R_QA); const bf16_t* KVA = (const bf16_t*)(F.ws + R_KVA); const bf16_t* KR = (const bf16_t*)(F.ws + R_KR);
    const bf16_t* QB = (const bf16_t*)(F.ws + R_QB); const bf16_t* KB = (const bf16_t*)(F.ws + R_KB); const bf16_t* VB = (const bf16_t*)(F.ws + R_VB);
    bf16_t* O = (bf16_t*)(F.ws + R_O);
    LAS char* lds = (LAS char*)F.lds;
    float mfixB; { float gq = 0.f, gk = 0.f; const float* a = F.in[15] + li * 64; const float* b = F.in[16] + li * 64;
        for (int i = 0; i < 64; ++i) { gq = fmaxf(gq, fabsf(a[i])); gk = fmaxf(gk, fabsf(b[i])); } mfixB = 64.f * gq * gk * SC_B * 1.02f; }
    constexpr int NU = 2048 + 32;
    for (int u = F.vcu; u < NU; u += F.G) {
        if (u < 1024 || (u >= 2048 && u < 2064)) {
            const bool isctx = u >= 2048; const int uu = isctx ? u - 2048 : u;
            const int b = isctx ? (uu >> 3) : (uu >> 9), h = isctx ? (uu & 7) : ((uu >> 6) & 7), qb = uu & 63;
            const int q0 = isctx ? NLAT + b * CTXL : b * SEQ + qb * 256;
            att::attn_unit<96, false>(QA + (size_t)q0 * 768 + h * 96, 768, KVA + h * 128, 1024, KR, KVA + h * 128 + 64, 1024, O + (size_t)q0 * 1024 + h * 64,
                               b * SEQ, isctx ? 0 : 256, NLAT + b * CTXL, isctx ? 4 : 260, lds, F.tid, (const f32x2*)(F.ws + WS_ROPE), isctx ? -1 : qb * 256, 0.f);
        } else {
            const bool isctx = u >= 2064; const int uu = isctx ? u - 2064 : u - 1024;
            const int b = isctx ? (uu >> 3) : (uu >> 9), h = isctx ? (uu & 7) : ((uu >> 6) & 7), qb = uu & 63, kvh = h >> 2;
            const int q0 = isctx ? NLAT + b * CTXL : b * SEQ + qb * 256;
            att::attn_unit<64, true>(QB + (size_t)q0 * 512 + h * 64, 512, KB + kvh * 64, 128, nullptr, VB + kvh * 64, 128, O + (size_t)q0 * 1024 + 512 + h * 64,
                               b * SEQ, isctx ? 0 : 256, NLAT + b * CTXL, isctx ? 4 : 260, lds, F.tid, nullptr, -1, mfixB);
        }
    }
}

namespace na {
constexpr int TABH = 528;
constexpr int L_KC = 0, L_VC = 32768, VC_LD = 528, L_TAB = L_VC + 64 * VC_LD, L_END = L_TAB + TABH * 4;
struct Tile { bf16x8 kf[4]; bf16x8 vf[2][2]; };
__device__ __forceinline__ void load_tile(Tile& T, const bf16_t* kbase, const bf16_t* vbase, size_t vld, int r32, int hi) {
#pragma unroll
    for (int d0 = 0; d0 < 4; ++d0) T.kf[d0] = *(const bf16x8*)(kbase + (size_t)r32 * 2048 + d0 * 16 + hi * 8);
#pragma unroll
    for (int dv = 0; dv < 2; ++dv)
#pragma unroll
        for (int ks = 0; ks < 2; ++ks) T.vf[dv][ks] = *(const bf16x8*)(vbase + (size_t)(32 * dv + r32) * vld + 16 * ks + 8 * hi);
}
__device__ __forceinline__ void load_tile_lds(Tile& T, const LAS char* lds, int t, int r32, int hi) {
#pragma unroll
    for (int d0 = 0; d0 < 4; ++d0) T.kf[d0] = *(const LAS bf16x8*)(lds + L_KC + att::swz64(32 * t + r32, d0 * 2 + hi));
#pragma unroll
    for (int dv = 0; dv < 2; ++dv)
#pragma unroll
        for (int ks = 0; ks < 2; ++ks) T.vf[dv][ks] = *(const LAS bf16x8*)(lds + L_VC + (32 * dv + r32) * VC_LD + (32 * t + 16 * ks + 8 * hi) * 2);
}
constexpr int L_WST = L_END, WST_K = 0, WST_V = 4096, WST_VLD = 80, WST_BYTES = 4096 + 64 * 80;
struct RawTile { bf16x8 k[4], v[4]; };
__device__ __forceinline__ void load_raw(RawTile& T, const bf16_t* kbase, const bf16_t* vbase, int lane) {
#pragma unroll
    for (int i = 0; i < 4; ++i) { T.k[i] = *(const bf16x8*)(kbase + (size_t)(i * 8 + (lane >> 3)) * 2048 + (lane & 7) * 8);
                                  T.v[i] = *(const bf16x8*)(vbase + (size_t)(i * 16 + (lane >> 2)) * SEQ + (lane & 3) * 8); }
}
__device__ __forceinline__ void stage_raw(const RawTile& T, LAS char* w, int lane) {
#pragma unroll
    for (int i = 0; i < 4; ++i) { *(LAS bf16x8*)(w + WST_K + att::swz64(i * 8 + (lane >> 3), lane & 7)) = T.k[i];
                                  *(LAS bf16x8*)(w + WST_V + (i * 16 + (lane >> 2)) * WST_VLD + (lane & 3) * 16) = T.v[i]; }
}
__device__ __forceinline__ void load_tile_wst(Tile& T, const LAS char* w, int r32, int hi) {
#pragma unroll
    for (int d0 = 0; d0 < 4; ++d0) T.kf[d0] = *(const LAS bf16x8*)(w + WST_K + att::swz64(r32, d0 * 2 + hi));
#pragma unroll
    for (int dv = 0; dv < 2; ++dv)
#pragma unroll
        for (int ks = 0; ks < 2; ++ks) T.vf[dv][ks] = *(const LAS bf16x8*)(w + WST_V + (32 * dv + r32) * WST_VLD + (16 * ks + 8 * hi) * 2);
}
template <bool NBR> __device__ __forceinline__ void tile_step(const Tile& cur, const bf16x8 (&qr)[4], float& m_reg, float& l_reg, f32x16& o0, f32x16& o1,
                                                              bool vr, int dlt, const LAS float* tr, int hi) {
    f32x16 p = {};
#pragma unroll
    for (int d0 = 0; d0 < 4; ++d0) p = __builtin_amdgcn_mfma_f32_32x32x16_bf16(cur.kf[d0], qr[d0], p, 0, 0, 0);
    if (NBR) {
#pragma unroll
        for (int r = 0; r < 16; ++r) { const int kcl = (r & 3) + 8 * (r >> 2) + 4 * hi;
            const bool ok = vr && (kcl >= dlt) && (kcl < dlt + 16);
            p[r] = ok ? p[r] + tr[(r & 3) + 8 * (r >> 2)] : -3.0e38f; }
    }
    float pmax = p[0];
#pragma unroll
    for (int r = 1; r < 16; ++r) pmax = fmaxf(pmax, p[r]);
    { auto rr = __builtin_amdgcn_permlane32_swap(__float_as_uint(pmax), __float_as_uint(pmax), false, false);
      pmax = fmaxf(__uint_as_float(rr[0]), __uint_as_float(rr[1])); }
    if (!__all(pmax - m_reg <= att::THR2)) {
        const float mn = fmaxf(m_reg, pmax), alpha = __builtin_amdgcn_exp2f(m_reg - mn); m_reg = mn; l_reg *= alpha;
#pragma unroll
        for (int r = 0; r < 16; ++r) { o0[r] *= alpha; o1[r] *= alpha; }
    }
    float ps = 0.f;
#pragma unroll
    for (int r = 0; r < 16; ++r) { p[r] = __builtin_amdgcn_exp2f(p[r] - m_reg); ps += p[r]; }
    { auto rr = __builtin_amdgcn_permlane32_swap(__float_as_uint(ps), __float_as_uint(ps), false, false);
      ps = __uint_as_float(rr[0]) + __uint_as_float(rr[1]); }
    l_reg += ps;
    bf16x8 pa0, pa1;
    ATT_PK4(p, 0, pa0); ATT_PK4(p, 8, pa1);
    o0 = __builtin_amdgcn_mfma_f32_32x32x16_bf16(cur.vf[0][0], pa0, o0, 0, 0, 0);
    o0 = __builtin_amdgcn_mfma_f32_32x32x16_bf16(cur.vf[0][1], pa1, o0, 0, 0, 0);
    o1 = __builtin_amdgcn_mfma_f32_32x32x16_bf16(cur.vf[1][0], pa0, o1, 0, 0, 0);
    o1 = __builtin_amdgcn_mfma_f32_32x32x16_bf16(cur.vf[1][1], pa1, o1, 0, 0, 0);
}
__device__ __forceinline__ void store_o(bf16_t* Ow, const f32x16& o0, const f32x16& o1, float inv) {
#pragma unroll
    for (int g = 0; g < 4; ++g) {
        u32x2 w0, w1;
        w0.x = cvt_pk_bf16(o0[4 * g] * inv, o0[4 * g + 1] * inv); w0.y = cvt_pk_bf16(o0[4 * g + 2] * inv, o0[4 * g + 3] * inv);
        w1.x = cvt_pk_bf16(o1[4 * g] * inv, o1[4 * g + 1] * inv); w1.y = cvt_pk_bf16(o1[4 * g + 2] * inv, o1[4 * g + 3] * inv);
        *(u32x2*)(Ow + 8 * g) = w0; *(u32x2*)(Ow + 32 + 8 * g) = w1;
    }
}
__device__ __forceinline__ void na_phase(Frame& F, int li, bool need_ctx) {
    const bf16_t* QK = (const bf16_t*)(F.ws + R_QK); const bf16_t* Vt = (const bf16_t*)(F.ws + R_VT); const bf16_t* Vtc = (const bf16_t*)(F.ws + R_VTC);
    bf16_t* ON = (bf16_t*)(F.ws + R_ON);
    LAS char* lds = (LAS char*)F.lds; LAS float* tab = (LAS float*)(lds + L_TAB);
    const int r32 = F.lane & 31, hi = F.lane >> 5;
    for (int bi = F.vcu; bi < 256; bi += F.G) {
        const int bh = bi >> 3, b = bh >> 4, h = bh & 15, sub = bi & 7;
        __syncthreads();
        { const float* rpb = F.in[19] + ((size_t)li * 16 + h) * 465;
          for (int i = F.tid; i < TABH; i += NTHREADS) { const int j = i - 16; tab[i] = (j >= 0 && j < 465) ? rpb[j] * LOG2E : 0.f; }
          const bf16_t* ksrc = QK + (size_t)(NLAT + b * CTXL) * 2048 + 1024 + h * 64; const bf16_t* vsrc = Vtc + (size_t)(b * 16 + h) * 64 * CTXL;
#pragma unroll
          for (int i = 0; i < 4; ++i) { const int c = F.tid + NTHREADS * i;
              *(LAS bf16x8*)(lds + L_KC + att::swz64(c >> 3, c & 7)) = *(const bf16x8*)(ksrc + (size_t)(c >> 3) * 2048 + (c & 7) * 8);
              *(LAS bf16x8*)(lds + L_VC + (c >> 5) * VC_LD + (c & 31) * 16) = *(const bf16x8*)(vsrc + (size_t)(c >> 5) * CTXL + (c & 31) * 8); } }
        __syncthreads();
        for (int pi = F.wave; pi < 64; pi += NWAVES) {
            const int patch = sub * 64 + pi, R = 2 * (patch >> 2), C = 16 * (patch & 3);
            const int qrow = R + (r32 >> 4), qcol = C + (r32 & 15), mq = b * SEQ + qrow * 64 + qcol;
            const int krow_lo = min(max(R - 4, 0), 248), krow_hi = min(max(R - 3, 0), 248) + 7, nn = krow_hi - krow_lo + 1, kc0 = min(max(C - 8, 0), 32);
            const int rsq = min(max(qrow - 4, 0), 248), dlt = min(max(qcol - 8, 0), 48) - kc0;
            const LAS float* tb = tab + 16 + (kc0 - qcol + 15);
            bf16x8 qr[4];
#pragma unroll
            for (int d0 = 0; d0 < 4; ++d0) qr[d0] = *(const bf16x8*)(QK + (size_t)mq * 2048 + h * 64 + d0 * 16 + hi * 8);
            const bf16_t* kn_base = QK + (size_t)(b * SEQ + krow_lo * 64 + kc0) * 2048 + 1024 + h * 64;
            const bf16_t* vn_base = Vt + (size_t)(b * 16 + h) * 64 * SEQ + krow_lo * 64 + kc0;
            float m_reg = -1e30f, l_reg = 0.f; f32x16 o0 = {}, o1 = {};
            Tile cur; RawTile nb;
            LAS char* wst = lds + L_WST + F.wave * WST_BYTES;
            load_raw(nb, kn_base, vn_base, F.lane);
#pragma unroll 2
            for (int t = 0; t < 8; ++t) { load_tile_lds(cur, lds, t, r32, hi); tile_step<false>(cur, qr, m_reg, l_reg, o0, o1, false, 0, tb, hi); }
            for (int t = 0; t < nn; ++t) {
                stage_raw(nb, wst, F.lane);
                if (t + 1 < nn) load_raw(nb, kn_base + (size_t)(t + 1) * 64 * 2048, vn_base + (t + 1) * 64, F.lane);
                load_tile_wst(cur, wst, r32, hi);
                const int kr = krow_lo + t; const bool vr = (kr >= rsq) && (kr < rsq + 8); const int rt = min(max(kr - qrow + 7, 0), 14);
                tile_step<true>(cur, qr, m_reg, l_reg, o0, o1, vr, dlt, tb + rt * 31 + 4 * hi, hi);
            }
            store_o(ON + (size_t)mq * 1024 + h * 64 + 4 * hi, o0, o1, __builtin_amdgcn_rcpf(l_reg));
        }
    }
    if (need_ctx) {
        for (int it = F.gw; it < 2 * 16 * 8; it += F.NGW) {
            const int bh = it >> 3, b = bh >> 4, h = bh & 15, mq = NLAT + b * CTXL + (it & 7) * 32 + r32;
            bf16x8 qr[4];
#pragma unroll
            for (int d0 = 0; d0 < 4; ++d0) qr[d0] = *(const bf16x8*)(QK + (size_t)mq * 2048 + h * 64 + d0 * 16 + hi * 8);
            const bf16_t* kc_base = QK + (size_t)(NLAT + b * CTXL) * 2048 + 1024 + h * 64; const bf16_t* vc_base = Vtc + (size_t)(b * 16 + h) * 64 * CTXL;
            float m_reg = -1e30f, l_reg = 0.f; f32x16 o0 = {}, o1 = {};
            Tile cur, nxt;
            load_tile(cur, kc_base, vc_base, CTXL, r32, hi);
            for (int t = 0; t < 8; ++t) {
                if (t + 1 < 8) load_tile(nxt, kc_base + (size_t)(t + 1) * 32 * 2048, vc_base + (t + 1) * 32, CTXL, r32, hi);
                tile_step<false>(cur, qr, m_reg, l_reg, o0, o1, false, 0, tab, hi);
                cur = nxt;
            }
            store_o(ON + (size_t)mq * 1024 + h * 64 + 4 * hi, o0, o1, __builtin_amdgcn_rcpf(l_reg));
        }
    }
}
}


__device__ __forceinline__ void dbg_mean_abs(Frame& F, const bf16_t* p, int nrows, int ld, int ncols, int slot) {
    float s = 0.f;
    for (int r = F.gw; r < nrows; r += F.NGW)
        for (int c = F.lane * 8; c < ncols; c += 512) { const u32x4 w = *(const u32x4*)(p + (size_t)r * ld + c);
            s += fabsf(bf16lo(w.x)) + fabsf(bf16hi(w.x)) + fabsf(bf16lo(w.y)) + fabsf(bf16hi(w.y)) + fabsf(bf16lo(w.z)) + fabsf(bf16hi(w.z)) + fabsf(bf16lo(w.w)) + fabsf(bf16hi(w.w)); }
    s = wave_sum(s);
    if (F.lane == 0) atomicAdd((float*)(F.ctl + CW_DBG + slot), s / ((float)nrows * (float)ncols));
}

__device__ __forceinline__ void dbg_ri(Frame& F, int slot) {
    const u32x2* RI = (const u32x2*)(F.ws + R_RI); float s = 0.f;
    for (int r = F.gw * 64 + F.lane; r < 65536; r += F.NGW * 64) { const u32x2 ri = RI[r]; if (ri.x != 0xffffffffu) s += 0.5f + u2f(ri.y); }
    s = wave_sum(s);
    if (F.lane == 0) atomicAdd((float*)(F.ctl + CW_DBG + slot), s / 65536.f);
}

__device__ __forceinline__ void dbg_listw(Frame& F, int slot) {
    const u32x2* listw = (const u32x2*)(F.ws + WS_LIST); float s = 0.f;
    for (int e = 0; e < 32; ++e) { const int c = (int)__hip_atomic_load(F.ctl + CW_CNT + e * 64, RLX_AGENT);
        for (int j = F.gw * 64 + F.lane; j < c; j += F.NGW * 64) s += u2f(listw[(size_t)e * MROWS + j].y); }
    s = wave_sum(s);
    if (F.lane == 0) atomicAdd((float*)(F.ctl + CW_DBG + slot), s / 66560.f);
}

#ifndef DBG_CHECK
#define DBG_CHECK 0
#endif
#if DBG_CHECK
__device__ __forceinline__ unsigned hash_u(unsigned x) { x ^= x >> 16; x *= 0x7feb352du; x ^= x >> 15; x *= 0x846ca68bu; x ^= x >> 16; return x; }
__device__ __forceinline__ float bf2f(bf16_t v) { return u2f((unsigned)v << 16); }
__device__ __forceinline__ void dbg_max(Frame& F, int slot, float err) { if (F.lane == 0) atomicMax(F.ctl + CW_DBG + slot, __builtin_bit_cast(unsigned, err)); }
__device__ __forceinline__ void rope_ref(float& x1, float& x2, int i, int n, int gr, int gc) {
    const int ii = i < n ? i : i - n; const float inv = powf(10000.f, -(float)ii / (float)n), ang = (float)(i < n ? gr : gc) * inv;
    float sn, cs; sincosf(ang, &sn, &cs); const float a = x1 * cs - x2 * sn, b = x1 * sn + x2 * cs; x1 = a; x2 = b;
}
__device__ __forceinline__ void check_gemm(Frame& F, int slot, const bf16_t* A, int lda, const float* W, int K, int N, const bf16_t* C, int ldc, float scale, int M, int ns) {
    float worst = 0.f;
    for (int i = F.gw; i < ns; i += F.NGW) { const unsigned hsh = hash_u(i * 2654435761u + slot); const int row = hsh % (unsigned)M, col = (hsh >> 8) % (unsigned)N;
        float a = 0.f; for (int k = F.lane; k < K; k += 64) a += bf2f(A[(size_t)row * lda + k]) * W[(size_t)k * N + col];
        const float ref = wave_sum(a) * scale, got = bf2f(C[(size_t)row * ldc + col]); worst = fmaxf(worst, fabsf(got - ref) / (0.1f + fabsf(ref))); }
    dbg_max(F, slot, worst);
}
__device__ __forceinline__ void check_out0(Frame& F, int slot, int ns) {
    const float* X = (const float*)(F.ws + WS_X); const bf16_t* O = (const bf16_t*)(F.ws + R_O); const float* W = F.in[10]; const float* mod = (const float*)(F.ws + WS_MOD);
    float worst = 0.f;
    for (int i = F.gw; i < ns; i += F.NGW) { const unsigned hsh = hash_u(i * 2654435761u + slot); const int row = hsh % (unsigned)MROWS, col = (hsh >> 8) & 1023;
        float a = 0.f; for (int k = F.lane; k < 1024; k += 64) a += bf2f(O[(size_t)row * 1024 + k]) * W[(size_t)k * 1024 + col];
        const float xin = row < NLAT ? F.in[0][(size_t)row * 1024 + col] : F.in[2][(size_t)(row - NLAT) * 1024 + col];
        const float g1 = mod[(size_t)row_class(row) * 6144 + 2 * 1024 + col];
        const float ref = xin + g1 * wave_sum(a), got = X[(size_t)row * 1024 + col]; worst = fmaxf(worst, fabsf(got - ref) / (0.1f + fabsf(ref))); }
    dbg_max(F, slot, worst);
}
__device__ __forceinline__ void check_prep(Frame& F, int slot, int li, int ns) {
    const bf16_t* P = (const bf16_t*)(F.ws + R_P);
    const bf16_t* CQN = (const bf16_t*)(F.ws + R_CQN); const bf16_t* CKVN = (const bf16_t*)(F.ws + R_CKVN); const bf16_t* KR = (const bf16_t*)(F.ws + R_KR);
    const bf16_t* QB = (const bf16_t*)(F.ws + R_QB); const bf16_t* KB = (const bf16_t*)(F.ws + R_KB); const bf16_t* VB = (const bf16_t*)(F.ws + R_VB);
    const float* qn = F.in[11] + li * QLORA; const float* kvn = F.in[13] + li * KVLORA; const float* gqn = F.in[15] + li * 64; const float* gkn = F.in[16] + li * 64;
    float worst = 0.f;
#define CHK(got, ref) worst = fmaxf(worst, fabsf(bf2f(got) - (ref)) / (0.1f + fabsf(ref)))
    for (int i = F.gw; i < ns; i += F.NGW) { const unsigned hsh = hash_u(i * 2654435761u + slot); const int m = (i & 7) == 7 ? NLAT + hsh % NCTX : hsh % NLAT;
        const bf16_t* p = P + (size_t)m * AB_INP; const bool lat = m < NLAT; const int t = m & (SEQ - 1), gr = t >> 6, gc = t & 63;
        float s = 0.f; for (int c = F.lane; c < 384; c += 64) { const float v = bf2f(p[c]); s += v * v; }
        const float rq = rsqrtf(wave_sum(s) / 384.f + RMS_EPS);
        for (int c = F.lane; c < 384; c += 64) CHK(CQN[(size_t)m * 384 + c], bf2f(p[c]) * rq * qn[c]);
        s = 0.f; for (int c = F.lane; c < 256; c += 64) { const float v = bf2f(p[384 + c]); s += v * v; }
        const float rk = rsqrtf(wave_sum(s) / 256.f + RMS_EPS);
        for (int c = F.lane; c < 256; c += 64) CHK(CKVN[(size_t)m * 256 + c], bf2f(p[384 + c]) * rk * kvn[c]);
        if (F.lane < 16) { float x1 = bf2f(p[640 + 2 * F.lane]), x2 = bf2f(p[641 + 2 * F.lane]); if (lat) rope_ref(x1, x2, F.lane, 8, gr, gc);
            CHK(KR[(size_t)m * 32 + 2 * F.lane], x1); CHK(KR[(size_t)m * 32 + 2 * F.lane + 1], x2); }
        for (int pr = F.lane; pr < 256; pr += 64) { const int h = pr >> 5, i2 = pr & 31; float ss = 0.f;
            for (int d = 0; d < 64; ++d) { const float v = bf2f(p[672 + h * 64 + d]); ss += v * v; }
            const float r = rsqrtf(ss / 64.f + RMS_EPS);
            float x1 = bf2f(p[672 + h * 64 + 2 * i2]) * r * gqn[2 * i2], x2 = bf2f(p[672 + h * 64 + 2 * i2 + 1]) * r * gqn[2 * i2 + 1]; if (lat) rope_ref(x1, x2, i2, 16, gr, gc);
            CHK(QB[(size_t)m * 512 + h * 64 + 2 * i2], x1 * SC_B); CHK(QB[(size_t)m * 512 + h * 64 + 2 * i2 + 1], x2 * SC_B); }
        { const int h = F.lane >> 5, i2 = F.lane & 31; float ss = 0.f;
            for (int d = 0; d < 64; ++d) { const float v = bf2f(p[1184 + h * 64 + d]); ss += v * v; }
            const float r = rsqrtf(ss / 64.f + RMS_EPS);
            float x1 = bf2f(p[1184 + h * 64 + 2 * i2]) * r * gkn[2 * i2], x2 = bf2f(p[1184 + h * 64 + 2 * i2 + 1]) * r * gkn[2 * i2 + 1]; if (lat) rope_ref(x1, x2, i2, 16, gr, gc);
            CHK(KB[(size_t)m * 128 + h * 64 + 2 * i2], x1); CHK(KB[(size_t)m * 128 + h * 64 + 2 * i2 + 1], x2);
            CHK(VB[(size_t)m * 128 + 2 * F.lane], bf2f(p[1312 + 2 * F.lane])); CHK(VB[(size_t)m * 128 + 2 * F.lane + 1], bf2f(p[1313 + 2 * F.lane])); }
    }
#undef CHK
    dbg_max(F, slot, worst);
}
__device__ __forceinline__ void check_attn(Frame& F, int slot, int type, int ns) {
    const bf16_t* QA = (const bf16_t*)(F.ws + R_QA); const bf16_t* KVA = (const bf16_t*)(F.ws + R_KVA); const bf16_t* KR = (const bf16_t*)(F.ws + R_KR);
    const bf16_t* QB = (const bf16_t*)(F.ws + R_QB); const bf16_t* KB = (const bf16_t*)(F.ws + R_KB); const bf16_t* VB = (const bf16_t*)(F.ws + R_VB);
    const bf16_t* O = (const bf16_t*)(F.ws + R_O);
    LAS float* qs = (LAS float*)(F.lds + F.wave * 512);
    float worst = 0.f;
    for (int i = F.gw; i < ns; i += F.NGW) { const unsigned hsh = hash_u(i * 2654435761u + slot); const bool qctx = (i & 7) == 7;
        const int b = hsh & 1, h = (hsh >> 1) & 7, tq = qctx ? (hsh >> 4) % CTXL : (hsh >> 4) % SEQ, mq = qctx ? NLAT + b * CTXL + tq : b * SEQ + tq;
        const int DQ = type == 0 ? 96 : 64;
        for (int d = F.lane; d < DQ; d += 64) qs[d] = type == 0 ? bf2f(QA[(size_t)mq * 768 + h * 96 + d]) : bf2f(QB[(size_t)mq * 512 + h * 64 + d]);
        LDS_WAIT();
        if (type == 0 && !qctx && F.lane < 16) { float x1 = qs[64 + 2 * F.lane], x2 = qs[65 + 2 * F.lane]; rope_ref(x1, x2, F.lane, 8, tq >> 6, tq & 63); qs[64 + 2 * F.lane] = x1; qs[65 + 2 * F.lane] = x2; }
        LDS_WAIT();
        const int nk = qctx ? CTXL : SEQ + CTXL;
        float mx = -3.0e38f, emax = 0.f, rmax = 0.f;
        for (int pass = 0; pass < 5; ++pass) {
            float l = 0.f, o[16];
#pragma unroll
            for (int d = 0; d < 16; ++d) o[d] = 0.f;
            const int dv0 = (pass - 1) * 16;
            for (int j = F.lane; j < nk; j += 64) { const int kr = (qctx || j >= SEQ) ? NLAT + b * CTXL + (qctx ? j : j - SEQ) : b * SEQ + j;
                float sc = 0.f;
                if (type == 0) { const bf16_t* kp = KVA + (size_t)kr * 1024 + h * 128; const bf16_t* rp = KR + (size_t)kr * 32;
                    for (int d = 0; d < 64; ++d) sc += qs[d] * bf2f(kp[d]); for (int d = 0; d < 32; ++d) sc += qs[64 + d] * bf2f(rp[d]); }
                else { const bf16_t* kp = KB + (size_t)kr * 128 + (h >> 2) * 64; for (int d = 0; d < 64; ++d) sc += qs[d] * bf2f(kp[d]); }
                if (pass == 0) mx = fmaxf(mx, sc);
                else { const float pw = exp2f(sc - mx); l += pw; const bf16_t* vp = (type == 0 ? KVA + (size_t)kr * 1024 + h * 128 + 64 : VB + (size_t)kr * 128 + (h >> 2) * 64) + dv0;
#pragma unroll
                    for (int d = 0; d < 16; ++d) o[d] += pw * bf2f(vp[d]); } }
            if (pass == 0) { for (int s2 = 1; s2 < 64; s2 <<= 1) mx = fmaxf(mx, __shfl_xor(mx, s2)); }
            else { l = wave_sum(l);
#pragma unroll
                for (int d = 0; d < 16; ++d) { const float ref = wave_sum(o[d]) / l, got = bf2f(O[(size_t)mq * 1024 + (type == 0 ? 0 : 512) + h * 64 + dv0 + d]); emax = fmaxf(emax, fabsf(got - ref)); rmax = fmaxf(rmax, fabsf(ref)); } }
        }
        worst = fmaxf(worst, emax / (rmax + 1e-9f));
    }
    dbg_max(F, slot, worst);
}
__device__ __forceinline__ void check_na(Frame& F, int slot, int li, bool need_ctx, int ns) {
    const bf16_t* QK = (const bf16_t*)(F.ws + R_QK); const bf16_t* Vt = (const bf16_t*)(F.ws + R_VT); const bf16_t* Vtc = (const bf16_t*)(F.ws + R_VTC); const bf16_t* ON = (const bf16_t*)(F.ws + R_ON);
    const float* rpb = F.in[19] + (size_t)li * 16 * 465;
    LAS float* qs = (LAS float*)(F.lds + F.wave * 512);
    float worst = 0.f;
    for (int i = F.gw; i < ns; i += F.NGW) { const unsigned hsh = hash_u(i * 2654435761u + slot); const bool qctx = need_ctx && (i & 7) == 7;
        const int b = hsh & 1, h = (hsh >> 1) & 15; int tq = qctx ? (hsh >> 5) % CTXL : (hsh >> 5) % SEQ;
        if (!qctx && (i & 7) == 1) tq = ((hsh >> 5) & 7) * 64 + ((hsh >> 9) & 63) + ((hsh >> 20) & 1) * (SEQ - 512);
        const int mq = qctx ? NLAT + b * CTXL + tq : b * SEQ + tq, r = tq >> 6, c = tq & 63;
        if (F.lane < 64) qs[F.lane] = bf2f(QK[(size_t)mq * 2048 + h * 64 + F.lane]);
        LDS_WAIT();
        const int rs = min(max(r - 4, 0), GRIDH - 8), cs = min(max(c - 8, 0), GRIDW - 16);
        const int nk = qctx ? CTXL : 128 + CTXL;
        float mx = -3.0e38f;
        for (int pass = 0; pass < 2; ++pass) {
            float l = 0.f, o[64];
#pragma unroll
            for (int d = 0; d < 64; ++d) o[d] = 0.f;
            for (int j = F.lane; j < nk; j += 64) { const bool nb = !qctx && j < 128;
                const int kr_ = rs + (j >> 4), kc_ = cs + (j & 15);
                const int krow = nb ? b * SEQ + kr_ * 64 + kc_ : NLAT + b * CTXL + (qctx ? j : j - 128);
                const bf16_t* kp = QK + (size_t)krow * 2048 + 1024 + h * 64; float sc = 0.f;
                for (int d = 0; d < 64; ++d) sc += qs[d] * bf2f(kp[d]);
                if (nb) sc += rpb[h * 465 + (kr_ - r + 7) * 31 + (kc_ - c + 15)] * LOG2E;
                if (pass == 0) mx = fmaxf(mx, sc);
                else { const float pw = exp2f(sc - mx); l += pw;
#pragma unroll
                    for (int d = 0; d < 64; ++d) o[d] += pw * (nb ? bf2f(Vt[((size_t)(b * 16 + h) * 64 + d) * SEQ + kr_ * 64 + kc_]) : bf2f(Vtc[((size_t)(b * 16 + h) * 64 + d) * CTXL + (qctx ? j : j - 128)])); } }
            if (pass == 0) { for (int s2 = 1; s2 < 64; s2 <<= 1) mx = fmaxf(mx, __shfl_xor(mx, s2)); }
            else { l = wave_sum(l); float emax = 0.f, rmax = 0.f;
#pragma unroll
                for (int d = 0; d < 64; ++d) { const float ref = wave_sum(o[d]) / l, got = bf2f(ON[(size_t)mq * 1024 + h * 64 + d]); emax = fmaxf(emax, fabsf(got - ref)); rmax = fmaxf(rmax, fabsf(ref)); }
                worst = fmaxf(worst, emax / (rmax + 1e-9f)); } }
    }
    dbg_max(F, slot, worst);
}
#endif

constexpr int PH_PER_LAYER = 12, NPH = 2 + DEPTH * PH_PER_LAYER;
__global__ void __launch_bounds__(NTHREADS, 2) fwd(Args args) {
    extern __shared__ __attribute__((aligned(16))) unsigned char lds_raw[];
    Frame F;
    F.lds = (LAS unsigned char*)lds_raw; F.ws = args.ws; F.ctl = (unsigned*)(args.ws + WS_CTL); F.in = args.in;
    F.tid = threadIdx.x; F.lane = F.tid & 63; F.wave = __builtin_amdgcn_readfirstlane(F.tid >> 6);
    F.G = gridDim.x; { const int bx = blockIdx.x; F.vcu = (F.G % 8 == 0) ? (bx % 8) * (F.G / 8) + bx / 8 : bx; }
    F.gw = F.vcu * NWAVES + F.wave; F.NGW = F.G * NWAVES;
    volatile LAS unsigned* MISC = (volatile LAS unsigned*)(F.lds + MISC_OFF);
    if (F.tid < 16) MISC[F.tid] = 0u;
    __syncthreads();
    const int lo = args.ph_lo, hi = args.ph_hi;
    XcdBarrier bar; bar.bar = F.ctl + CW_BAR; bar.x = 0; bar.st = MISC;
    if (hi - lo > 1) bar = xcd_barrier_post(F.ctl + CW_BAR, MISC);
#define OPAQUE_V(x) asm volatile("" : "+v"(x))
#define OPAQUE_S(x) asm volatile("" : "+s"(x))
#define PHASE_BEGIN() do { GAS unsigned char* _ws = (GAS unsigned char*)args.ws; OPAQUE_S(_ws); F.ws = (unsigned char*)_ws; F.ctl = (unsigned*)(F.ws + WS_CTL); int _t = threadIdx.x; OPAQUE_V(_t); F.tid = _t; F.lane = _t & 63; \
    F.wave = __builtin_amdgcn_readfirstlane(_t >> 6); int _bx = blockIdx.x; OPAQUE_S(_bx); bx = _bx; F.vcu = (F.G % 8 == 0) ? (_bx % 8) * (F.G / 8) + _bx / 8 : _bx; F.gw = F.vcu * NWAVES + F.wave; \
    mod = (const float*)(F.ws + WS_MOD); } while (0)
#define RUN(k) ((k) >= lo && (k) < hi)
#define SEAM(k) do { if ((k) + 1 < hi) xcd_barrier(bar); } while (0)
    LAS unsigned char* ring = F.lds;
    const float* mod; int bx;

    if (RUN(0)) { PHASE_BEGIN(); if (EN_P0) for (int rep_ = 0; rep_ < REP_P0; ++rep_) { p0_prologue(F); __syncthreads(); } SEAM(0); }


#if DBG_CHECK == 2
#define CHECK_E2(l, li)
#define CHECK_PREP(l, li)
#define CHECK_UP(l, li)
#define CHECK_ATT(l, li) { check_attn(F, 32 + (l), 0, 2048); check_attn(F, 36 + (l), 1, 2048); __syncthreads(); }
#define CHECK_OUT(l, li)
#define CHECK_NA(l, li, nc)
#elif DBG_CHECK
#define CHECK_E2(l, li) { check_gemm(F, 16 + (l), (const bf16_t*)(F.ws + WS_H), 1024, F.in[9] + (size_t)(li) * 1024 * 1440, 1024, 1440, (const bf16_t*)(F.ws + R_P), AB_INP, 1.f, MROWS, 4096); }
#define CHECK_PREP(l, li) { check_prep(F, 20 + (l), li, 2048); }
#define CHECK_UP(l, li) { check_gemm(F, 24 + (l), (const bf16_t*)(F.ws + R_CQN), 384, F.in[12] + (size_t)(li) * 384 * 768, 384, 768, (const bf16_t*)(F.ws + R_QA), 768, SC_A, MROWS, 4096); \
                          check_gemm(F, 28 + (l), (const bf16_t*)(F.ws + R_CKVN), 256, F.in[14] + (size_t)(li) * 256 * 1024, 256, 1024, (const bf16_t*)(F.ws + R_KVA), 1024, 1.f, MROWS, 4096); }
#define CHECK_ATT(l, li) { check_attn(F, 32 + (l), 0, 2048); check_attn(F, 36 + (l), 1, 2048); __syncthreads(); }
#define CHECK_OUT(l, li) { if ((l) == 0) check_out0(F, 40, 4096); }
#define CHECK_NA(l, li, nc) { check_na(F, 44 + (l), li, nc, 4096); __syncthreads(); }
#else
#define CHECK_E2(l, li)
#define CHECK_PREP(l, li)
#define CHECK_UP(l, li)
#define CHECK_ATT(l, li)
#define CHECK_OUT(l, li)
#define CHECK_NA(l, li, nc)
#endif
#define LAYER_BODY(LL) { constexpr int l = (LL); \
        const int pb = 1 + l * PH_PER_LAYER, li = l >> 1; \
        if (RUN(pb)) { PHASE_BEGIN(); if (EN_NORM) mix_norm_phase(F, l); SEAM(pb); } \
        if ((l & 1) == 0) { \
            if (RUN(pb + 1)) { PHASE_BEGIN(); \
                pg8::Gemm g{(const bf16_t*)(F.ws + WS_H), (const bf16_t*)(F.ws + WS_WIN) + (size_t)li * AB_INP * 1024, 1024, 1024}; \
                pg8::StaticOrder S; S.init(MROWS / 256, AB_INP / 256, F.G, bx); \
                EpiStore E{(bf16_t*)(F.ws + R_P), AB_INP}; \
                if (EN_GEMM & 1) { pg8::gemm_phase<EpiStore, pg8::StaticOrder, true>(ring, g, S, E, F.tid); if (REP_IN >= 2) pg8::gemm_phase<EpiStore, pg8::StaticOrder, true>(ring, g, S, E, F.tid); if (REP_IN >= 3) pg8::gemm_phase<EpiStore, pg8::StaticOrder, true>(ring, g, S, E, F.tid); } \
                SEAM(pb + 1); CHECK_E2(l, li) \
            } \
            if (RUN(pb + 2)) { PHASE_BEGIN(); if (EN_PREP) for (int rep_ = 0; rep_ < REP_PREP; ++rep_) ab_prep_phase(F, li); SEAM(pb + 2); CHECK_PREP(l, li) } \
            if (RUN(pb + 3)) { PHASE_BEGIN(); \
                { pg8::Gemm g{(const bf16_t*)(F.ws + R_CQN), (const bf16_t*)(F.ws + WS_WQUP) + (size_t)li * 768 * 384, QLORA, QLORA}; \
                  pg8::StaticOrder S; S.init(MROWS / 256, 3, F.G, bx); \
                  EpiStore E{(bf16_t*)(F.ws + R_QA), 768}; \
                  if (EN_GEMM & 2) { pg8::gemm_phase<EpiStore, pg8::StaticOrder, true>(ring, g, S, E, F.tid); if (REP_UP >= 2) pg8::gemm_phase<EpiStore, pg8::StaticOrder, true>(ring, g, S, E, F.tid); } } \
                { pg8::Gemm g{(const bf16_t*)(F.ws + R_CKVN), (const bf16_t*)(F.ws + WS_WKVUP) + (size_t)li * 1024 * 256, KVLORA, KVLORA}; \
                  pg8::StaticOrder S; S.init(MROWS / 256, 4, F.G, (bx + 134) % F.G); \
                  EpiStore E{(bf16_t*)(F.ws + R_KVA), 1024}; \
                  if (EN_GEMM & 4) { pg8::gemm_phase<EpiStore, pg8::StaticOrder, true>(ring, g, S, E, F.tid); if (REP_UP >= 2) pg8::gemm_phase<EpiStore, pg8::StaticOrder, true>(ring, g, S, E, F.tid); } } \
                SEAM(pb + 3); CHECK_UP(l, li) \
            } \
            if (RUN(pb + 4)) { PHASE_BEGIN(); if (EN_ATT) for (int rep_ = 0; rep_ < REP_ATT; ++rep_) { attn_phase(F, li); if (rep_ + 1 < REP_ATT) __syncthreads(); } SEAM(pb + 4); CHECK_ATT(l, li) } \
            if (RUN(pb + 5)) { PHASE_BEGIN(); \
                pg8::Gemm g{(const bf16_t*)(F.ws + R_O), (const bf16_t*)(F.ws + WS_WOUT) + (size_t)li * 1024 * 1024, 1024, 1024}; \
                pg8::StaticOrder S; S.init(MROWS / 256, 4, F.G, bx); \
                EpiOut E{(float*)(F.ws + WS_X), mod + (size_t)l * 3 * 6144, l == 0 ? F.in[0] : (const float*)(F.ws + WS_X), l == 0 ? F.in[2] : (const float*)(F.ws + WS_X) + (size_t)NLAT * 1024}; \
                if (EN_GEMM & 8) pg8::gemm_phase<EpiOut, pg8::StaticOrder, true>(ring, g, S, E, F.tid); \
                SEAM(pb + 5); CHECK_OUT(l, li) \
            } \
        } else { \
            const bool last = (l == DEPTH - 1); \
            if (RUN(pb + 1)) { PHASE_BEGIN(); \
                pg8::Gemm g{(const bf16_t*)(F.ws + WS_H), (const bf16_t*)(F.ws + WS_NIN) + (size_t)li * 3072 * 1024, 1024, 1024}; \
                pg8::StaticOrder S; S.init(MROWS / 256, 12, F.G, bx); \
                EpiNaIn E{(bf16_t*)(F.ws + R_QK), (bf16_t*)(F.ws + R_VT), (bf16_t*)(F.ws + R_VTC)}; \
                if (EN_GEMM & 16) { pg8::gemm_phase<EpiNaIn, pg8::StaticOrder, true>(ring, g, S, E, F.tid); if (REP_IN >= 2) pg8::gemm_phase<EpiNaIn, pg8::StaticOrder, true>(ring, g, S, E, F.tid); if (REP_IN >= 3) pg8::gemm_phase<EpiNaIn, pg8::StaticOrder, true>(ring, g, S, E, F.tid); } \
                SEAM(pb + 1); \
            } \
            if (RUN(pb + 4)) { PHASE_BEGIN(); if (EN_NA) for (int rep_ = 0; rep_ < REP_NA; ++rep_) { na::na_phase(F, li, !last); if (rep_ + 1 < REP_NA) __syncthreads(); } SEAM(pb + 4); CHECK_NA(l, li, !last) } \
            if (RUN(pb + 5)) { PHASE_BEGIN(); \
                pg8::Gemm g{(const bf16_t*)(F.ws + R_ON), (const bf16_t*)(F.ws + WS_NOUT) + (size_t)li * 1024 * 1024, 1024, 1024}; \
                pg8::StaticOrder S; S.init((last ? NLAT : MROWS) / 256, 4, F.G, bx); \
                EpiOut E{(float*)(F.ws + WS_X), mod + (size_t)l * 3 * 6144, (const float*)(F.ws + WS_X), (const float*)(F.ws + WS_X) + (size_t)NLAT * 1024}; \
                if (EN_GEMM & 32) pg8::gemm_phase<EpiOut, pg8::StaticOrder, true>(ring, g, S, E, F.tid); \
                SEAM(pb + 5); \
            } \
        } \
        if (RUN(pb + 6)) { PHASE_BEGIN(); if (EN_ROUTE) ffn_norm_route_phase(F, l); SEAM(pb + 6); } \
                if (RUN(pb + 8)) { PHASE_BEGIN(); \
            moe_tile_map(F, l); \
            if (DBG_SEL == 0 && l == 0 && blockIdx.x == 0 && F.tid == 0) F.ctl[CW_DBG + 0] = __builtin_bit_cast(unsigned, 0.001f * (float)*(const LAS int*)(F.lds + MOE_NT_OFF)); \
            pg8::Gemm g{(const bf16_t*)(F.ws + WS_H), (const bf16_t*)(F.ws + WS_MOEW + (size_t)l * MOEW_LAYER), 1024, 1024}; \
            pg8::MoeGatherOrder S; S.tile_e = (const LAS int*)(F.lds + TILE_E_OFF); S.nT = *(const LAS int*)(F.lds + MOE_NT_OFF); S.G = F.G; S.c = bx; S.estride = (size_t)1024 * 1024; \
            S.lcnt = (const LAS int*)(F.lds + CNTL_OFF); S.lbase = S.lcnt + 32; S.list = (const u32x2*)(F.ws + WS_LIST); \
            EpiMoe1 E{(bf16_t*)(F.ws + R_ACT)}; \
            if (EN_GEMM & 64) { pg8::gemm_phase<EpiMoe1, pg8::MoeGatherOrder, true>(ring, g, S, E, F.tid); if (REP_MOE >= 2) pg8::gemm_phase<EpiMoe1, pg8::MoeGatherOrder, true>(ring, g, S, E, F.tid); if (REP_MOE >= 3) pg8::gemm_phase<EpiMoe1, pg8::MoeGatherOrder, true>(ring, g, S, E, F.tid); } \
            SEAM(pb + 8); if (DBG_SEL == 2 && l == 0) dbg_mean_abs(F, (const bf16_t*)(F.ws + R_ACT), 65536, 512, 512, 2); \
        } \
        if (RUN(pb + 9)) { PHASE_BEGIN(); \
            moe_tile_map(F, l); \
            pg8::Gemm g{(const bf16_t*)(F.ws + R_ACT), (const bf16_t*)(F.ws + WS_MOEW + (size_t)l * MOEW_LAYER + MOEW_DN), 512, 512}; \
            pg8::MoeOrder S{(const LAS int*)(F.lds + TILE_E_OFF), *(const LAS int*)(F.lds + MOE_NT_OFF), F.G, bx, (size_t)1024 * 512}; \
            EpiMoe2 E{(bf16_t*)(F.ws + R_Y), (const LAS int*)(F.lds + TILE_E_OFF), (const LAS int*)(F.lds + CNTL_OFF), (const LAS int*)(F.lds + CNTL_OFF) + 32, (const u32x2*)(F.ws + WS_LIST)}; if (DBG_SEL == 4 && l == 0) dbg_ri(F, 4); if (DBG_SEL == 6 && l == 0) dbg_listw(F, 6); if (DBG_SEL == 5 && l == 0) dbg_mean_abs(F, (const bf16_t*)(F.ws + WS_MOEW + MOEW_DN), 32768, 512, 512, 5); \
            if (EN_GEMM & 128) { pg8::gemm_phase<EpiMoe2, pg8::MoeOrder, true>(ring, g, S, E, F.tid); if (REP_MOE >= 2) pg8::gemm_phase<EpiMoe2, pg8::MoeOrder, true>(ring, g, S, E, F.tid); if (REP_MOE >= 3) pg8::gemm_phase<EpiMoe2, pg8::MoeOrder, true>(ring, g, S, E, F.tid); } \
            SEAM(pb + 9); if (DBG_SEL == 1 && l == 0) dbg_mean_abs(F, (const bf16_t*)(F.ws + R_Y), 65536, 1024, 1024, 1); \
        } \
    }
    LAYER_BODY(0)
    LAYER_BODY(1)
    LAYER_BODY(2)
    LAYER_BODY(3)
#undef LAYER_BODY
    if (RUN(NPH - 1)) { PHASE_BEGIN(); if (EN_FINAL) final_phase(F, args.out); }
#undef RUN
#undef SEAM
}

extern "C" void kernel_launch(void* const* d_in, const int* in_sizes, int n_in, void* d_out, int out_size, void* d_ws, size_t ws_size, hipStream_t stream) {
    static int grid = 0;
    if (grid == 0) {
        if (n_in != 27 || out_size != NLAT * DM || ws_size < WS_END) { fprintf(stderr, "kernel_launch: unexpected shapes: n_in %d out %d ws %zu (need %zu)\n", n_in, out_size, ws_size, (size_t)WS_END); grid = -1; return; }
        int dev = 0, cus = 0, per_cu = 0;
        if (hipGetDevice(&dev) != hipSuccess || hipDeviceGetAttribute(&cus, hipDeviceAttributeMultiprocessorCount, dev) != hipSuccess) { grid = -1; return; }
        if (hipFuncSetAttribute((const void*)fwd, hipFuncAttributeMaxDynamicSharedMemorySize, LDS_BYTES) != hipSuccess) { fprintf(stderr, "kernel_launch: hipFuncSetAttribute failed\n"); grid = -1; return; }
        if (hipOccupancyMaxActiveBlocksPerMultiprocessor(&per_cu, (const void*)fwd, NTHREADS, LDS_BYTES) != hipSuccess || per_cu < 1)
            fprintf(stderr, "kernel_launch: occupancy query reports %d workgroups per CU\n", per_cu);
        (void)hipGetLastError();
        grid = cus;
    }
    if (grid < 0) return;
    if (hipMemsetAsync((char*)d_ws + WS_CTL, 0, CTL_ZERO_BYTES, stream) != hipSuccess) return;
    Args a{};
    for (int i = 0; i < 27; ++i) a.in[i] = (const float*)d_in[i];
    a.out = (float*)d_out; a.ws = (unsigned char*)d_ws;
#if MK_PER_PHASE
    for (int p = 0; p < NPH; ++p) { a.ph_lo = p; a.ph_hi = p + 1; hipLaunchKernelGGL(fwd, dim3(grid), dim3(NTHREADS), LDS_BYTES, stream, a); }
#else
    a.ph_lo = 0; a.ph_hi = NPH;
    hipLaunchKernelGGL(fwd, dim3(grid), dim3(NTHREADS), LDS_BYTES, stream, a);
#endif
    const hipError_t le = hipPeekAtLastError();
    if (le != hipSuccess) fprintf(stderr, "kernel_launch: launch failed: %s\n", hipGetErrorName(le));
}
```

```cpp
#include <hip/hip_runtime.h>
#include <cstdio>
#include <cstdint>

#ifndef MK_PER_PHASE
#define MK_PER_PHASE 0
#endif


#ifndef EN_P0
#define EN_P0 1
#endif
#ifndef EN_NORM
#define EN_NORM 1
#endif
#ifndef EN_PREP
#define EN_PREP 1
#endif
#ifndef EN_ATT
#define EN_ATT 1
#endif
#ifndef EN_NA
#define EN_NA 1
#endif
#ifndef EN_ROUTE
#define EN_ROUTE 1
#endif
#ifndef EN_GATHER
#define EN_GATHER 1
#endif
#ifndef EN_FINAL
#define EN_FINAL 1
#endif
#ifndef EN_GEMM
#define EN_GEMM 255
#endif
#ifndef REP_PREP
#define REP_PREP 1
#endif
#ifndef REP_GATHER
#define REP_GATHER 1
#endif
#ifndef REP_UP
#define REP_UP 1
#endif
#ifndef REP_ATT
#define REP_ATT 1
#endif
#ifndef REP_NA
#define REP_NA 1
#endif
#ifndef REP_P0
#define REP_P0 1
#endif
#ifndef REP_MOE
#define REP_MOE 1
#endif
#ifndef REP_IN
#define REP_IN 1
#endif
#ifndef NOBAR_PROBE
#define NOBAR_PROBE 0
#endif
#ifndef EXP_PROBE
#define EXP_PROBE 0
#endif
#ifndef DBG_SEL
#define DBG_SEL -1
#endif
#ifndef W_CONST
#define W_CONST 0.f
#endif
#ifndef MOE_ALPHA
#define MOE_ALPHA 1.f
#endif
#define GAS __attribute__((address_space(1)))
#define LAS __attribute__((address_space(3)))
typedef unsigned short bf16_t;
typedef short bf16x8 __attribute__((ext_vector_type(8)));
typedef short s16x4 __attribute__((ext_vector_type(4)));
typedef float f32x4 __attribute__((ext_vector_type(4)));
typedef float f32x2 __attribute__((ext_vector_type(2)));
typedef float f32x16 __attribute__((ext_vector_type(16)));
typedef unsigned u32x4 __attribute__((ext_vector_type(4)));
typedef unsigned u32x2 __attribute__((ext_vector_type(2)));

constexpr int DM = 1024, SEQ = 16384, NLAT = 32768, CTXL = 256, NCTX = 512, MROWS = NLAT + NCTX;
constexpr int DEPTH = 4, GRIDW = 64, GRIDH = 256;
constexpr int AB_IN = 1440, AB_INP = 1536, QLORA = 384, KVLORA = 256;
constexpr int NEXP = 32, DEXP = 512;
constexpr float LOG2E = 1.4426950408889634f;
constexpr float SC_A = 0.10206207261596577f * LOG2E;
constexpr float SC_B = 0.125f * LOG2E;
constexpr float RMS_EPS = 1e-6f;
constexpr int NWAVES = 8, NTHREADS = 512;

constexpr size_t MiB = 1u << 20;
constexpr size_t WS_CTL = 0, CTL_ZERO_BYTES = 1 * MiB;
constexpr size_t WS_MOD = 1 * MiB;
constexpr size_t WS_ROPE = WS_MOD + 512 * 1024;
constexpr size_t WS_WIN = 2 * MiB;
constexpr size_t WS_WQUP = 8 * MiB;
constexpr size_t WS_WKVUP = 10 * MiB;
constexpr size_t WS_WOUT = 11 * MiB;
constexpr size_t WS_NIN = 15 * MiB;
constexpr size_t WS_NOUT = 27 * MiB;
constexpr size_t WS_LIST = 31 * MiB;
constexpr size_t WS_X = 41 * MiB;
constexpr size_t WS_H = 171 * MiB;
constexpr size_t WS_R = 236 * MiB;
constexpr size_t R_P = WS_R;
constexpr size_t R_CQN = R_P + 98 * MiB;
constexpr size_t R_CKVN = R_CQN + 25 * MiB;
constexpr size_t R_QA = R_CKVN + 17 * MiB;
constexpr size_t R_KVA = R_QA + 49 * MiB;
constexpr size_t R_KR = R_KVA + 65 * MiB;
constexpr size_t R_QB = R_KR + 3 * MiB;
constexpr size_t R_KB = R_QB + 33 * MiB;
constexpr size_t R_VB = R_KB + 9 * MiB;
constexpr size_t R_O = R_P;
constexpr size_t R_EVEN_END = R_VB + 9 * MiB;
constexpr size_t R_QK = WS_R;
constexpr size_t R_VT = R_QK + 130 * MiB;
constexpr size_t R_VTC = R_VT + 64 * MiB;
constexpr size_t R_ON = R_VTC + 1 * MiB;
constexpr size_t R_ODD_END = R_ON + 65 * MiB;
constexpr int MOE_MAXT = 292;
constexpr size_t R_XB = WS_R;
constexpr size_t R_ACT = R_XB + 146 * MiB;
constexpr size_t R_RI = R_ACT + 73 * MiB;
constexpr size_t R_Y = R_RI + 1 * MiB;
constexpr size_t R_MOE_END = R_Y + 130 * MiB;
constexpr size_t WS_MOEW = 606 * MiB;
constexpr size_t MOEW_LAYER = 96 * MiB, MOEW_DN = 64 * MiB;
constexpr size_t WS_END = WS_MOEW + 4 * MOEW_LAYER;
static_assert(R_EVEN_END <= WS_MOEW && R_ODD_END <= WS_MOEW && R_MOE_END <= WS_MOEW, "overlay region");
static_assert(WS_END <= 1024 * MiB, "workspace");

constexpr int CW_BAR = 4096;
constexpr int CW_DBG = 8192;
constexpr int CW_CNT = 16384;
static_assert((CW_CNT + 4 * 32 * 64) * 4 <= (int)CTL_ZERO_BYTES, "ctl");

constexpr int RING_BYTES = 131072;
constexpr int TAB_LD = 1028;
constexpr int LDS_TAB = 36 * TAB_LD * 4;
constexpr int MISC_OFF = LDS_TAB;
constexpr int TILE_E_OFF = MISC_OFF + 64;
constexpr int MOE_NT_OFF = TILE_E_OFF + 1280;
constexpr int CNTL_OFF = MOE_NT_OFF + 16;
constexpr int REC_OFF = CNTL_OFF + 256;
constexpr int LDS_BYTES = REC_OFF + 3584;
static_assert(LDS_BYTES <= 163840, "LDS");

#define RLX_AGENT __ATOMIC_RELAXED, __HIP_MEMORY_SCOPE_AGENT
#define LDS_WAIT() asm volatile("s_waitcnt lgkmcnt(0)" ::: "memory")
#define VM_WAIT() asm volatile("s_waitcnt vmcnt(0)" ::: "memory")
#define SBAR() __builtin_amdgcn_sched_barrier(0)

__device__ __forceinline__ unsigned cvt_pk_bf16(float lo, float hi) { unsigned r; asm volatile("v_cvt_pk_bf16_f32 %0, %1, %2" : "=v"(r) : "v"(lo), "v"(hi)); return r; }
__device__ __forceinline__ float u2f(unsigned u) { return __builtin_bit_cast(float, u); }
__device__ __forceinline__ float bf16lo(unsigned w) { return __builtin_bit_cast(float, w << 16); }
__device__ __forceinline__ float bf16hi(unsigned w) { return __builtin_bit_cast(float, w & 0xffff0000u); }
__device__ __forceinline__ float wave_sum(float v) {
    v += __builtin_bit_cast(float, __builtin_amdgcn_update_dpp(0, __builtin_bit_cast(int, v), 0xB1, 0xF, 0xF, true));
    v += __builtin_bit_cast(float, __builtin_amdgcn_update_dpp(0, __builtin_bit_cast(int, v), 0x4E, 0xF, 0xF, true));
    v += __builtin_bit_cast(float, __builtin_amdgcn_update_dpp(0, __builtin_bit_cast(int, v), 0x141, 0xF, 0xF, true));
    v += __builtin_bit_cast(float, __builtin_amdgcn_update_dpp(0, __builtin_bit_cast(int, v), 0x140, 0xF, 0xF, true));
    { auto rr = __builtin_amdgcn_permlane16_swap(__float_as_uint(v), __float_as_uint(v), false, false); v = __uint_as_float(rr[0]) + __uint_as_float(rr[1]); }
    { auto rr = __builtin_amdgcn_permlane32_swap(__float_as_uint(v), __float_as_uint(v), false, false); v = __uint_as_float(rr[0]) + __uint_as_float(rr[1]); }
    return v;
}
__device__ __forceinline__ float wave_sum2(float a, float b) {
    float v; { auto rr = __builtin_amdgcn_permlane32_swap(__float_as_uint(a), __float_as_uint(b), false, false); v = __uint_as_float(rr[0]) + __uint_as_float(rr[1]); }
    v += __builtin_bit_cast(float, __builtin_amdgcn_update_dpp(0, __builtin_bit_cast(int, v), 0xB1, 0xF, 0xF, true));
    v += __builtin_bit_cast(float, __builtin_amdgcn_update_dpp(0, __builtin_bit_cast(int, v), 0x4E, 0xF, 0xF, true));
    v += __builtin_bit_cast(float, __builtin_amdgcn_update_dpp(0, __builtin_bit_cast(int, v), 0x141, 0xF, 0xF, true));
    v += __builtin_bit_cast(float, __builtin_amdgcn_update_dpp(0, __builtin_bit_cast(int, v), 0x140, 0xF, 0xF, true));
    { auto rr = __builtin_amdgcn_permlane16_swap(__float_as_uint(v), __float_as_uint(v), false, false); v = __uint_as_float(rr[0]) + __uint_as_float(rr[1]); }
    return v;
}
__device__ __forceinline__ int row_class(int m) { return m < SEQ ? 0 : (m < NLAT ? 1 : 2); }

namespace pg8 {
constexpr int BM = 256, BK = 64, HALF = 128, HTB = HALF * BK * 2, STAGE_BYTES = 8 * HTB, NXCD = 8, WGM = 8;
__host__ __device__ __forceinline__ int lds_byte(int r, int c) { const int st = (r >> 4) * 2 + (c >> 5), rr = r & 15, cc = c & 31, ob = rr * 64 + cc * 2; return st * 1024 + (ob ^ (((ob >> 9) & 1) << 5)); }
__host__ __device__ __forceinline__ void stage_rc(int b, int& R, int& C) { const int st = b / 1024, sb = b % 1024, swz = sb ^ (((sb >> 9) & 1) << 5); R = (st >> 1) * 16 + swz / 64; C = (st & 1) * 32 + (swz % 64) / 2; }
__host__ __device__ __forceinline__ int perm32(int rho) { const int n = rho >> 4, i = rho & 15; return 8 * (i >> 2) + 4 * n + (i & 3); }

struct Unit { int pm, pn; };
struct Gemm { const bf16_t* A; const bf16_t* Bt; int lda, K; };

struct StaticOrder {
    static constexpr bool GATHER = false;
    int nM, nN, nwg, G, c;
    __device__ void init(int nM_, int nN_, int G_, int c_) { nM = nM_; nN = nN_; nwg = nM * nN; G = G_; c = c_; }
    __device__ bool next(int i, Unit& u) const {
        const long L = (long)i * G + c; if (L >= nwg) return false;
        int wgid = (int)L; { const int q = nwg / NXCD, r = nwg % NXCD, xcd = wgid % NXCD, off = wgid / NXCD; wgid = (xcd < r ? xcd * (q + 1) : r * (q + 1) + (xcd - r) * q) + off; }
        const int nig = WGM * nN, gid = wgid / nig, fm = gid * WGM, gsz = (nM - fm) < WGM ? (nM - fm) : WGM;
        u.pm = fm + ((wgid % nig) % gsz); u.pn = (wgid % nig) / gsz; return true;
    }
    __device__ __forceinline__ size_t boff(const Unit&) const { return 0; }
};
struct MoeOrder {
    static constexpr bool GATHER = false;
    const LAS int* tile_e; int nT, G, c; size_t estride;
    __device__ bool next(int i, Unit& u) const { const int L = i * G + c; u.pm = L >> 2; u.pn = L & 3; return u.pm < nT; }
    __device__ __forceinline__ size_t boff(const Unit& u) const { return (size_t)tile_e[u.pm] * estride; }
};
struct MoeGatherOrder : MoeOrder {
    static constexpr bool GATHER = true;
    const LAS int* lcnt; const LAS int* lbase; const u32x2* list;
    __device__ __forceinline__ unsigned rowoff(int r, int C, int lda) const { const int e = tile_e[r >> 8], j = r - lbase[e];
        unsigned tok = 0u; if (j < lcnt[e]) tok = list[(size_t)e * MROWS + j].x >> 1; return (tok * (unsigned)lda + (unsigned)C) * 2u; }
};

template <class Epi, class Sched, bool ALIGN_EPI = false>
__device__ __forceinline__ void gemm_phase(LAS unsigned char* lds, const Gemm g, const Sched& S, const Epi& E, const int tid) {
    const int wid = __builtin_amdgcn_readfirstlane(tid >> 6), lane = tid & 63, wr = wid >> 2, wc = wid & 3, fr = lane & 15, fq = lane >> 4;
    const int K = g.K, nt = K / BK;
    constexpr bool GA = Sched::GATHER;
    unsigned voffA[2], voffB[2]; int sR[2], sC[2];
#pragma unroll
    for (int i = 0; i < 2; ++i) { int R, C; stage_rc(tid * 16 + i * 8192, R, C); const int Rb = (R & ~31) + perm32(R & 31); sR[i] = R; sC[i] = C;
        voffA[i] = (unsigned)(R * g.lda + C) * 2u; voffB[i] = (unsigned)(Rb * K + C) * 2u; }
    unsigned ra[2][2], rn[2][2];
    const size_t kstep = (size_t)(BK * 2);
    const size_t hstepA = (size_t)HALF * g.lda * 2, hstepB = (size_t)HALF * K * 2;
    const size_t tstepA = 2 * hstepA, tstepB = 2 * hstepB;
    const unsigned ldsw = (unsigned)wid * 1024u;
    const int aoff = lds_byte(wr * 64 + fr, fq * 8), boff = lds_byte(wc * 32 + fr, fq * 8);
#define PG8_SA(b, h) (((b) * 2 + (h)) * HTB)
#define PG8_SB(b, h) ((4 + (b) * 2 + (h)) * HTB)
#define PG8_STAGE(bufoff, gbase, voff) do { _Pragma("unroll") for (int _i = 0; _i < 2; ++_i) \
        __builtin_amdgcn_global_load_lds((const unsigned*)((const char*)(gbase) + (voff)[_i]), (LAS unsigned*)(lds + (bufoff) + ldsw + _i * 8192), 16, 0, 0); } while (0)
#define PG8_ROWS(dst, u) do { if constexpr (GA) { _Pragma("unroll") for (int _h = 0; _h < 2; ++_h) _Pragma("unroll") for (int _i = 0; _i < 2; ++_i) dst[_h][_i] = S.rowoff((u).pm * 256 + _h * 128 + sR[_i], sC[_i], g.lda); } } while (0)
#define PG8_STAGE_A(bufoff, gbase, R, h) do { if constexpr (GA) { _Pragma("unroll") for (int _i = 0; _i < 2; ++_i) \
        __builtin_amdgcn_global_load_lds((const unsigned*)((const char*)(gbase) + (R)[h][_i]), (LAS unsigned*)(lds + (bufoff) + ldsw + _i * 8192), 16, 0, 0); } \
        else PG8_STAGE(bufoff, (gbase) + (h) * hstepA, voffA); } while (0)
#define PG8_LDA(dst, b, h) do { _Pragma("unroll") for (int m = 0; m < 4; ++m) _Pragma("unroll") for (int k = 0; k < 2; ++k) dst[m][k] = *(const LAS bf16x8*)(lds + PG8_SA(b, h) + aoff + m * 2048 + k * 1024); } while (0)
#define PG8_LDB(dst, b, h) do { _Pragma("unroll") for (int n = 0; n < 2; ++n) _Pragma("unroll") for (int k = 0; k < 2; ++k) dst[n][k] = *(const LAS bf16x8*)(lds + PG8_SB(b, h) + boff + n * 2048 + k * 1024); } while (0)
#define PG8_MMA(ai, bj, At, Bt) do { __builtin_amdgcn_s_setprio(1); _Pragma("unroll") for (int m = 0; m < 4; ++m) _Pragma("unroll") for (int n = 0; n < 2; ++n) _Pragma("unroll") for (int k = 0; k < 2; ++k) \
        acc[ai][bj][m][n] = __builtin_amdgcn_mfma_f32_16x16x32_bf16(Bt[n][k], At[m][k], acc[ai][bj][m][n], 0, 0, 0); __builtin_amdgcn_s_setprio(0); } while (0)
#define PG8_WAIT_V(n) asm volatile("s_waitcnt vmcnt(" #n ")" ::: "memory")
#define PG8_WAIT_L(n) asm volatile("s_waitcnt lgkmcnt(" #n ")" ::: "memory")
#define PG8_BAR __builtin_amdgcn_s_barrier()
#define PG8_SCHED __builtin_amdgcn_sched_barrier(0)
    Unit cur, nxt; int ui = 0;
    if (!S.next(0, cur)) return;
    f32x4 acc[2][2][4][2];
#pragma unroll
    for (int a = 0; a < 2; ++a)
#pragma unroll
        for (int b = 0; b < 2; ++b)
#pragma unroll
            for (int m = 0; m < 4; ++m)
#pragma unroll
                for (int n = 0; n < 2; ++n) acc[a][b][m][n] = (f32x4){0.f, 0.f, 0.f, 0.f};
    bf16x8 At[4][2], B0[2][2], B1[2][2];
    const char* cA = (const char*)g.A + (GA ? (size_t)0 : (size_t)cur.pm * tstepA); const char* cB = (const char*)g.Bt + S.boff(cur) * 2 + (size_t)cur.pn * tstepB;
    PG8_ROWS(ra, cur);
    PG8_STAGE(PG8_SB(0, 0), cB, voffB); PG8_STAGE(PG8_SB(0, 1), cB + hstepB, voffB); PG8_STAGE_A(PG8_SA(0, 0), cA, ra, 0); PG8_STAGE_A(PG8_SA(0, 1), cA, ra, 1);
    if (wr == 1) PG8_BAR;
    PG8_WAIT_V(2); PG8_BAR;
    PG8_STAGE(PG8_SB(1, 0), cB + kstep, voffB); PG8_STAGE_A(PG8_SA(1, 0), cA + kstep, ra, 0); PG8_STAGE(PG8_SB(1, 1), cB + hstepB + kstep, voffB);
    PG8_WAIT_V(6); PG8_BAR;
    for (;;) {
        const bool has_next = S.next(ui + 1, nxt);
        if constexpr (GA) { if (has_next) PG8_ROWS(rn, nxt); else { _Pragma("unroll") for (int _h = 0; _h < 2; ++_h) _Pragma("unroll") for (int _i = 0; _i < 2; ++_i) rn[_h][_i] = ra[_h][_i]; } }
        const char* nA = (has_next && !GA) ? (const char*)g.A + (size_t)nxt.pm * tstepA : cA; const char* nB = has_next ? (const char*)g.Bt + S.boff(nxt) * 2 + (size_t)nxt.pn * tstepB : cB;
        for (int t = 0; t < nt; t += 2) {
            const bool last = (t == nt - 2);
            const char* a1 = cA + (size_t)(t + 1) * kstep;
            const char* a2 = last ? nA : cA + (size_t)(t + 2) * kstep; const char* b2 = last ? nB : cB + (size_t)(t + 2) * kstep;
            const char* a3 = a2 + kstep; const char* b3 = b2 + kstep;
            unsigned rs[2][2];
            if constexpr (GA) { _Pragma("unroll") for (int _h = 0; _h < 2; ++_h) _Pragma("unroll") for (int _i = 0; _i < 2; ++_i) rs[_h][_i] = last ? rn[_h][_i] : ra[_h][_i]; }
            PG8_LDB(B0, 0, 0); PG8_LDB(B1, 0, 1); PG8_SCHED; PG8_LDA(At, 0, 0); PG8_STAGE_A(PG8_SA(1, 1), a1, ra, 1);
            PG8_WAIT_V(8); PG8_WAIT_L(0); PG8_BAR; PG8_MMA(0, 0, At, B0); PG8_MMA(0, 1, At, B1); PG8_BAR; PG8_SCHED;
            PG8_LDA(At, 0, 1); PG8_STAGE(PG8_SB(0, 0), b2, voffB); PG8_STAGE(PG8_SB(0, 1), b2 + hstepB, voffB); PG8_STAGE_A(PG8_SA(0, 0), a2, rs, 0);
            PG8_WAIT_V(8); PG8_WAIT_L(0); PG8_BAR; PG8_MMA(1, 0, At, B0); PG8_MMA(1, 1, At, B1); PG8_BAR; PG8_SCHED;
            PG8_LDB(B0, 1, 0); PG8_LDB(B1, 1, 1); PG8_SCHED; PG8_LDA(At, 1, 0); PG8_STAGE_A(PG8_SA(0, 1), a2, rs, 1);
            PG8_WAIT_V(8); PG8_WAIT_L(0); PG8_BAR; PG8_MMA(0, 0, At, B0); PG8_MMA(0, 1, At, B1); PG8_BAR; PG8_SCHED;
            PG8_LDA(At, 1, 1); PG8_STAGE(PG8_SB(1, 0), b3, voffB); PG8_STAGE(PG8_SB(1, 1), b3 + hstepB, voffB); PG8_STAGE_A(PG8_SA(1, 0), a3, rs, 0);
            PG8_WAIT_V(8); PG8_WAIT_L(0); PG8_BAR; PG8_MMA(1, 0, At, B0); PG8_MMA(1, 1, At, B1); PG8_BAR; PG8_SCHED;
        }
        if constexpr (ALIGN_EPI) { if (wr == 0) PG8_BAR; }
        E(acc, cur, wr, wc, fr, fq);
        if (!has_next) break;
#pragma unroll
        for (int a = 0; a < 2; ++a)
#pragma unroll
            for (int b = 0; b < 2; ++b)
#pragma unroll
                for (int m = 0; m < 4; ++m)
#pragma unroll
                    for (int n = 0; n < 2; ++n) acc[a][b][m][n] = (f32x4){0.f, 0.f, 0.f, 0.f};
        cur = nxt; cA = nA; cB = nB; ++ui;
        if constexpr (GA) { _Pragma("unroll") for (int _h = 0; _h < 2; ++_h) _Pragma("unroll") for (int _i = 0; _i < 2; ++_i) ra[_h][_i] = rn[_h][_i]; }
        if constexpr (ALIGN_EPI) { if (wr == 1) PG8_BAR; }
    }
    PG8_WAIT_V(0);
    if constexpr (!ALIGN_EPI) { if (wr == 0) PG8_BAR; }
    PG8_BAR;
#undef PG8_SA
#undef PG8_SB
#undef PG8_STAGE
#undef PG8_LDA
#undef PG8_ROWS
#undef PG8_STAGE_A
#undef PG8_LDB
#undef PG8_MMA
#undef PG8_WAIT_V
#undef PG8_WAIT_L
#undef PG8_BAR
#undef PG8_SCHED
}
}

#define XB_TMO      128
#define XB_XCNT(j)  (256  + 64 * (j))
#define XB_XSUB(j)  (1280 + 64 * (j))
#define XB_XGEN(j)  (2304 + 64 * (j))
#define XB_TOP      3328
#define XB_TOPGEN   3392
#define XCD_BAR_WORDS 3456
#define XB_SPIN_CAP (1u << 18)

__device__ __forceinline__ unsigned xb_ld(unsigned* p)              { return __hip_atomic_load(p, __ATOMIC_RELAXED, __HIP_MEMORY_SCOPE_AGENT); }
__device__ __forceinline__ unsigned xb_add(unsigned* p, unsigned v) { return __hip_atomic_fetch_add(p, v, __ATOMIC_RELAXED, __HIP_MEMORY_SCOPE_AGENT); }
__device__ __forceinline__ unsigned xb_xcc_id() { return (unsigned)__builtin_amdgcn_s_getreg((3 << 11) | 20) & 0xFu; }
#define XB_SPIN(cond, bar) do { unsigned _sp = 0; while (cond) { __builtin_amdgcn_s_sleep(1); \
    if ((++_sp & 255u) == 0u) { if (xb_ld(&(bar)[XB_TMO])) break; if (_sp > XB_SPIN_CAP) { atomicAdd(&(bar)[XB_TMO], 1u); break; } } } } while (0)

struct XcdBarrier {
    unsigned* bar; unsigned x;
    volatile LAS unsigned* st;
};
__device__ __forceinline__ XcdBarrier xcd_barrier_post(unsigned* bar, volatile LAS unsigned* st) {
    XcdBarrier b; b.bar = bar; b.x = xb_xcc_id(); b.st = st;
    if (threadIdx.x == 0) (void)xb_add(&bar[XB_XCNT(b.x)], 1u);
    return b;
}
__device__ __forceinline__ void xcd_barrier_complete(unsigned* bar, unsigned x, unsigned& nloc, unsigned& nx) {
    const unsigned G = gridDim.x * gridDim.y * gridDim.z;
    unsigned sum, cnt, mine, sp = 0u;
    for (;;) {
        sum = 0u; cnt = 0u; mine = 0u;
#pragma unroll
        for (unsigned j = 0; j < 16; ++j) { const unsigned c = xb_ld(&bar[XB_XCNT(j)]); sum += c; cnt += (c > 0u) ? 1u : 0u; mine = (j == x) ? c : mine; }
        if (sum == G) break;
        __builtin_amdgcn_s_sleep(1);
        if ((++sp & 255u) == 0u) { if (xb_ld(&bar[XB_TMO])) break; if (sp > XB_SPIN_CAP) { atomicAdd(&bar[XB_TMO], 1u); break; } }
    }
    nloc = mine > 0u ? mine : 1u; nx = cnt > 0u ? cnt : 1u;
}
__device__ __forceinline__ void xcd_barrier(const XcdBarrier& b) {
    asm volatile("s_waitcnt vmcnt(0)" ::: "memory");
    __syncthreads();
    if (threadIdx.x == 0) {
        unsigned* bar = b.bar;
        __builtin_amdgcn_s_waitcnt(0);
        unsigned nloc = b.st[0], nx = b.st[1];
        if (nloc == 0u) { xcd_barrier_complete(bar, b.x, nloc, nx); b.st[0] = nloc; b.st[1] = nx; }
        const unsigned old = xb_add(&bar[XB_XSUB(b.x)], 1u);
        const unsigned gen = old / nloc;
        if (old + 1u == (gen + 1u) * nloc) {
            __builtin_amdgcn_fence(__ATOMIC_RELEASE, "agent");
            asm volatile("s_waitcnt vmcnt(0)" ::: "memory");
            const unsigned og = xb_add(&bar[XB_TOP], 1u);
            const unsigned tg = og / nx;
            if (og + 1u == (tg + 1u) * nx) xb_add(&bar[XB_TOPGEN], 1u);
            else XB_SPIN(xb_ld(&bar[XB_TOPGEN]) == tg, bar);
            __builtin_amdgcn_fence(__ATOMIC_ACQUIRE, "agent");
            xb_add(&bar[XB_XGEN(b.x)], 1u);
            asm volatile("s_waitcnt vmcnt(0)" ::: "memory");
        } else {
            XB_SPIN(xb_ld(&bar[XB_XGEN(b.x)]) == gen, bar);
            __builtin_amdgcn_fence(__ATOMIC_ACQUIRE, "agent");
            asm volatile("s_waitcnt vmcnt(0)" ::: "memory");
        }
    }
    __syncthreads();
}

struct Args { const float* in[27]; float* out; unsigned char* ws; int ph_lo, ph_hi; };
struct Frame {
    LAS unsigned char* lds;
    unsigned char* ws;
    unsigned* ctl;
    const float* const* in;
    int tid, lane, wave, vcu, G, gw, NGW;
};

__device__ __forceinline__ void p0_transpose_item(const float* W, int K, int N, bf16_t* WT, int mode, LAS unsigned* scr, int item, int lane, float scale = 1.f) {
    const int nblk = (N + 63) / 64, kb = item / nblk, nb = item % nblk, k0 = 64 * kb, n0 = 64 * nb;
    const int drow0 = mode == 0 ? n0 : ((n0 >> 7) * 256 + (n0 & 127) + (mode == 2 ? 128 : 0));
    const int r = lane >> 4, n4 = lane & 15; const bool okc = n0 + 4 * n4 < N;
    f32x4 la[8], lb[8];
#pragma unroll
    for (int st = 0; st < 8; ++st) { const float* p = W + (size_t)(k0 + st * 8 + 2 * r) * N + n0 + 4 * n4;
        la[st] = okc ? __builtin_nontemporal_load((const f32x4*)p) : (f32x4){0.f, 0.f, 0.f, 0.f}; lb[st] = okc ? __builtin_nontemporal_load((const f32x4*)(p + N)) : (f32x4){0.f, 0.f, 0.f, 0.f}; }
#pragma unroll
    for (int st = 0; st < 8; ++st)
#pragma unroll
        for (int q = 0; q < 4; ++q) scr[(4 * n4 + q) * 33 + st * 4 + r] = cvt_pk_bf16(la[st][q] * scale, lb[st][q] * scale);
    LDS_WAIT(); asm volatile("" ::: "memory");
    const int c = lane & 7;
#pragma unroll
    for (int st = 0; st < 8; ++st) { const int n = st * 8 + (lane >> 3); const LAS unsigned* sp = scr + n * 33 + 4 * c;
        const u32x4 o = {sp[0], sp[1], sp[2], sp[3]};
        if (n0 + n < N) *(u32x4*)(WT + (size_t)(drow0 + n) * K + k0 + 8 * c) = o; }
    LDS_WAIT(); asm volatile("" ::: "memory");
}
__device__ __forceinline__ float silu_f(float x) { return x / (1.f + __expf(-x)); }

__device__ __forceinline__ void p0_prologue(Frame& F) {
    {
        LAS float* sv = (LAS float*)F.lds;
        LAS float* red = (LAS float*)(F.lds + 12288);
        const float* c = F.in[1]; const float* cc = F.in[3];
        for (int i = F.tid; i < 3072; i += NTHREADS) { const float x = i < 2048 ? c[i] : cc[i - 2048]; sv[i] = silu_f(x); }
        __syncthreads();
        const float* wada = F.in[4]; const float* bada = F.in[5]; float* mod = (float*)(F.ws + WS_MOD);
        for (int it = F.vcu; it < 4 * 96; it += F.G) {
            const int l = it / 96, n = (it % 96) * 64 + F.lane;
            const float* wp = wada + ((size_t)l * 1024 + F.wave * 128) * 6144 + n;
            float a0 = 0.f, a1 = 0.f, a2 = 0.f;
#pragma unroll 16
            for (int k = 0; k < 128; ++k) { const float w = wp[(size_t)k * 6144]; const int kk = F.wave * 128 + k; a0 += sv[kk] * w; a1 += sv[1024 + kk] * w; a2 += sv[2048 + kk] * w; }
            red[(F.wave * 3 + 0) * 64 + F.lane] = a0; red[(F.wave * 3 + 1) * 64 + F.lane] = a1; red[(F.wave * 3 + 2) * 64 + F.lane] = a2;
            __syncthreads();
            if (F.wave < 3) { float s = bada[l * 6144 + n];
#pragma unroll
                for (int w = 0; w < 8; ++w) s += red[(w * 3 + F.wave) * 64 + F.lane];
                mod[(size_t)(l * 3 + F.wave) * 6144 + n] = s; }
            __syncthreads();
        }
    }
    {
        f32x2* rope = (f32x2*)(F.ws + WS_ROPE);
        for (int e = F.vcu * NTHREADS + F.tid; e < 7680; e += F.G * NTHREADS) {
            int pos, i, n;
            if (e < 2048) { pos = e >> 3; i = e & 7; n = 8; } else if (e < 2560) { pos = (e - 2048) >> 3; i = e & 7; n = 8; }
            else if (e < 6656) { pos = (e - 2560) >> 4; i = (e - 2560) & 15; n = 16; } else { pos = (e - 6656) >> 4; i = (e - 6656) & 15; n = 16; }
            const float inv = powf(10000.f, -(float)i / (float)n);
            const float ang = (float)pos * inv; float s, co; sincosf(ang, &s, &co);
            rope[e] = (f32x2){co, s};
        }
    }
    {
        bf16_t* winT = (bf16_t*)(F.ws + WS_WIN);
        for (int e = F.vcu * NTHREADS + F.tid; e < 2 * 96 * 128; e += F.G * NTHREADS) { const int i = e / (96 * 128), r = (e / 128) % 96, c8 = e % 128;
            *(u32x4*)(winT + ((size_t)i * AB_INP + AB_IN + r) * 1024 + c8 * 8) = (u32x4){0u, 0u, 0u, 0u}; }
    }
    {
        LAS unsigned* scr = (LAS unsigned*)(F.lds + F.wave * 16384);
        constexpr int I_WIN = 16 * 23, I_QUP = 6 * 12, I_KVUP = 4 * 16, I_OUT = 16 * 16, I_NIN = 16 * 48, I_NOUT = 16 * 16;
        constexpr int I_SMALL = I_WIN + I_QUP + I_KVUP + I_OUT + I_NIN + I_NOUT;
        constexpr int NITEMS = 2 * I_SMALL + 128 * 384;
        for (int it = F.gw; it < NITEMS; it += F.NGW) {
            if (it < 2 * I_SMALL) {
                const int i = it / I_SMALL; int r = it % I_SMALL;
                if (r < I_WIN) { p0_transpose_item(F.in[9] + (size_t)i * 1024 * 1440, 1024, 1440, (bf16_t*)(F.ws + WS_WIN) + (size_t)i * AB_INP * 1024, 0, scr, r, F.lane); continue; } r -= I_WIN;
                if (r < I_QUP) { p0_transpose_item(F.in[12] + (size_t)i * 384 * 768, 384, 768, (bf16_t*)(F.ws + WS_WQUP) + (size_t)i * 768 * 384, 0, scr, r, F.lane, SC_A); continue; } r -= I_QUP;
                if (r < I_KVUP) { p0_transpose_item(F.in[14] + (size_t)i * 256 * 1024, 256, 1024, (bf16_t*)(F.ws + WS_WKVUP) + (size_t)i * 1024 * 256, 0, scr, r, F.lane); continue; } r -= I_KVUP;
                if (r < I_OUT) { p0_transpose_item(F.in[10] + (size_t)i * 1024 * 1024, 1024, 1024, (bf16_t*)(F.ws + WS_WOUT) + (size_t)i * 1024 * 1024, 0, scr, r, F.lane); continue; } r -= I_OUT;
                if (r < I_NIN) { p0_transpose_item(F.in[17] + (size_t)i * 1024 * 3072, 1024, 3072, (bf16_t*)(F.ws + WS_NIN) + (size_t)i * 3072 * 1024, 0, scr, r, F.lane); continue; } r -= I_NIN;
                p0_transpose_item(F.in[18] + (size_t)i * 1024 * 1024, 1024, 1024, (bf16_t*)(F.ws + WS_NOUT) + (size_t)i * 1024 * 1024, 0, scr, r, F.lane);
            } else {
                const int r = it - 2 * I_SMALL, le = r / 384, q = r % 384, kind = q >> 7, sub = q & 127, l = le >> 5, e = le & 31;
                bf16_t* gu = (bf16_t*)(F.ws + WS_MOEW + (size_t)l * MOEW_LAYER) + (size_t)e * 1024 * 1024;
                bf16_t* dn = (bf16_t*)(F.ws + WS_MOEW + (size_t)l * MOEW_LAYER + MOEW_DN) + (size_t)e * 1024 * 512;
                if (kind == 0) p0_transpose_item(F.in[24] + (size_t)le * 1024 * 512, 1024, 512, gu, 1, scr, sub, F.lane);
                else if (kind == 1) p0_transpose_item(F.in[25] + (size_t)le * 1024 * 512, 1024, 512, gu, 2, scr, sub, F.lane);
                else p0_transpose_item(F.in[26] + (size_t)le * 512 * 1024, 512, 1024, dn, 0, scr, sub, F.lane);
            }
        }
    }
}

__device__ __forceinline__ void store_bf16_row(bf16_t* orow, int lane, const f32x4 (&h)[4]) {
#pragma unroll
    for (int j = 0; j < 4; ++j) { u32x2 w; w.x = cvt_pk_bf16(h[j].x, h[j].y); w.y = cvt_pk_bf16(h[j].z, h[j].w); *(u32x2*)(orow + 256 * j + 4 * lane) = w; }
}
__device__ __forceinline__ void combine_row(f32x4 (&x)[4], const bf16_t* y0, const float* g2, int lane) {
#pragma unroll
    for (int j = 0; j < 4; ++j) {
        const u32x2 a = *(const u32x2*)(y0 + 256 * j + 4 * lane), b = *(const u32x2*)(y0 + 1024 + 256 * j + 4 * lane);
        const f32x4 g = *(const f32x4*)(g2 + 256 * j + 4 * lane) * MOE_ALPHA;
        x[j].x += g.x * (bf16lo(a.x) + bf16lo(b.x)); x[j].y += g.y * (bf16hi(a.x) + bf16hi(b.x));
        x[j].z += g.z * (bf16lo(a.y) + bf16lo(b.y)); x[j].w += g.w * (bf16hi(a.y) + bf16hi(b.y));
    }
}
__device__ __forceinline__ float row_rs(const f32x4 (&x)[4]) {
    float s = 0.f;
#pragma unroll
    for (int j = 0; j < 4; ++j) s += (x[j].x * x[j].x + x[j].y * x[j].y) + (x[j].z * x[j].z + x[j].w * x[j].w);
    return rsqrtf(wave_sum(s) * (1.f / 1024.f) + RMS_EPS);
}
__device__ __forceinline__ void modulate_row(const f32x4 (&x)[4], f32x4 (&h)[4], float rs, const float* gain, const float* sh, const float* sc, int lane) {
#pragma unroll
    for (int j = 0; j < 4; ++j) {
        const f32x4 g = *(const f32x4*)(gain + 256 * j + 4 * lane), s1 = *(const f32x4*)(sc + 256 * j + 4 * lane), s0 = *(const f32x4*)(sh + 256 * j + 4 * lane);
        h[j] = (x[j] * rs) * g * (s1 + 1.f) + s0;
    }
}

struct RowVec { f32x4 a[4], b[4], g[4]; };
__device__ __forceinline__ void load_rowvec(RowVec& V, const float* gain, const float* sh, const float* sc, const float* g2, int lane) {
#pragma unroll
    for (int j = 0; j < 4; ++j) { const int c = 256 * j + 4 * lane;
        const f32x4 g = *(const f32x4*)(gain + c), s1 = *(const f32x4*)(sc + c); V.a[j] = g * (s1 + 1.f); V.b[j] = *(const f32x4*)(sh + c);
        V.g[j] = g2 ? *(const f32x4*)(g2 + c) * MOE_ALPHA : (f32x4){0.f, 0.f, 0.f, 0.f}; }
}
struct RowRaw { f32x4 x[4]; u32x2 y0[4], y1[4]; };
__device__ __forceinline__ void load_rowraw(RowRaw& R, const float* xrow, const bf16_t* yrow, int lane) {
#pragma unroll
    for (int j = 0; j < 4; ++j) R.x[j] = *(const f32x4*)(xrow + 256 * j + 4 * lane);
    if (yrow) {
#pragma unroll
        for (int j = 0; j < 4; ++j) { R.y0[j] = *(const u32x2*)(yrow + 256 * j + 4 * lane); R.y1[j] = *(const u32x2*)(yrow + 1024 + 256 * j + 4 * lane); } }
}
__device__ __forceinline__ void combine_raw(RowRaw& R, const RowVec& V) {
#pragma unroll
    for (int j = 0; j < 4; ++j) { const u32x2 a = R.y0[j], b = R.y1[j];
        R.x[j].x += V.g[j].x * (bf16lo(a.x) + bf16lo(b.x)); R.x[j].y += V.g[j].y * (bf16hi(a.x) + bf16hi(b.x));
        R.x[j].z += V.g[j].z * (bf16lo(a.y) + bf16lo(b.y)); R.x[j].w += V.g[j].w * (bf16hi(a.y) + bf16hi(b.y)); }
}
__device__ __forceinline__ int chunk_lo(int gw, int M, int NGW) { return (int)(((long)gw * M) / NGW); }

__device__ __forceinline__ void mix_norm_phase(Frame& F, int l) {
    float* X = (float*)(F.ws + WS_X); bf16_t* H = (bf16_t*)(F.ws + WS_H);
    const float* mod = (const float*)(F.ws + WS_MOD); const bf16_t* Y = (const bf16_t*)(F.ws + R_Y);
    const float* gain = F.in[6] + l * 1024;
    const int r0 = chunk_lo(F.gw, MROWS, F.NGW), r1 = chunk_lo(F.gw + 1, MROWS, F.NGW);
    RowVec V; RowRaw cur, nxt; int vcur = -1;
#define SRC(m) ((l == 0) ? ((m) < NLAT ? F.in[0] + (size_t)(m) * 1024 : F.in[2] + (size_t)((m) - NLAT) * 1024) : X + (size_t)(m) * 1024)
    if (r0 < r1) load_rowraw(nxt, SRC(r0), l > 0 ? Y + (size_t)r0 * 2048 : nullptr, F.lane);
    for (int m = r0; m < r1; ++m) {
        cur = nxt;
        if (m + 1 < r1) load_rowraw(nxt, SRC(m + 1), l > 0 ? Y + (size_t)(m + 1) * 2048 : nullptr, F.lane);
        const int v = row_class(m);
        if (v != vcur) { vcur = v; const float* mv = mod + (size_t)(l * 3 + v) * 6144;
            load_rowvec(V, gain, mv, mv + 1024, l > 0 ? mod + ((size_t)((l - 1) * 3 + v) * 6 + 5) * 1024 : nullptr, F.lane); }
        if (l > 0) combine_raw(cur, V);
        if (l > 0) {
#pragma unroll
        for (int j = 0; j < 4; ++j) *(f32x4*)(X + (size_t)m * 1024 + 256 * j + 4 * F.lane) = cur.x[j]; }
        const float rs = row_rs(cur.x);
        f32x4 h[4];
#pragma unroll
        for (int j = 0; j < 4; ++j) h[j] = (cur.x[j] * rs) * V.a[j] + V.b[j];
        store_bf16_row(H + (size_t)m * 1024, F.lane, h);
    }
#undef SRC
}
__device__ __forceinline__ void final_phase(Frame& F, float* out) {
    const float* X = (const float*)(F.ws + WS_X); const float* mod = (const float*)(F.ws + WS_MOD); const bf16_t* Y = (const bf16_t*)(F.ws + R_Y);
    const float* gain = F.in[8];
    const int r0 = chunk_lo(F.gw, NLAT, F.NGW), r1 = chunk_lo(F.gw + 1, NLAT, F.NGW);
    RowVec V; RowRaw cur, nxt; int vcur = -1;
    if (r0 < r1) load_rowraw(nxt, X + (size_t)r0 * 1024, Y + (size_t)r0 * 2048, F.lane);
    for (int m = r0; m < r1; ++m) {
        cur = nxt;
        if (m + 1 < r1) load_rowraw(nxt, X + (size_t)(m + 1) * 1024, Y + (size_t)(m + 1) * 2048, F.lane);
        const int v = row_class(m);
        if (v != vcur) { vcur = v; const float* mv = mod + (size_t)(3 * 3 + v) * 6144; load_rowvec(V, gain, mv, mv + 1024, mv + 5 * 1024, F.lane); }
        combine_raw(cur, V);
        float rs = row_rs(cur.x);
        if (DBG_SEL >= 0 && DBG_SEL < 100) rs *= 1.f + (DBG_SEL >= 16 ? 10.f : 1.f) * fminf(u2f(__hip_atomic_load(F.ctl + CW_DBG + DBG_SEL, RLX_AGENT)), 0.3f);
        if (DBG_SEL == 101) { float code = 0.f;
            for (int g = 0; g < 8; ++g) { float e = 0.f; for (int q = 0; q < 4; ++q) e = fmaxf(e, u2f(__hip_atomic_load(F.ctl + CW_DBG + 16 + 4 * g + q, RLX_AGENT))); if (e > 0.05f) code += 0.1f * (float)(1 << g); }
            rs *= 1.f + code; }
#pragma unroll
        for (int j = 0; j < 4; ++j) { const f32x4 g = *(const f32x4*)(gain + 256 * j + 4 * F.lane); *(f32x4*)(out + (size_t)m * 1024 + 256 * j + 4 * F.lane) = (cur.x[j] * rs) * g; }
    }
}

__device__ __forceinline__ void ffn_norm_route_phase(Frame& F, int l) {
    const int M = (l == DEPTH - 1) ? NLAT : MROWS;
    const float* X = (const float*)(F.ws + WS_X); bf16_t* H = (bf16_t*)(F.ws + WS_H);
    const float* mod = (const float*)(F.ws + WS_MOD);
    const float* gain = F.in[7] + l * 1024;
    LAS float* tab = (LAS float*)F.lds;
    LAS int* lcnt = (LAS int*)(F.lds + CNTL_OFF); LAS int* lbase = lcnt + 32;
    LAS int* rec = (LAS int*)(F.lds + REC_OFF);
    {
        const float* wrg = F.in[20] + (size_t)l * 4096; const float* wre = F.in[22] + (size_t)l * 32768;
        for (int i = F.tid; i < 4096; i += NTHREADS) tab[(i & 3) * TAB_LD + (i >> 2)] = wrg[i];
        for (int i = F.tid; i < 32768; i += NTHREADS) tab[(4 + (i & 31)) * TAB_LD + (i >> 5)] = wre[i];
        if (F.tid < 32) lcnt[F.tid] = 0;
    }
    __syncthreads();
    const float* brg = F.in[21] + l * 4; const float* bre = F.in[23] + l * 32;
    const int r0 = 2 * chunk_lo(F.gw, M >> 1, F.NGW), r1 = 2 * chunk_lo(F.gw + 1, M >> 1, F.NGW);
    RowVec V; RowRaw curA, curB, nxtA, nxtB; int vcur = -1;
    if (r0 < r1) { load_rowraw(nxtA, X + (size_t)r0 * 1024, nullptr, F.lane); load_rowraw(nxtB, X + (size_t)(r0 + 1) * 1024, nullptr, F.lane); }
    float keep[36];
#pragma unroll
    for (int o = 0; o < 36; ++o) keep[o] = 0.f;
    int pit = 0;
    for (int m = r0; m < r1; m += 2, ++pit) {
        curA = nxtA; curB = nxtB;
        if (m + 2 < r1) { load_rowraw(nxtA, X + (size_t)(m + 2) * 1024, nullptr, F.lane); load_rowraw(nxtB, X + (size_t)(m + 3) * 1024, nullptr, F.lane); }
        const int v = row_class(m);
        if (v != vcur) { vcur = v; const float* mv = mod + (size_t)(l * 3 + v) * 6144; load_rowvec(V, gain, mv + 3 * 1024, mv + 4 * 1024, nullptr, F.lane); }
        const float rsA = row_rs(curA.x), rsB = row_rs(curB.x);
        f32x4 hA[4], hB[4];
#pragma unroll
        for (int j = 0; j < 4; ++j) { hA[j] = (curA.x[j] * rsA) * V.a[j] + V.b[j]; hB[j] = (curB.x[j] * rsB) * V.a[j] + V.b[j]; }
        store_bf16_row(H + (size_t)m * 1024, F.lane, hA);
        store_bf16_row(H + (size_t)(m + 1) * 1024, F.lane, hB);
#pragma unroll
        for (int o = 0; o < 36; ++o) {
            f32x2 a2 = {0.f, 0.f}, b2 = {0.f, 0.f};
#pragma unroll
            for (int j = 0; j < 4; ++j) { const f32x4 w = *(const LAS f32x4*)(tab + o * TAB_LD + 256 * j + 4 * F.lane);
                a2 = __builtin_elementwise_fma((f32x2){hA[j].x, hA[j].y}, (f32x2){w.x, w.y}, a2); a2 = __builtin_elementwise_fma((f32x2){hA[j].z, hA[j].w}, (f32x2){w.z, w.w}, a2);
                b2 = __builtin_elementwise_fma((f32x2){hB[j].x, hB[j].y}, (f32x2){w.x, w.y}, b2); b2 = __builtin_elementwise_fma((f32x2){hB[j].z, hB[j].w}, (f32x2){w.z, w.w}, b2); }
            const float tot = wave_sum2(a2.x + a2.y, b2.x + b2.y);
            keep[o] = ((F.lane & 31) == pit) ? tot : keep[o];
        }
    }
    if ((F.lane & 31) < ((r1 - r0) >> 1)) {
        float g0 = keep[0] + brg[0], g1 = keep[1] + brg[1], g2 = keep[2] + brg[2], g3 = keep[3] + brg[3];
        int gs = 0; float gm = g0;
        if (g1 > gm) { gm = g1; gs = 1; } if (g2 > gm) { gm = g2; gs = 2; } if (g3 > gm) { gm = g3; gs = 3; }
        const float pg = 1.f / (__expf(g0 - gm) + __expf(g1 - gm) + __expf(g2 - gm) + __expf(g3 - gm));
        float se[8];
#pragma unroll
        for (int j = 0; j < 8; ++j) { const float a0 = keep[4 + j] + bre[j], a1 = keep[12 + j] + bre[8 + j], a2 = keep[20 + j] + bre[16 + j], a3 = keep[28 + j] + bre[24 + j];
            se[j] = gs == 0 ? a0 : (gs == 1 ? a1 : (gs == 2 ? a2 : a3)); }
        int i0 = 0; float m0 = se[0];
#pragma unroll
        for (int j = 1; j < 8; ++j) if (se[j] > m0) { m0 = se[j]; i0 = j; }
        int i1 = -1; float m1 = -3.0e38f;
#pragma unroll
        for (int j = 0; j < 8; ++j) if (j != i0 && se[j] > m1) { m1 = se[j]; i1 = j; }
        const float e1 = __expf(m1 - m0), w0 = pg / (1.f + e1), w1 = pg * e1 / (1.f + e1);
        const int ea = gs * 8 + i0, eb = gs * 8 + i1;
        const int lra = atomicAdd((int*)(lcnt + ea), 1), lrb = atomicAdd((int*)(lcnt + eb), 1);
        LAS int* r = rec + (((2 * (F.lane & 31) + (F.lane >> 5)) * 8 + F.wave) * 2) * 3;
        r[0] = ea; r[1] = lra; r[2] = __builtin_bit_cast(int, W_CONST > 0.f ? W_CONST : w0);
        r[3] = eb; r[4] = lrb; r[5] = __builtin_bit_cast(int, W_CONST > 0.f ? W_CONST : w1);
    }
    __syncthreads();
    if (F.tid < 32) lbase[F.tid] = (int)__hip_atomic_fetch_add(F.ctl + CW_CNT + (l * 32 + F.tid) * 64, (unsigned)lcnt[F.tid], RLX_AGENT);
    __syncthreads();
    u32x2* list = (u32x2*)(F.ws + WS_LIST);
    if (F.lane < 2 * (r1 - r0)) { const int it = F.lane >> 1, k = F.lane & 1;
        const LAS int* r = rec + ((it * 8 + F.wave) * 2 + k) * 3; const int e = r[0], pos = lbase[e] + r[1];
        list[(size_t)e * MROWS + pos] = (u32x2){(unsigned)(2 * (r0 + it) + k), (unsigned)r[2]}; }
}

__device__ __forceinline__ void moe_tile_map(Frame& F, int l) {
    LAS int* tile_e = (LAS int*)(F.lds + TILE_E_OFF); LAS int* nt = (LAS int*)(F.lds + MOE_NT_OFF);
    LAS int* lcnt = (LAS int*)(F.lds + CNTL_OFF); LAS int* lbase = lcnt + 32;
    __syncthreads();
    if (F.tid < 32) lcnt[F.tid] = (int)__hip_atomic_load(F.ctl + CW_CNT + (l * 32 + F.tid) * 64, RLX_AGENT);
    __syncthreads();
    if (F.tid == 0) {
        int t0 = 0;
        for (int e = 0; e < 32; ++e) { const int c = lcnt[e], n = (c + 255) >> 8; lbase[e] = t0 * 256; for (int t = 0; t < n && t0 + t < 320; ++t) tile_e[t0 + t] = e; t0 += n; }
        nt[0] = t0 < MOE_MAXT ? t0 : MOE_MAXT;
    }
    __syncthreads();
}
__device__ __forceinline__ void moe_gather_phase(Frame& F, int l) {
    moe_tile_map(F, l);
    const LAS int* tile_e = (const LAS int*)(F.lds + TILE_E_OFF); const int nT = *(const LAS int*)(F.lds + MOE_NT_OFF);
    const LAS int* lcnt = (const LAS int*)(F.lds + CNTL_OFF); const LAS int* lbase = lcnt + 32;
    const bf16_t* H = (const bf16_t*)(F.ws + WS_H); bf16_t* XB = (bf16_t*)(F.ws + R_XB); u32x2* RI = (u32x2*)(F.ws + R_RI);
    const u32x2* list = (const u32x2*)(F.ws + WS_LIST);
    const int nrows = nT * 256;
    for (int rb = F.gw * 4; rb < nrows; rb += F.NGW * 4) {
        u32x2 ri[4]; u32x4 a[4], b[4];
#pragma unroll
        for (int q = 0; q < 4; ++q) { const int r = rb + q; const int e = tile_e[r >> 8], j = r - lbase[e];
            ri[q] = (u32x2){0xffffffffu, 0u};
            if (j < lcnt[e]) ri[q] = list[(size_t)e * MROWS + j]; }
#pragma unroll
        for (int q = 0; q < 4; ++q) { a[q] = (u32x4){0u, 0u, 0u, 0u}; b[q] = a[q];
            if (ri[q].x != 0xffffffffu) { const bf16_t* src = H + (size_t)(ri[q].x >> 1) * 1024; a[q] = *(const u32x4*)(src + F.lane * 8); b[q] = *(const u32x4*)(src + 512 + F.lane * 8); } }
#pragma unroll
        for (int q = 0; q < 4; ++q) { const int r = rb + q;
            *(u32x4*)(XB + (size_t)r * 1024 + F.lane * 8) = a[q]; *(u32x4*)(XB + (size_t)r * 1024 + 512 + F.lane * 8) = b[q];
            if (F.lane == 0) RI[r] = ri[q]; }
    }
}

using pg8::Unit;
__device__ __forceinline__ u32x4 pack8(const f32x4 v0, const f32x4 v1) { u32x4 w; w.x = cvt_pk_bf16(v0[0], v0[1]); w.y = cvt_pk_bf16(v0[2], v0[3]); w.z = cvt_pk_bf16(v1[0], v1[1]); w.w = cvt_pk_bf16(v1[2], v1[3]); return w; }

struct EpiStore {
    bf16_t* O; int ldc;
    __device__ __forceinline__ void operator()(const f32x4 (&acc)[2][2][4][2], const Unit& u, int wr, int wc, int fr, int fq) const {
        const int row0 = u.pm * 256 + wr * 64 + fr, col0 = u.pn * 256 + wc * 32 + 8 * fq;
#pragma unroll
        for (int ai = 0; ai < 2; ++ai)
#pragma unroll
            for (int m = 0; m < 4; ++m) { bf16_t* rowp = O + (size_t)(row0 + ai * 128 + m * 16) * ldc + col0;
#pragma unroll
                for (int bj = 0; bj < 2; ++bj) *(u32x4*)(rowp + bj * 128) = pack8(acc[ai][bj][m][0], acc[ai][bj][m][1]); }
    }
};
struct EpiOut {
    float* X; const float* modl;
    const float* Xs; const float* Xc;
    __device__ __forceinline__ void operator()(const f32x4 (&acc)[2][2][4][2], const Unit& u, int wr, int wc, int fr, int fq) const {
        const int row0 = u.pm * 256 + wr * 64 + fr, col0 = u.pn * 256 + wc * 32 + 8 * fq;
        const int v = u.pm < 64 ? 0 : (u.pm < 128 ? 1 : 2);
        const float* g1 = modl + (size_t)v * 6144 + 2 * 1024 + col0;
        f32x4 g[2][2];
#pragma unroll
        for (int bj = 0; bj < 2; ++bj) { g[bj][0] = *(const f32x4*)(g1 + bj * 128); g[bj][1] = *(const f32x4*)(g1 + bj * 128 + 4); }
#pragma unroll
        for (int ai = 0; ai < 2; ++ai)
#pragma unroll
            for (int m = 0; m < 4; ++m) { const int row = row0 + ai * 128 + m * 16; float* rowp = X + (size_t)row * 1024 + col0;
                const float* srcp = (u.pm < 128 ? Xs + (size_t)row * 1024 : Xc + (size_t)(row - NLAT) * 1024) + col0;
#pragma unroll
                for (int bj = 0; bj < 2; ++bj) { f32x4* p = (f32x4*)(rowp + bj * 128); const f32x4* q = (const f32x4*)(srcp + bj * 128);
                    const f32x4 a = q[0], b = q[1];
                    p[0] = a + g[bj][0] * acc[ai][bj][m][0]; p[1] = b + g[bj][1] * acc[ai][bj][m][1]; } }
    }
};
struct EpiNaIn {
    bf16_t* QK; bf16_t* Vt; bf16_t* Vtc;
    __device__ __forceinline__ void operator()(const f32x4 (&acc)[2][2][4][2], const Unit& u, int wr, int wc, int fr, int fq) const {
        const int row0 = u.pm * 256 + wr * 64 + fr, col0 = u.pn * 256 + wc * 32 + 8 * fq;
        if (u.pn < 8) {
            const float sc = u.pn < 4 ? SC_B : 1.f;
#pragma unroll
            for (int ai = 0; ai < 2; ++ai)
#pragma unroll
                for (int m = 0; m < 4; ++m) { bf16_t* rowp = QK + (size_t)(row0 + ai * 128 + m * 16) * 2048 + col0;
#pragma unroll
                    for (int bj = 0; bj < 2; ++bj) *(u32x4*)(rowp + bj * 128) = pack8(acc[ai][bj][m][0] * sc, acc[ai][bj][m][1] * sc); }
        } else {
#pragma unroll
            for (int ai = 0; ai < 2; ++ai)
#pragma unroll
                for (int m = 0; m < 4; ++m) { const int row = row0 + ai * 128 + m * 16;
                    bf16_t* base; size_t ld;
                    if (row < NLAT) { base = Vt + (size_t)(row >> 14) * 1024 * SEQ + (row & (SEQ - 1)); ld = SEQ; }
                    else { const int rc = row - NLAT; base = Vtc + (size_t)(rc >> 8) * 1024 * CTXL + (rc & 255); ld = CTXL; }
#pragma unroll
                    for (int bj = 0; bj < 2; ++bj) { const int hc = col0 + bj * 128 - 2048;
                        const u32x4 w = pack8(acc[ai][bj][m][0], acc[ai][bj][m][1]);
                        bf16_t* p = base + (size_t)hc * ld;
                        p[0] = (bf16_t)(w.x & 0xffff); p[ld] = (bf16_t)(w.x >> 16); p[2 * ld] = (bf16_t)(w.y & 0xffff); p[3 * ld] = (bf16_t)(w.y >> 16);
                        p[4 * ld] = (bf16_t)(w.z & 0xffff); p[5 * ld] = (bf16_t)(w.z >> 16); p[6 * ld] = (bf16_t)(w.w & 0xffff); p[7 * ld] = (bf16_t)(w.w >> 16); } }
        }
    }
};
struct EpiMoe1 {
    bf16_t* ACT;
    __device__ __forceinline__ void operator()(const f32x4 (&acc)[2][2][4][2], const Unit& u, int wr, int wc, int fr, int fq) const {
        const int row0 = u.pm * 256 + wr * 64 + fr, col0 = u.pn * 128 + wc * 32 + 8 * fq;
#pragma unroll
        for (int ai = 0; ai < 2; ++ai)
#pragma unroll
            for (int m = 0; m < 4; ++m) { f32x4 o[2];
#pragma unroll
                for (int n = 0; n < 2; ++n)
#pragma unroll
                    for (int i = 0; i < 4; ++i) { const float g = acc[ai][0][m][n][i], up = acc[ai][1][m][n][i];
                        o[n][i] = g * __builtin_amdgcn_rcpf(1.f + __builtin_amdgcn_exp2f(-g * LOG2E)) * up; }
                *(u32x4*)(ACT + (size_t)(row0 + ai * 128 + m * 16) * 512 + col0) = pack8(o[0], o[1]); }
    }
};
struct EpiMoe2 {
    bf16_t* Y; const LAS int* tile_e; const LAS int* lcnt; const LAS int* lbase; const u32x2* list;
    __device__ __forceinline__ void operator()(const f32x4 (&acc)[2][2][4][2], const Unit& u, int wr, int wc, int fr, int fq) const {
        const int row0 = u.pm * 256 + wr * 64 + fr, col0 = u.pn * 256 + wc * 32 + 8 * fq;
        const int e = tile_e[u.pm], j0 = row0 - lbase[e], cnt = lcnt[e];
#pragma unroll
        for (int ai = 0; ai < 2; ++ai)
#pragma unroll
            for (int m = 0; m < 4; ++m) { const int j = j0 + ai * 128 + m * 16;
                if (j < cnt) { const u32x2 ri = list[(size_t)e * MROWS + j]; const float w = u2f(ri.y); bf16_t* rowp = Y + (size_t)ri.x * 1024 + col0;
#pragma unroll
                    for (int bj = 0; bj < 2; ++bj) *(u32x4*)(rowp + bj * 128) = pack8(acc[ai][bj][m][0] * w, acc[ai][bj][m][1] * w); } }
    }
};

__device__ __forceinline__ void ab_prep_phase(Frame& F, int li) {
    const bf16_t* P = (const bf16_t*)(F.ws + R_P);
    bf16_t* CQN = (bf16_t*)(F.ws + R_CQN); bf16_t* CKVN = (bf16_t*)(F.ws + R_CKVN); bf16_t* KR = (bf16_t*)(F.ws + R_KR);
    bf16_t* QB = (bf16_t*)(F.ws + R_QB); bf16_t* KB = (bf16_t*)(F.ws + R_KB); bf16_t* VB = (bf16_t*)(F.ws + R_VB);
    const f32x2* rope = (const f32x2*)(F.ws + WS_ROPE);
    const float* qn = F.in[11] + li * QLORA; const float* kvn = F.in[13] + li * KVLORA; const float* gqn = F.in[15] + li * 64; const float* gkn = F.in[16] + li * 64;
    const int l = F.lane;
    for (int m = F.gw; m < MROWS; m += F.NGW) {
        const bf16_t* p = P + (size_t)m * AB_INP;
        const bool lat = m < NLAT; const int t = m & (SEQ - 1), gr = t >> 6, gc = t & 63;
        const unsigned* pc = (const unsigned*)(p + 6 * l); const unsigned c0 = pc[0], c1 = pc[1], c2 = pc[2];
        const u32x2 kv = *(const u32x2*)(p + 384 + 4 * l);
        const unsigned krw = *(const unsigned*)(p + 640 + 2 * (l & 15));
        const u32x4 gq = *(const u32x4*)(p + 672 + 8 * l);
        const unsigned gkw = *(const unsigned*)(p + 1184 + 2 * l), gvw = *(const unsigned*)(p + 1312 + 2 * l);
        { float x[6] = {bf16lo(c0), bf16hi(c0), bf16lo(c1), bf16hi(c1), bf16lo(c2), bf16hi(c2)};
          float ss = 0.f;
#pragma unroll
          for (int i = 0; i < 6; ++i) ss += x[i] * x[i];
          const float rs = rsqrtf(wave_sum(ss) * (1.f / 384.f) + RMS_EPS);
          unsigned* o = (unsigned*)(CQN + (size_t)m * QLORA + 6 * l);
#pragma unroll
          for (int i = 0; i < 3; ++i) o[i] = cvt_pk_bf16(x[2 * i] * rs * qn[6 * l + 2 * i], x[2 * i + 1] * rs * qn[6 * l + 2 * i + 1]); }
        { float x[4] = {bf16lo(kv.x), bf16hi(kv.x), bf16lo(kv.y), bf16hi(kv.y)};
          const float ss = (x[0] * x[0] + x[1] * x[1]) + (x[2] * x[2] + x[3] * x[3]);
          const float rs = rsqrtf(wave_sum(ss) * (1.f / 256.f) + RMS_EPS);
          const f32x4 g = *(const f32x4*)(kvn + 4 * l);
          u32x2 w; w.x = cvt_pk_bf16(x[0] * rs * g.x, x[1] * rs * g.y); w.y = cvt_pk_bf16(x[2] * rs * g.z, x[3] * rs * g.w);
          *(u32x2*)(CKVN + (size_t)m * KVLORA + 4 * l) = w; }
        if (l < 16) { float x1 = bf16lo(krw), x2 = bf16hi(krw);
            if (lat) { const f32x2 cs = (l < 8) ? rope[gr * 8 + l] : rope[2048 + gc * 8 + (l - 8)]; const float a = x1 * cs.x - x2 * cs.y, b = x1 * cs.y + x2 * cs.x; x1 = a; x2 = b; }
            *(unsigned*)(KR + (size_t)m * 32 + 2 * l) = cvt_pk_bf16(x1, x2); }
        { float x[8] = {bf16lo(gq.x), bf16hi(gq.x), bf16lo(gq.y), bf16hi(gq.y), bf16lo(gq.z), bf16hi(gq.z), bf16lo(gq.w), bf16hi(gq.w)};
          float ss = 0.f;
#pragma unroll
          for (int i = 0; i < 8; ++i) ss += x[i] * x[i];
          ss += __shfl_xor(ss, 1); ss += __shfl_xor(ss, 2); ss += __shfl_xor(ss, 4);
          const float rs = rsqrtf(ss * (1.f / 64.f) + RMS_EPS);
          const int d0 = (l & 7) * 8;
          const f32x4 g0 = *(const f32x4*)(gqn + d0), g1 = *(const f32x4*)(gqn + d0 + 4);
          x[0] *= rs * g0.x; x[1] *= rs * g0.y; x[2] *= rs * g0.z; x[3] *= rs * g0.w; x[4] *= rs * g1.x; x[5] *= rs * g1.y; x[6] *= rs * g1.z; x[7] *= rs * g1.w;
          if (lat) { const int p0 = (l & 7) * 4; const f32x2* tp = (p0 < 16) ? rope + 2560 + gr * 16 + p0 : rope + 6656 + gc * 16 + (p0 - 16);
              const f32x4 cs0 = *(const f32x4*)tp, cs1 = *(const f32x4*)(tp + 2);
              float a;
              a = x[0] * cs0[0] - x[1] * cs0[1]; x[1] = x[0] * cs0[1] + x[1] * cs0[0]; x[0] = a;
              a = x[2] * cs0[2] - x[3] * cs0[3]; x[3] = x[2] * cs0[3] + x[3] * cs0[2]; x[2] = a;
              a = x[4] * cs1[0] - x[5] * cs1[1]; x[5] = x[4] * cs1[1] + x[5] * cs1[0]; x[4] = a;
              a = x[6] * cs1[2] - x[7] * cs1[3]; x[7] = x[6] * cs1[3] + x[7] * cs1[2]; x[6] = a; }
          u32x4 w; w.x = cvt_pk_bf16(x[0] * SC_B, x[1] * SC_B); w.y = cvt_pk_bf16(x[2] * SC_B, x[3] * SC_B); w.z = cvt_pk_bf16(x[4] * SC_B, x[5] * SC_B); w.w = cvt_pk_bf16(x[6] * SC_B, x[7] * SC_B);
          *(u32x4*)(QB + (size_t)m * 512 + 8 * l) = w; }
        { float x1 = bf16lo(gkw), x2 = bf16hi(gkw);
          float ss = x1 * x1 + x2 * x2;
          ss += __shfl_xor(ss, 1); ss += __shfl_xor(ss, 2); ss += __shfl_xor(ss, 4); ss += __shfl_xor(ss, 8); ss += __shfl_xor(ss, 16);
          const float rs = rsqrtf(ss * (1.f / 64.f) + RMS_EPS);
          const int pi = l & 31;
          x1 *= rs * gkn[2 * pi]; x2 *= rs * gkn[2 * pi + 1];
          if (lat) { const f32x2 cs = (pi < 16) ? rope[2560 + gr * 16 + pi] : rope[6656 + gc * 16 + (pi - 16)]; const float a = x1 * cs.x - x2 * cs.y, b = x1 * cs.y + x2 * cs.x; x1 = a; x2 = b; }
          *(unsigned*)(KB + (size_t)m * 128 + 2 * l) = cvt_pk_bf16(x1, x2);
          *(unsigned*)(VB + (size_t)m * 128 + 2 * l) = gvw; }
    }
}

namespace att {
constexpr int B_KN = 0, B_KR = 8192, B_V = 12288, BUF = 20480;
constexpr float THR2 = 8.f * LOG2E;
__device__ __forceinline__ int crow(int r, int hi) { return (r & 3) + 8 * (r >> 2) + 4 * hi; }
__device__ __forceinline__ int swz64(int row, int ch) { return row * 128 + ((ch ^ ((row >> 1) & 7)) << 4); }
__device__ __forceinline__ int swz32(int row, int ch) { return row * 64 + ((ch ^ ((row >> 2) & 3)) << 4); }
__device__ __forceinline__ int v_st(int k, int c) { const int kk = k;     return ((kk >> 3) * 2 + (c >> 5)) * 512 + ((kk & 7) * 32 + (c & 31)) * 2; }
__device__ __forceinline__ int v_rd_base(int lane) { return ((lane & 3) << 3) | (((lane >> 2) & 3) << 6) | (((lane >> 4) & 1) << 5) | (((lane >> 5) & 1) << 8); }
constexpr int v_rd_off(int d0, int ks, int half) { return d0 * 512 + ks * 2048 + half * 1024; }
template <int OFF> __device__ __forceinline__ s16x4 tr_read(unsigned vb) {
    s16x4 r; asm volatile("ds_read_b64_tr_b16 %0, %1 offset:%2" : "=&v"(r) : "v"(vb), "i"(OFF) : "memory"); return r;
}
__device__ __forceinline__ float psm_max(const f32x16& p0, const f32x16& p1) {
    float pmax = p0[0];
#pragma unroll
    for (int r = 1; r < 16; ++r) pmax = fmaxf(pmax, p0[r]);
#pragma unroll
    for (int r = 0; r < 16; ++r) pmax = fmaxf(pmax, p1[r]);
    { auto rr = __builtin_amdgcn_permlane32_swap(__float_as_uint(pmax), __float_as_uint(pmax), false, false);
      pmax = fmaxf(__uint_as_float(rr[0]), __uint_as_float(rr[1])); }
    return pmax;
}
template <bool FIRST> __device__ __forceinline__ void psm_apply(f32x16& p0, f32x16& p1, float pmax, float& m_reg, f32x16& negm, float& alpha) {
    alpha = 1.f;
    if (FIRST || !__builtin_expect(__all(pmax <= THR2), 1)) {
        const float delta = FIRST ? pmax : fmaxf(pmax, 0.f);
        if (!FIRST) alpha = __builtin_amdgcn_exp2f(-delta);
        m_reg += delta;
#pragma unroll
        for (int r = 0; r < 16; ++r) { p0[r] -= delta; p1[r] -= delta; negm[r] = -m_reg; }
    }
#pragma unroll
    for (int r = 0; r < 16; ++r) p0[r] = EXP_PROBE ? fmaf(p0[r], 0.001f, 1.f) : __builtin_amdgcn_exp2f(p0[r]);
}
template <bool FIRST> __device__ __forceinline__ void partialSM(f32x16& p0, f32x16& p1, float& m_reg, f32x16& negm, float& alpha) {
    const float pmax = psm_max(p0, p1); psm_apply<FIRST>(p0, p1, pmax, m_reg, negm, alpha);
}
#define ATT_PK4(P, BASE, OUT) do { unsigned a0 = cvt_pk_bf16(P[BASE + 0], P[BASE + 1]), a1 = cvt_pk_bf16(P[BASE + 2], P[BASE + 3]);   \
    unsigned b0 = cvt_pk_bf16(P[BASE + 4], P[BASE + 5]), b1 = cvt_pk_bf16(P[BASE + 6], P[BASE + 7]);                              \
    auto r0 = __builtin_amdgcn_permlane32_swap(a0, b0, false, false); auto r1 = __builtin_amdgcn_permlane32_swap(a1, b1, false, false); \
    u32x4 w = {r0[0], r1[0], r0[1], r1[1]}; OUT = __builtin_bit_cast(bf16x8, w); } while (0)
#define ATT_PKN(P, BASE, OUT) do { u32x4 w = {cvt_pk_bf16(P[BASE + 0], P[BASE + 1]), cvt_pk_bf16(P[BASE + 2], P[BASE + 3]), cvt_pk_bf16(P[BASE + 4], P[BASE + 5]), cvt_pk_bf16(P[BASE + 6], P[BASE + 7])}; \
    OUT = __builtin_bit_cast(bf16x8, w); } while (0)
__device__ __forceinline__ void finishSM(f32x16& p0, f32x16& p1, float alpha, float& l_reg, bf16x8& pa0, bf16x8& pa1, bf16x8& pa2, bf16x8& pa3) {
#pragma unroll
    for (int r = 0; r < 16; ++r) p1[r] = EXP_PROBE ? fmaf(p1[r], 0.001f, 1.f) : __builtin_amdgcn_exp2f(p1[r]);
    float ps = 0.f;
#pragma unroll
    for (int r = 0; r < 16; ++r) ps += p0[r];
#pragma unroll
    for (int r = 0; r < 16; ++r) ps += p1[r];
    { auto rr = __builtin_amdgcn_permlane32_swap(__float_as_uint(ps), __float_as_uint(ps), false, false);
      ps = __uint_as_float(rr[0]) + __uint_as_float(rr[1]); }
    l_reg = l_reg * alpha + ps;
    ATT_PKN(p0, 0, pa0); ATT_PKN(p0, 8, pa1); ATT_PKN(p1, 0, pa2); ATT_PKN(p1, 8, pa3);
}
template <int DQK> __device__ __forceinline__ void qkt(f32x16& p0, f32x16& p1, const LAS char* buf, const bf16x8* qr, int r32, int hi, const f32x16& negm) {
#pragma unroll
    for (int d0 = 0; d0 < 4; ++d0) { const int ch = d0 * 2 + hi;
        const bf16x8 b0 = *(const LAS bf16x8*)(buf + B_KN + swz64(r32, ch));
        const bf16x8 b1 = *(const LAS bf16x8*)(buf + B_KN + swz64(32 + r32, ch));
        p0 = __builtin_amdgcn_mfma_f32_32x32x16_bf16(b0, qr[d0], d0 == 0 ? negm : p0, 0, 0, 0);
        p1 = __builtin_amdgcn_mfma_f32_32x32x16_bf16(b1, qr[d0], d0 == 0 ? negm : p1, 0, 0, 0); }
    if constexpr (DQK == 96) {
#pragma unroll
        for (int d0 = 0; d0 < 2; ++d0) { const int ch = d0 * 2 + hi;
            const bf16x8 b0 = *(const LAS bf16x8*)(buf + B_KR + swz32(r32, ch));
            const bf16x8 b1 = *(const LAS bf16x8*)(buf + B_KR + swz32(32 + r32, ch));
            p0 = __builtin_amdgcn_mfma_f32_32x32x16_bf16(b0, qr[4 + d0], p0, 0, 0, 0);
            p1 = __builtin_amdgcn_mfma_f32_32x32x16_bf16(b1, qr[4 + d0], p1, 0, 0, 0); }
    }
}
template <int D0> __device__ __forceinline__ void pv_one(f32x16& od, unsigned vb, bf16x8 pa0, bf16x8 pa1, bf16x8 pa2, bf16x8 pa3) {
    const s16x4 l0 = tr_read<v_rd_off(D0, 0, 0)>(vb), h0 = tr_read<v_rd_off(D0, 0, 1)>(vb), l1 = tr_read<v_rd_off(D0, 1, 0)>(vb), h1 = tr_read<v_rd_off(D0, 1, 1)>(vb);
    const s16x4 l2 = tr_read<v_rd_off(D0, 2, 0)>(vb), h2 = tr_read<v_rd_off(D0, 2, 1)>(vb), l3 = tr_read<v_rd_off(D0, 3, 0)>(vb), h3 = tr_read<v_rd_off(D0, 3, 1)>(vb);
    asm volatile("s_waitcnt lgkmcnt(0)" ::: "memory"); SBAR();
#define ATT_PK(L, H) (bf16x8){L[0], L[1], L[2], L[3], H[0], H[1], H[2], H[3]}
    od = __builtin_amdgcn_mfma_f32_32x32x16_bf16(ATT_PK(l0, h0), pa0, od, 0, 0, 0);
    od = __builtin_amdgcn_mfma_f32_32x32x16_bf16(ATT_PK(l1, h1), pa1, od, 0, 0, 0);
    od = __builtin_amdgcn_mfma_f32_32x32x16_bf16(ATT_PK(l2, h2), pa2, od, 0, 0, 0);
    od = __builtin_amdgcn_mfma_f32_32x32x16_bf16(ATT_PK(l3, h3), pa3, od, 0, 0, 0);
#undef ATT_PK
}

#define ATT_PK(L, H) (bf16x8){L[0], L[1], L[2], L[3], H[0], H[1], H[2], H[3]}
template <bool FIXM> __device__ __forceinline__ void pv_psm(f32x16& o0, f32x16& o1, unsigned vb, bf16x8 pa0, bf16x8 pa1, bf16x8 pa2, bf16x8 pa3,
                                       f32x16& p0, f32x16& p1, float& m_reg, f32x16& negm, float& alpha) {
    { const s16x4 l0 = tr_read<v_rd_off(0, 0, 0)>(vb), h0 = tr_read<v_rd_off(0, 0, 1)>(vb), l1 = tr_read<v_rd_off(0, 1, 0)>(vb), h1 = tr_read<v_rd_off(0, 1, 1)>(vb);
      const s16x4 l2 = tr_read<v_rd_off(0, 2, 0)>(vb), h2 = tr_read<v_rd_off(0, 2, 1)>(vb), l3 = tr_read<v_rd_off(0, 3, 0)>(vb), h3 = tr_read<v_rd_off(0, 3, 1)>(vb);
      float pmax = 0.f; SBAR(); if (!FIXM) pmax = psm_max(p0, p1); else { _Pragma("unroll") for (int r = 0; r < 8; ++r) p0[r] = __builtin_amdgcn_exp2f(p0[r]); } SBAR();
      asm volatile("s_waitcnt lgkmcnt(0)" ::: "memory"); SBAR();
      o0 = __builtin_amdgcn_mfma_f32_32x32x16_bf16(ATT_PK(l0, h0), pa0, o0, 0, 0, 0);
      o0 = __builtin_amdgcn_mfma_f32_32x32x16_bf16(ATT_PK(l1, h1), pa1, o0, 0, 0, 0);
      o0 = __builtin_amdgcn_mfma_f32_32x32x16_bf16(ATT_PK(l2, h2), pa2, o0, 0, 0, 0);
      o0 = __builtin_amdgcn_mfma_f32_32x32x16_bf16(ATT_PK(l3, h3), pa3, o0, 0, 0, 0);
      SBAR();
      const s16x4 m0 = tr_read<v_rd_off(1, 0, 0)>(vb), n0 = tr_read<v_rd_off(1, 0, 1)>(vb), m1 = tr_read<v_rd_off(1, 1, 0)>(vb), n1 = tr_read<v_rd_off(1, 1, 1)>(vb);
      const s16x4 m2 = tr_read<v_rd_off(1, 2, 0)>(vb), n2 = tr_read<v_rd_off(1, 2, 1)>(vb), m3 = tr_read<v_rd_off(1, 3, 0)>(vb), n3 = tr_read<v_rd_off(1, 3, 1)>(vb);
      SBAR(); if (!FIXM) psm_apply<false>(p0, p1, pmax, m_reg, negm, alpha); else { alpha = 1.f; _Pragma("unroll") for (int r = 8; r < 16; ++r) p0[r] = __builtin_amdgcn_exp2f(p0[r]); } SBAR();
      asm volatile("s_waitcnt lgkmcnt(0)" ::: "memory"); SBAR();
      o1 = __builtin_amdgcn_mfma_f32_32x32x16_bf16(ATT_PK(m0, n0), pa0, o1, 0, 0, 0);
      o1 = __builtin_amdgcn_mfma_f32_32x32x16_bf16(ATT_PK(m1, n1), pa1, o1, 0, 0, 0);
      o1 = __builtin_amdgcn_mfma_f32_32x32x16_bf16(ATT_PK(m2, n2), pa2, o1, 0, 0, 0);
      o1 = __builtin_amdgcn_mfma_f32_32x32x16_bf16(ATT_PK(m3, n3), pa3, o1, 0, 0, 0); }
}
#undef ATT_PK
template <int DQK, bool FIXM>
__device__ __forceinline__ void attn_unit(const bf16_t* __restrict__ Qp, int ldq, const bf16_t* __restrict__ Knp, int ldk, const bf16_t* __restrict__ Krp,
                                          const bf16_t* __restrict__ Vp, int ldv, bf16_t* __restrict__ Op, int lat0, int nlt, int ctx0, int NT, LAS char* lds, const int tid, const f32x2* rope, int qtok0, float mfix) {
    constexpr int NQ = DQK / 16;
    const int wid = tid >> 6, lane = tid & 63, r32 = lane & 31, hi = lane >> 5;
    float m_reg = 0.f, l_reg = 0.f; f32x16 o0 = {}, o1 = {}, negm = {}; bf16x8 qr[NQ];
    if (FIXM) { _Pragma("unroll") for (int r = 0; r < 16; ++r) negm[r] = -mfix; }
    const bf16_t* Qw = Qp + (size_t)(wid * 32 + r32) * ldq + hi * 8;
#pragma unroll
    for (int d0 = 0; d0 < NQ; ++d0) qr[d0] = *(const bf16x8*)(Qw + d0 * 16);
    if constexpr (DQK == 96) { if (qtok0 >= 0) {
        const int t = qtok0 + wid * 32 + r32, gr = t >> 6, gc = t & 63;
#pragma unroll
        for (int e = 0; e < 2; ++e) { const f32x2* tp = (e == 0) ? rope + gr * 8 + hi * 4 : rope + 2048 + gc * 8 + hi * 4;
            const f32x4 cs0 = *(const f32x4*)tp, cs1 = *(const f32x4*)(tp + 2);
            const u32x4 w = __builtin_bit_cast(u32x4, qr[4 + e]); u32x4 o;
            { const float x1 = bf16lo(w.x), x2 = bf16hi(w.x); o.x = cvt_pk_bf16(x1 * cs0[0] - x2 * cs0[1], x1 * cs0[1] + x2 * cs0[0]); }
            { const float x1 = bf16lo(w.y), x2 = bf16hi(w.y); o.y = cvt_pk_bf16(x1 * cs0[2] - x2 * cs0[3], x1 * cs0[3] + x2 * cs0[2]); }
            { const float x1 = bf16lo(w.z), x2 = bf16hi(w.z); o.z = cvt_pk_bf16(x1 * cs1[0] - x2 * cs1[1], x1 * cs1[1] + x2 * cs1[0]); }
            { const float x1 = bf16lo(w.w), x2 = bf16hi(w.w); o.w = cvt_pk_bf16(x1 * cs1[2] - x2 * cs1[3], x1 * cs1[3] + x2 * cs1[2]); }
            qr[4 + e] = __builtin_bit_cast(bf16x8, o); } } }
    const int sr = tid >> 3, c8 = tid & 7, sr2 = (tid >> 2) & 63, c4 = tid & 3;
    const bool krw = (DQK == 96) && (tid < 256);
    const int kn_st = B_KN + swz64(sr, c8), v_stw = B_V + v_st(sr, c8 * 8), kr_st = B_KR + swz32(sr2, c4);
    const unsigned vb0 = (unsigned)(uintptr_t)lds + B_V + v_rd_base(lane);
    bf16x8 skn[2], sv[2], skr[2];
#define KROW(j) ((j) < nlt ? lat0 + 64 * (j) : ctx0 + 64 * ((j) - nlt))
#define SLOAD(i, j) do { const int _row = KROW(j); skn[i] = *(const bf16x8*)(Knp + (size_t)(_row + sr) * ldk + c8 * 8); sv[i] = *(const bf16x8*)(Vp + (size_t)(_row + sr) * ldv + c8 * 8); \
        if (krw) skr[i] = *(const bf16x8*)(Krp + (size_t)(_row + sr2) * 32 + c4 * 8); } while (0)
#define SWRITE(b, i) do { *(LAS bf16x8*)(lds + (b) * BUF + kn_st) = skn[i]; *(LAS bf16x8*)(lds + (b) * BUF + v_stw) = sv[i]; if (krw) *(LAS bf16x8*)(lds + (b) * BUF + kr_st) = skr[i]; } while (0)
#define SWRITEO(boff, i) do { *(LAS bf16x8*)(lds + (boff) + kn_st) = skn[i]; *(LAS bf16x8*)(lds + (boff) + v_stw) = sv[i]; if (krw) *(LAS bf16x8*)(lds + (boff) + kr_st) = skr[i]; } while (0)
#define PVO(boff) do { pv_one<0>(o0, vb0 + (boff), pa0, pa1, pa2, pa3); pv_one<1>(o1, vb0 + (boff), pa0, pa1, pa2, pa3); } while (0)
#define SWAIT() asm volatile("s_waitcnt vmcnt(2)" ::: "memory")
#define RESC(a) do { if (__any((a) < 1.f)) { _Pragma("unroll") for (int r = 0; r < 16; ++r) { o0[r] *= (a); o1[r] *= (a); } } } while (0)
#define PV(bufi) do { pv_one<0>(o0, vb0 + (bufi) * BUF, pa0, pa1, pa2, pa3); pv_one<1>(o1, vb0 + (bufi) * BUF, pa0, pa1, pa2, pa3); } while (0)
    f32x16 pA0, pA1, pB0, pB1; float alA, alB; bf16x8 pa0, pa1, pa2, pa3;
    int bV = 0, bK = BUF, bW = 2 * BUF;
#define ROT() do { const int _t = bV; bV = bK; bK = bW; bW = _t; } while (0)
    __syncthreads();
    SLOAD(0, 0); asm volatile("s_waitcnt vmcnt(0)" ::: "memory"); SWRITE(0, 0);
    SLOAD(1, 1); if (2 < NT) SLOAD(0, 2);
    __syncthreads();
    qkt<DQK>(pA0, pA1, lds, qr, r32, hi, negm);
    if (FIXM) { alA = 1.f; _Pragma("unroll") for (int r = 0; r < 16; ++r) pA0[r] = __builtin_amdgcn_exp2f(pA0[r]); } else partialSM<true>(pA0, pA1, m_reg, negm, alA);
    SWAIT(); SWRITEO(BUF, 1);
    for (int j = 1; j + 1 < NT; j += 2) {
        if (!NOBAR_PROBE) __syncthreads();
        SBAR(); qkt<DQK>(pB0, pB1, lds + bK, qr, r32, hi, negm);
        finishSM(pA0, pA1, alA, l_reg, pa0, pa1, pa2, pa3); SBAR();
        SLOAD(1, j + 2); SBAR();
        if constexpr (FIXM) pv_psm<true>(o0, o1, vb0 + bV, pa0, pa1, pa2, pa3, pB0, pB1, m_reg, negm, alB); else { PVO(bV); partialSM<false>(pB0, pB1, m_reg, negm, alB); }
        SWAIT(); SWRITEO(bW, 0);
        if (!FIXM) RESC(alB); ROT();
        if (!NOBAR_PROBE) __syncthreads();
        SBAR(); qkt<DQK>(pA0, pA1, lds + bK, qr, r32, hi, negm);
        finishSM(pB0, pB1, alB, l_reg, pa0, pa1, pa2, pa3); SBAR();
        if (j + 3 < NT) SLOAD(0, j + 3); SBAR();
        if constexpr (FIXM) pv_psm<true>(o0, o1, vb0 + bV, pa0, pa1, pa2, pa3, pA0, pA1, m_reg, negm, alA); else { PVO(bV); partialSM<false>(pA0, pA1, m_reg, negm, alA); }
        SWAIT(); SWRITEO(bW, 1);
        if (!FIXM) RESC(alA); ROT();
    }
    __syncthreads();
    SBAR(); qkt<DQK>(pB0, pB1, lds + bK, qr, r32, hi, negm);
    finishSM(pA0, pA1, alA, l_reg, pa0, pa1, pa2, pa3); SBAR();
    if constexpr (FIXM) pv_psm<true>(o0, o1, vb0 + bV, pa0, pa1, pa2, pa3, pB0, pB1, m_reg, negm, alB); else { PVO(bV); partialSM<false>(pB0, pB1, m_reg, negm, alB); }
    if (!FIXM) RESC(alB);
    finishSM(pB0, pB1, alB, l_reg, pa0, pa1, pa2, pa3); SBAR();
    PVO(bK);
#undef ROT
    const float inv = __builtin_amdgcn_rcpf(l_reg);
    bf16_t* Ow = Op + (size_t)(wid * 32 + r32) * 1024 + 4 * hi;
#pragma unroll
    for (int g = 0; g < 4; ++g) {
        u32x2 w0, w1;
        w0.x = cvt_pk_bf16(o0[4 * g] * inv, o0[4 * g + 1] * inv); w0.y = cvt_pk_bf16(o0[4 * g + 2] * inv, o0[4 * g + 3] * inv);
        w1.x = cvt_pk_bf16(o1[4 * g] * inv, o1[4 * g + 1] * inv); w1.y = cvt_pk_bf16(o1[4 * g + 2] * inv, o1[4 * g + 3] * inv);
        *(u32x2*)(Ow + 8 * g) = w0; *(u32x2*)(Ow + 32 + 8 * g) = w1;
    }
#undef KROW
#undef SLOAD
#undef SWRITE
#undef SWAIT
#undef SWRITEO
#undef PVO
#undef RESC
#undef PV
}
}

__device__ __forceinline__ void attn_phase(Frame& F, int li) {
    const bf16_t* QA = (const bf16_t*)(F.ws + R_QA); const bf16_t* KVA = (const bf16_t*)(F.ws + R_KVA); const bf16_t* KR = (const bf16_t*)(F.ws + R_KR);
    const bf16_t* QB = (const bf16_t*)(F.ws + R_QB); const bf16_t* KB = (const bf16_t*)(F.ws + R_KB); const bf16_t* VB = (const bf16_t*)(F.ws + R_VB);
    bf16_t* O = (bf16_t*)(F.ws + R_O);
    LAS char* lds = (LAS char*)F.lds;
    float mfixB; { float gq = 0.f, gk = 0.f; const float* a = F.in[15] + li * 64; const float* b = F.in[16] + li * 64;
        for (int i = 0; i < 64; ++i) { gq = fmaxf(gq, fabsf(a[i])); gk = fmaxf(gk, fabsf(b[i])); } mfixB = 64.f * gq * gk * SC_B * 1.02f; }
    constexpr int NU = 2048 + 32;
    for (int u = F.vcu; u < NU; u += F.G) {
        if (u < 1024 || (u >= 2048 && u < 2064)) {
            const bool isctx = u >= 2048; const int uu = isctx ? u - 2048 : u;
            const int b = isctx ? (uu >> 3) : (uu >> 9), h = isctx ? (uu & 7) : ((uu >> 6) & 7), qb = uu & 63;
            const int q0 = isctx ? NLAT + b * CTXL : b * SEQ + qb * 256;
            att::attn_unit<96, false>(QA + (size_t)q0 * 768 + h * 96, 768, KVA + h * 128, 1024, KR, KVA + h * 128 + 64, 1024, O + (size_t)q0 * 1024 + h * 64,
                               b * SEQ, isctx ? 0 : 256, NLAT + b * CTXL, isctx ? 4 : 260, lds, F.tid, (const f32x2*)(F.ws + WS_ROPE), isctx ? -1 : qb * 256, 0.f);
        } else {
            const bool isctx = u >= 2064; const int uu = isctx ? u - 2064 : u - 1024;
            const int b = isctx ? (uu >> 3) : (uu >> 9), h = isctx ? (uu & 7) : ((uu >> 6) & 7), qb = uu & 63, kvh = h >> 2;
            const int q0 = isctx ? NLAT + b * CTXL : b * SEQ + qb * 256;
            att::attn_unit<64, true>(QB + (size_t)q0 * 512 + h * 64, 512, KB + kvh * 64, 128, nullptr, VB + kvh * 64, 128, O + (size_t)q0 * 1024 + 512 + h * 64,
                               b * SEQ, isctx ? 0 : 256, NLAT + b * CTXL, isctx ? 4 : 260, lds, F.tid, nullptr, -1, mfixB);
        }
    }
}

namespace na {
constexpr int TABH = 528;
constexpr int L_KC = 0, L_VC = 32768, VC_LD = 528, L_TAB = L_VC + 64 * VC_LD, L_END = L_TAB + TABH * 4;
struct Tile { bf16x8 kf[4]; bf16x8 vf[2][2]; };
__device__ __forceinline__ void load_tile(Tile& T, const bf16_t* kbase, const bf16_t* vbase, size_t vld, int r32, int hi) {
#pragma unroll
    for (int d0 = 0; d0 < 4; ++d0) T.kf[d0] = *(const bf16x8*)(kbase + (size_t)r32 * 2048 + d0 * 16 + hi * 8);
#pragma unroll
    for (int dv = 0; dv < 2; ++dv)
#pragma unroll
        for (int ks = 0; ks < 2; ++ks) T.vf[dv][ks] = *(const bf16x8*)(vbase + (size_t)(32 * dv + r32) * vld + 16 * ks + 8 * hi);
}
__device__ __forceinline__ void load_tile_lds(Tile& T, const LAS char* lds, int t, int r32, int hi) {
#pragma unroll
    for (int d0 = 0; d0 < 4; ++d0) T.kf[d0] = *(const LAS bf16x8*)(lds + L_KC + att::swz64(32 * t + r32, d0 * 2 + hi));
#pragma unroll
    for (int dv = 0; dv < 2; ++dv)
#pragma unroll
        for (int ks = 0; ks < 2; ++ks) T.vf[dv][ks] = *(const LAS bf16x8*)(lds + L_VC + (32 * dv + r32) * VC_LD + (32 * t + 16 * ks + 8 * hi) * 2);
}
constexpr int L_WST = L_END, WST_K = 0, WST_V = 4096, WST_VLD = 80, WST_BYTES = 4096 + 64 * 80;
struct RawTile { bf16x8 k[4], v[4]; };
__device__ __forceinline__ void load_raw(RawTile& T, const bf16_t* kbase, const bf16_t* vbase, int lane) {
#pragma unroll
    for (int i = 0; i < 4; ++i) { T.k[i] = *(const bf16x8*)(kbase + (size_t)(i * 8 + (lane >> 3)) * 2048 + (lane & 7) * 8);
                                  T.v[i] = *(const bf16x8*)(vbase + (size_t)(i * 16 + (lane >> 2)) * SEQ + (lane & 3) * 8); }
}
__device__ __forceinline__ void stage_raw(const RawTile& T, LAS char* w, int lane) {
#pragma unroll
    for (int i = 0; i < 4; ++i) { *(LAS bf16x8*)(w + WST_K + att::swz64(i * 8 + (lane >> 3), lane & 7)) = T.k[i];
                                  *(LAS bf16x8*)(w + WST_V + (i * 16 + (lane >> 2)) * WST_VLD + (lane & 3) * 16) = T.v[i]; }
}
__device__ __forceinline__ void load_tile_wst(Tile& T, const LAS char* w, int r32, int hi) {
#pragma unroll
    for (int d0 = 0; d0 < 4; ++d0) T.kf[d0] = *(const LAS bf16x8*)(w + WST_K + att::swz64(r32, d0 * 2 + hi));
#pragma unroll
    for (int dv = 0; dv < 2; ++dv)
#pragma unroll
        for (int ks = 0; ks < 2; ++ks) T.vf[dv][ks] = *(const LAS bf16x8*)(w + WST_V + (32 * dv + r32) * WST_VLD + (16 * ks + 8 * hi) * 2);
}
template <bool NBR> __device__ __forceinline__ void tile_step(const Tile& cur, const bf16x8 (&qr)[4], float& m_reg, float& l_reg, f32x16& o0, f32x16& o1,
                                                              bool vr, int dlt, const LAS float* tr, int hi) {
    f32x16 p = {};
#pragma unroll
    for (int d0 = 0; d0 < 4; ++d0) p = __builtin_amdgcn_mfma_f32_32x32x16_bf16(cur.kf[d0], qr[d0], p, 0, 0, 0);
    if (NBR) {
#pragma unroll
        for (int r = 0; r < 16; ++r) { const int kcl = (r & 3) + 8 * (r >> 2) + 4 * hi;
            const bool ok = vr && (kcl >= dlt) && (kcl < dlt + 16);
            p[r] = ok ? p[r] + tr[(r & 3) + 8 * (r >> 2)] : -3.0e38f; }
    }
    float pmax = p[0];
#pragma unroll
    for (int r = 1; r < 16; ++r) pmax = fmaxf(pmax, p[r]);
    { auto rr = __builtin_amdgcn_permlane32_swap(__float_as_uint(pmax), __float_as_uint(pmax), false, false);
      pmax = fmaxf(__uint_as_float(rr[0]), __uint_as_float(rr[1])); }
    if (!__all(pmax - m_reg <= att::THR2)) {
        const float mn = fmaxf(m_reg, pmax), alpha = __builtin_amdgcn_exp2f(m_reg - mn); m_reg = mn; l_reg *= alpha;
#pragma unroll
        for (int r = 0; r < 16; ++r) { o0[r] *= alpha; o1[r] *= alpha; }
    }
    float ps = 0.f;
#pragma unroll
    for (int r = 0; r < 16; ++r) { p[r] = __builtin_amdgcn_exp2f(p[r] - m_reg); ps += p[r]; }
    { auto rr = __builtin_amdgcn_permlane32_swap(__float_as_uint(ps), __float_as_uint(ps), false, false);
      ps = __uint_as_float(rr[0]) + __uint_as_float(rr[1]); }
    l_reg += ps;
    bf16x8 pa0, pa1;
    ATT_PK4(p, 0, pa0); ATT_PK4(p, 8, pa1);
    o0 = __builtin_amdgcn_mfma_f32_32x32x16_bf16(cur.vf[0][0], pa0, o0, 0, 0, 0);
    o0 = __builtin_amdgcn_mfma_f32_32x32x16_bf16(cur.vf[0][1], pa1, o0, 0, 0, 0);
    o1 = __builtin_amdgcn_mfma_f32_32x32x16_bf16(cur.vf[1][0], pa0, o1, 0, 0, 0);
    o1 = __builtin_amdgcn_mfma_f32_32x32x16_bf16(cur.vf[1][1], pa1, o1, 0, 0, 0);
}
__device__ __forceinline__ void store_o(bf16_t* Ow, const f32x16& o0, const f32x16& o1, float inv) {
#pragma unroll
    for (int g = 0; g < 4; ++g) {
        u32x2 w0, w1;
        w0.x = cvt_pk_bf16(o0[4 * g] * inv, o0[4 * g + 1] * inv); w0.y = cvt_pk_bf16(o0[4 * g + 2] * inv, o0[4 * g + 3] * inv);
        w1.x = cvt_pk_bf16(o1[4 * g] * inv, o1[4 * g + 1] * inv); w1.y = cvt_pk_bf16(o1[4 * g + 2] * inv, o1[4 * g + 3] * inv);
        *(u32x2*)(Ow + 8 * g) = w0; *(u32x2*)(Ow + 32 + 8 * g) = w1;
    }
}
__device__ __forceinline__ void na_phase(Frame& F, int li, bool need_ctx) {
    const bf16_t* QK = (const bf16_t*)(F.ws + R_QK); const bf16_t* Vt = (const bf16_t*)(F.ws + R_VT); const bf16_t* Vtc = (const bf16_t*)(F.ws + R_VTC);
    bf16_t* ON = (bf16_t*)(F.ws + R_ON);
    LAS char* lds = (LAS char*)F.lds; LAS float* tab = (LAS float*)(lds + L_TAB);
    const int r32 = F.lane & 31, hi = F.lane >> 5;
    for (int bi = F.vcu; bi < 256; bi += F.G) {
        const int bh = bi >> 3, b = bh >> 4, h = bh & 15, sub = bi & 7;
        __syncthreads();
        { const float* rpb = F.in[19] + ((size_t)li * 16 + h) * 465;
          for (int i = F.tid; i < TABH; i += NTHREADS) { const int j = i - 16; tab[i] = (j >= 0 && j < 465) ? rpb[j] * LOG2E : 0.f; }
          const bf16_t* ksrc = QK + (size_t)(NLAT + b * CTXL) * 2048 + 1024 + h * 64; const bf16_t* vsrc = Vtc + (size_t)(b * 16 + h) * 64 * CTXL;
#pragma unroll
          for (int i = 0; i < 4; ++i) { const int c = F.tid + NTHREADS * i;
              *(LAS bf16x8*)(lds + L_KC + att::swz64(c >> 3, c & 7)) = *(const bf16x8*)(ksrc + (size_t)(c >> 3) * 2048 + (c & 7) * 8);
              *(LAS bf16x8*)(lds + L_VC + (c >> 5) * VC_LD + (c & 31) * 16) = *(const bf16x8*)(vsrc + (size_t)(c >> 5) * CTXL + (c & 31) * 8); } }
        __syncthreads();
        for (int pi = F.wave; pi < 64; pi += NWAVES) {
            const int patch = sub * 64 + pi, R = 2 * (patch >> 2), C = 16 * (patch & 3);
            const int qrow = R + (r32 >> 4), qcol = C + (r32 & 15), mq = b * SEQ + qrow * 64 + qcol;
            const int krow_lo = min(max(R - 4, 0), 248), krow_hi = min(max(R - 3, 0), 248) + 7, nn = krow_hi - krow_lo + 1, kc0 = min(max(C - 8, 0), 32);
            const int rsq = min(max(qrow - 4, 0), 248), dlt = min(max(qcol - 8, 0), 48) - kc0;
            const LAS float* tb = tab + 16 + (kc0 - qcol + 15);
            bf16x8 qr[4];
#pragma unroll
            for (int d0 = 0; d0 < 4; ++d0) qr[d0] = *(const bf16x8*)(QK + (size_t)mq * 2048 + h * 64 + d0 * 16 + hi * 8);
            const bf16_t* kn_base = QK + (size_t)(b * SEQ + krow_lo * 64 + kc0) * 2048 + 1024 + h * 64;
            const bf16_t* vn_base = Vt + (size_t)(b * 16 + h) * 64 * SEQ + krow_lo * 64 + kc0;
            float m_reg = -1e30f, l_reg = 0.f; f32x16 o0 = {}, o1 = {};
            Tile cur; RawTile nb;
            LAS char* wst = lds + L_WST + F.wave * WST_BYTES;
            load_raw(nb, kn_base, vn_base, F.lane);
#pragma unroll 2
            for (int t = 0; t < 8; ++t) { load_tile_lds(cur, lds, t, r32, hi); tile_step<false>(cur, qr, m_reg, l_reg, o0, o1, false, 0, tb, hi); }
            for (int t = 0; t < nn; ++t) {
                stage_raw(nb, wst, F.lane);
                if (t + 1 < nn) load_raw(nb, kn_base + (size_t)(t + 1) * 64 * 2048, vn_base + (t + 1) * 64, F.lane);
                load_tile_wst(cur, wst, r32, hi);
                const int kr = krow_lo + t; const bool vr = (kr >= rsq) && (kr < rsq + 8); const int rt = min(max(kr - qrow + 7, 0), 14);
                tile_step<true>(cur, qr, m_reg, l_reg, o0, o1, vr, dlt, tb + rt * 31 + 4 * hi, hi);
            }
            store_o(ON + (size_t)mq * 1024 + h * 64 + 4 * hi, o0, o1, __builtin_amdgcn_rcpf(l_reg));
        }
    }
    if (need_ctx) {
        for (int it = F.gw; it < 2 * 16 * 8; it += F.NGW) {
            const int bh = it >> 3, b = bh >> 4, h = bh & 15, mq = NLAT + b * CTXL + (it & 7) * 32 + r32;
            bf16x8 qr[4];
#pragma unroll
            for (int d0 = 0; d0 < 4; ++d0) qr[d0] = *(const bf16x8*)(QK + (size_t)mq * 2048 + h * 64 + d0 * 16 + hi * 8);
            const bf16_t* kc_base = QK + (size_t)(NLAT + b * CTXL) * 2048 + 1024 + h * 64; const bf16_t* vc_base = Vtc + (size_t)(b * 16 + h) * 64 * CTXL;
            float m_reg = -1e30f, l_reg = 0.f; f32x16 o0 = {}, o1 = {};
            Tile cur, nxt;
            load_tile(cur, kc_base, vc_base, CTXL, r32, hi);
            for (int t = 0; t < 8; ++t) {
                if (t + 1 < 8) load_tile(nxt, kc_base + (size_t)(t + 1) * 32 * 2048, vc_base + (t + 1) * 32, CTXL, r32, hi);
                tile_step<false>(cur, qr, m_reg, l_reg, o0, o1, false, 0, tab, hi);
                cur = nxt;
            }
            store_o(ON + (size_t)mq * 1024 + h * 64 + 4 * hi, o0, o1, __builtin_amdgcn_rcpf(l_reg));
        }
    }
}
}


__device__ __forceinline__ void dbg_mean_abs(Frame& F, const bf16_t* p, int nrows, int ld, int ncols, int slot) {
    float s = 0.f;
    for (int r = F.gw; r < nrows; r += F.NGW)
        for (int c = F.lane * 8; c < ncols; c += 512) { const u32x4 w = *(const u32x4*)(p + (size_t)r * ld + c);
            s += fabsf(bf16lo(w.x)) + fabsf(bf16hi(w.x)) + fabsf(bf16lo(w.y)) + fabsf(bf16hi(w.y)) + fabsf(bf16lo(w.z)) + fabsf(bf16hi(w.z)) + fabsf(bf16lo(w.w)) + fabsf(bf16hi(w.w)); }
    s = wave_sum(s);
    if (F.lane == 0) atomicAdd((float*)(F.ctl + CW_DBG + slot), s / ((float)nrows * (float)ncols));
}

__device__ __forceinline__ void dbg_ri(Frame& F, int slot) {
    const u32x2* RI = (const u32x2*)(F.ws + R_RI); float s = 0.f;
    for (int r = F.gw * 64 + F.lane; r < 65536; r += F.NGW * 64) { const u32x2 ri = RI[r]; if (ri.x != 0xffffffffu) s += 0.5f + u2f(ri.y); }
    s = wave_sum(s);
    if (F.lane == 0) atomicAdd((float*)(F.ctl + CW_DBG + slot), s / 65536.f);
}

__device__ __forceinline__ void dbg_listw(Frame& F, int slot) {
    const u32x2* listw = (const u32x2*)(F.ws + WS_LIST); float s = 0.f;
    for (int e = 0; e < 32; ++e) { const int c = (int)__hip_atomic_load(F.ctl + CW_CNT + e * 64, RLX_AGENT);
        for (int j = F.gw * 64 + F.lane; j < c; j += F.NGW * 64) s += u2f(listw[(size_t)e * MROWS + j].y); }
    s = wave_sum(s);
    if (F.lane == 0) atomicAdd((float*)(F.ctl + CW_DBG + slot), s / 66560.f);
}

#ifndef DBG_CHECK
#define DBG_CHECK 0
#endif
#if DBG_CHECK
__device__ __forceinline__ unsigned hash_u(unsigned x) { x ^= x >> 16; x *= 0x7feb352du; x ^= x >> 15; x *= 0x846ca68bu; x ^= x >> 16; return x; }
__device__ __forceinline__ float bf2f(bf16_t v) { return u2f((unsigned)v << 16); }
__device__ __forceinline__ void dbg_max(Frame& F, int slot, float err) { if (F.lane == 0) atomicMax(F.ctl + CW_DBG + slot, __builtin_bit_cast(unsigned, err)); }
__device__ __forceinline__ void rope_ref(float& x1, float& x2, int i, int n, int gr, int gc) {
    const int ii = i < n ? i : i - n; const float inv = powf(10000.f, -(float)ii / (float)n), ang = (float)(i < n ? gr : gc) * inv;
    float sn, cs; sincosf(ang, &sn, &cs); const float a = x1 * cs - x2 * sn, b = x1 * sn + x2 * cs; x1 = a; x2 = b;
}
__device__ __forceinline__ void check_gemm(Frame& F, int slot, const bf16_t* A, int lda, const float* W, int K, int N, const bf16_t* C, int ldc, float scale, int M, int ns) {
    float worst = 0.f;
    for (int i = F.gw; i < ns; i += F.NGW) { const unsigned hsh = hash_u(i * 2654435761u + slot); const int row = hsh % (unsigned)M, col = (hsh >> 8) % (unsigned)N;
        float a = 0.f; for (int k = F.lane; k < K; k += 64) a += bf2f(A[(size_t)row * lda + k]) * W[(size_t)k * N + col];
        const float ref = wave_sum(a) * scale, got = bf2f(C[(size_t)row * ldc + col]); worst = fmaxf(worst, fabsf(got - ref) / (0.1f + fabsf(ref))); }
    dbg_max(F, slot, worst);
}
__device__ __forceinline__ void check_out0(Frame& F, int slot, int ns) {
    const float* X = (const float*)(F.ws + WS_X); const bf16_t* O = (const bf16_t*)(F.ws + R_O); const float* W = F.in[10]; const float* mod = (const float*)(F.ws + WS_MOD);
    float worst = 0.f;
    for (int i = F.gw; i < ns; i += F.NGW) { const unsigned hsh = hash_u(i * 2654435761u + slot); const int row = hsh % (unsigned)MROWS, col = (hsh >> 8) & 1023;
        float a = 0.f; for (int k = F.lane; k < 1024; k += 64) a += bf2f(O[(size_t)row * 1024 + k]) * W[(size_t)k * 1024 + col];
        const float xin = row < NLAT ? F.in[0][(size_t)row * 1024 + col] : F.in[2][(size_t)(row - NLAT) * 1024 + col];
        const float g1 = mod[(size_t)row_class(row) * 6144 + 2 * 1024 + col];
        const float ref = xin + g1 * wave_sum(a), got = X[(size_t)row * 1024 + col]; worst = fmaxf(worst, fabsf(got - ref) / (0.1f + fabsf(ref))); }
    dbg_max(F, slot, worst);
}
__device__ __forceinline__ void check_prep(Frame& F, int slot, int li, int ns) {
    const bf16_t* P = (const bf16_t*)(F.ws + R_P);
    const bf16_t* CQN = (const bf16_t*)(F.ws + R_CQN); const bf16_t* CKVN = (const bf16_t*)(F.ws + R_CKVN); const bf16_t* KR = (const bf16_t*)(F.ws + R_KR);
    const bf16_t* QB = (const bf16_t*)(F.ws + R_QB); const bf16_t* KB = (const bf16_t*)(F.ws + R_KB); const bf16_t* VB = (const bf16_t*)(F.ws + R_VB);
    const float* qn = F.in[11] + li * QLORA; const float* kvn = F.in[13] + li * KVLORA; const float* gqn = F.in[15] + li * 64; const float* gkn = F.in[16] + li * 64;
    float worst = 0.f;
#define CHK(got, ref) worst = fmaxf(worst, fabsf(bf2f(got) - (ref)) / (0.1f + fabsf(ref)))
    for (int i = F.gw; i < ns; i += F.NGW) { const unsigned hsh = hash_u(i * 2654435761u + slot); const int m = (i & 7) == 7 ? NLAT + hsh % NCTX : hsh % NLAT;
        const bf16_t* p = P + (size_t)m * AB_INP; const bool lat = m < NLAT; const int t = m & (SEQ - 1), gr = t >> 6, gc = t & 63;
        float s = 0.f; for (int c = F.lane; c < 384; c += 64) { const float v = bf2f(p[c]); s += v * v; }
        const float rq = rsqrtf(wave_sum(s) / 384.f + RMS_EPS);
        for (int c = F.lane; c < 384; c += 64) CHK(CQN[(size_t)m * 384 + c], bf2f(p[c]) * rq * qn[c]);
        s = 0.f; for (int c = F.lane; c < 256; c += 64) { const float v = bf2f(p[384 + c]); s += v * v; }
        const float rk = rsqrtf(wave_sum(s) / 256.f + RMS_EPS);
        for (int c = F.lane; c < 256; c += 64) CHK(CKVN[(size_t)m * 256 + c], bf2f(p[384 + c]) * rk * kvn[c]);
        if (F.lane < 16) { float x1 = bf2f(p[640 + 2 * F.lane]), x2 = bf2f(p[641 + 2 * F.lane]); if (lat) rope_ref(x1, x2, F.lane, 8, gr, gc);
            CHK(KR[(size_t)m * 32 + 2 * F.lane], x1); CHK(KR[(size_t)m * 32 + 2 * F.lane + 1], x2); }
        for (int pr = F.lane; pr < 256; pr += 64) { const int h = pr >> 5, i2 = pr & 31; float ss = 0.f;
            for (int d = 0; d < 64; ++d) { const float v = bf2f(p[672 + h * 64 + d]); ss += v * v; }
            const float r = rsqrtf(ss / 64.f + RMS_EPS);
            float x1 = bf2f(p[672 + h * 64 + 2 * i2]) * r * gqn[2 * i2], x2 = bf2f(p[672 + h * 64 + 2 * i2 + 1]) * r * gqn[2 * i2 + 1]; if (lat) rope_ref(x1, x2, i2, 16, gr, gc);
            CHK(QB[(size_t)m * 512 + h * 64 + 2 * i2], x1 * SC_B); CHK(QB[(size_t)m * 512 + h * 64 + 2 * i2 + 1], x2 * SC_B); }
        { const int h = F.lane >> 5, i2 = F.lane & 31; float ss = 0.f;
            for (int d = 0; d < 64; ++d) { const float v = bf2f(p[1184 + h * 64 + d]); ss += v * v; }
            const float r = rsqrtf(ss / 64.f + RMS_EPS);
            float x1 = bf2f(p[1184 + h * 64 + 2 * i2]) * r * gkn[2 * i2], x2 = bf2f(p[1184 + h * 64 + 2 * i2 + 1]) * r * gkn[2 * i2 + 1]; if (lat) rope_ref(x1, x2, i2, 16, gr, gc);
            CHK(KB[(size_t)m * 128 + h * 64 + 2 * i2], x1); CHK(KB[(size_t)m * 128 + h * 64 + 2 * i2 + 1], x2);
            CHK(VB[(size_t)m * 128 + 2 * F.lane], bf2f(p[1312 + 2 * F.lane])); CHK(VB[(size_t)m * 128 + 2 * F.lane + 1], bf2f(p[1313 + 2 * F.lane])); }
    }
#undef CHK
    dbg_max(F, slot, worst);
}
__device__ __forceinline__ void check_attn(Frame& F, int slot, int type, int ns) {
    const bf16_t* QA = (const bf16_t*)(F.ws + R_QA); const bf16_t* KVA = (const bf16_t*)(F.ws + R_KVA); const bf16_t* KR = (const bf16_t*)(F.ws + R_KR);
    const bf16_t* QB = (const bf16_t*)(F.ws + R_QB); const bf16_t* KB = (const bf16_t*)(F.ws + R_KB); const bf16_t* VB = (const bf16_t*)(F.ws + R_VB);
    const bf16_t* O = (const bf16_t*)(F.ws + R_O);
    LAS float* qs = (LAS float*)(F.lds + F.wave * 512);
    float worst = 0.f;
    for (int i = F.gw; i < ns; i += F.NGW) { const unsigned hsh = hash_u(i * 2654435761u + slot); const bool qctx = (i & 7) == 7;
        const int b = hsh & 1, h = (hsh >> 1) & 7, tq = qctx ? (hsh >> 4) % CTXL : (hsh >> 4) % SEQ, mq = qctx ? NLAT + b * CTXL + tq : b * SEQ + tq;
        const int DQ = type == 0 ? 96 : 64;
        for (int d = F.lane; d < DQ; d += 64) qs[d] = type == 0 ? bf2f(QA[(size_t)mq * 768 + h * 96 + d]) : bf2f(QB[(size_t)mq * 512 + h * 64 + d]);
        LDS_WAIT();
        if (type == 0 && !qctx && F.lane < 16) { float x1 = qs[64 + 2 * F.lane], x2 = qs[65 + 2 * F.lane]; rope_ref(x1, x2, F.lane, 8, tq >> 6, tq & 63); qs[64 + 2 * F.lane] = x1; qs[65 + 2 * F.lane] = x2; }
        LDS_WAIT();
        const int nk = qctx ? CTXL : SEQ + CTXL;
        float mx = -3.0e38f, emax = 0.f, rmax = 0.f;
        for (int pass = 0; pass < 5; ++pass) {
            float l = 0.f, o[16];
#pragma unroll
            for (int d = 0; d < 16; ++d) o[d] = 0.f;
            const int dv0 = (pass - 1) * 16;
            for (int j = F.lane; j < nk; j += 64) { const int kr = (qctx || j >= SEQ) ? NLAT + b * CTXL + (qctx ? j : j - SEQ) : b * SEQ + j;
                float sc = 0.f;
                if (type == 0) { const bf16_t* kp = KVA + (size_t)kr * 1024 + h * 128; const bf16_t* rp = KR + (size_t)kr * 32;
                    for (int d = 0; d < 64; ++d) sc += qs[d] * bf2f(kp[d]); for (int d = 0; d < 32; ++d) sc += qs[64 + d] * bf2f(rp[d]); }
                else { const bf16_t* kp = KB + (size_t)kr * 128 + (h >> 2) * 64; for (int d = 0; d < 64; ++d) sc += qs[d] * bf2f(kp[d]); }
                if (pass == 0) mx = fmaxf(mx, sc);
                else { const float pw = exp2f(sc - mx); l += pw; const bf16_t* vp = (type == 0 ? KVA + (size_t)kr * 1024 + h * 128 + 64 : VB + (size_t)kr * 128 + (h >> 2) * 64) + dv0;
#pragma unroll
                    for (int d = 0; d < 16; ++d) o[d] += pw * bf2f(vp[d]); } }
            if (pass == 0) { for (int s2 = 1; s2 < 64; s2 <<= 1) mx = fmaxf(mx, __shfl_xor(mx, s2)); }
            else { l = wave_sum(l);
#pragma unroll
                for (int d = 0; d < 16; ++d) { const float ref = wave_sum(o[d]) / l, got = bf2f(O[(size_t)mq * 1024 + (type == 0 ? 0 : 512) + h * 64 + dv0 + d]); emax = fmaxf(emax, fabsf(got - ref)); rmax = fmaxf(rmax, fabsf(ref)); } }
        }
        worst = fmaxf(worst, emax / (rmax + 1e-9f));
    }
    dbg_max(F, slot, worst);
}
__device__ __forceinline__ void check_na(Frame& F, int slot, int li, bool need_ctx, int ns) {
    const bf16_t* QK = (const bf16_t*)(F.ws + R_QK); const bf16_t* Vt = (const bf16_t*)(F.ws + R_VT); const bf16_t* Vtc = (const bf16_t*)(F.ws + R_VTC); const bf16_t* ON = (const bf16_t*)(F.ws + R_ON);
    const float* rpb = F.in[19] + (size_t)li * 16 * 465;
    LAS float* qs = (LAS float*)(F.lds + F.wave * 512);
    float worst = 0.f;
    for (int i = F.gw; i < ns; i += F.NGW) { const unsigned hsh = hash_u(i * 2654435761u + slot); const bool qctx = need_ctx && (i & 7) == 7;
        const int b = hsh & 1, h = (hsh >> 1) & 15; int tq = qctx ? (hsh >> 5) % CTXL : (hsh >> 5) % SEQ;
        if (!qctx && (i & 7) == 1) tq = ((hsh >> 5) & 7) * 64 + ((hsh >> 9) & 63) + ((hsh >> 20) & 1) * (SEQ - 512);
        const int mq = qctx ? NLAT + b * CTXL + tq : b * SEQ + tq, r = tq >> 6, c = tq & 63;
        if (F.lane < 64) qs[F.lane] = bf2f(QK[(size_t)mq * 2048 + h * 64 + F.lane]);
        LDS_WAIT();
        const int rs = min(max(r - 4, 0), GRIDH - 8), cs = min(max(c - 8, 0), GRIDW - 16);
        const int nk = qctx ? CTXL : 128 + CTXL;
        float mx = -3.0e38f;
        for (int pass = 0; pass < 2; ++pass) {
            float l = 0.f, o[64];
#pragma unroll
            for (int d = 0; d < 64; ++d) o[d] = 0.f;
            for (int j = F.lane; j < nk; j += 64) { const bool nb = !qctx && j < 128;
                const int kr_ = rs + (j >> 4), kc_ = cs + (j & 15);
                const int krow = nb ? b * SEQ + kr_ * 64 + kc_ : NLAT + b * CTXL + (qctx ? j : j - 128);
                const bf16_t* kp = QK + (size_t)krow * 2048 + 1024 + h * 64; float sc = 0.f;
                for (int d = 0; d < 64; ++d) sc += qs[d] * bf2f(kp[d]);
                if (nb) sc += rpb[h * 465 + (kr_ - r + 7) * 31 + (kc_ - c + 15)] * LOG2E;
                if (pass == 0) mx = fmaxf(mx, sc);
                else { const float pw = exp2f(sc - mx); l += pw;
#pragma unroll
                    for (int d = 0; d < 64; ++d) o[d] += pw * (nb ? bf2f(Vt[((size_t)(b * 16 + h) * 64 + d) * SEQ + kr_ * 64 + kc_]) : bf2f(Vtc[((size_t)(b * 16 + h) * 64 + d) * CTXL + (qctx ? j : j - 128)])); } }
            if (pass == 0) { for (int s2 = 1; s2 < 64; s2 <<= 1) mx = fmaxf(mx, __shfl_xor(mx, s2)); }
            else { l = wave_sum(l); float emax = 0.f, rmax = 0.f;
#pragma unroll
                for (int d = 0; d < 64; ++d) { const float ref = wave_sum(o[d]) / l, got = bf2f(ON[(size_t)mq * 1024 + h * 64 + d]); emax = fmaxf(emax, fabsf(got - ref)); rmax = fmaxf(rmax, fabsf(ref)); }
                worst = fmaxf(worst, emax / (rmax + 1e-9f)); } }
    }
    dbg_max(F, slot, worst);
}
#endif

constexpr int PH_PER_LAYER = 12, NPH = 2 + DEPTH * PH_PER_LAYER;
__global__ void __launch_bounds__(NTHREADS, 2) fwd(Args args) {
    extern __shared__ __attribute__((aligned(16))) unsigned char lds_raw[];
    Frame F;
    F.lds = (LAS unsigned char*)lds_raw; F.ws = args.ws; F.ctl = (unsigned*)(args.ws + WS_CTL); F.in = args.in;
    F.tid = threadIdx.x; F.lane = F.tid & 63; F.wave = __builtin_amdgcn_readfirstlane(F.tid >> 6);
    F.G = gridDim.x; { const int bx = blockIdx.x; F.vcu = (F.G % 8 == 0) ? (bx % 8) * (F.G / 8) + bx / 8 : bx; }
    F.gw = F.vcu * NWAVES + F.wave; F.NGW = F.G * NWAVES;
    volatile LAS unsigned* MISC = (volatile LAS unsigned*)(F.lds + MISC_OFF);
    if (F.tid < 16) MISC[F.tid] = 0u;
    __syncthreads();
    const int lo = args.ph_lo, hi = args.ph_hi;
    XcdBarrier bar; bar.bar = F.ctl + CW_BAR; bar.x = 0; bar.st = MISC;
    if (hi - lo > 1) bar = xcd_barrier_post(F.ctl + CW_BAR, MISC);
#define OPAQUE_V(x) asm volatile("" : "+v"(x))
#define OPAQUE_S(x) asm volatile("" : "+s"(x))
#define PHASE_BEGIN() do { GAS unsigned char* _ws = (GAS unsigned char*)args.ws; OPAQUE_S(_ws); F.ws = (unsigned char*)_ws; F.ctl = (unsigned*)(F.ws + WS_CTL); int _t = threadIdx.x; OPAQUE_V(_t); F.tid = _t; F.lane = _t & 63; \
    F.wave = __builtin_amdgcn_readfirstlane(_t >> 6); int _bx = blockIdx.x; OPAQUE_S(_bx); bx = _bx; F.vcu = (F.G % 8 == 0) ? (_bx % 8) * (F.G / 8) + _bx / 8 : _bx; F.gw = F.vcu * NWAVES + F.wave; \
    mod = (const float*)(F.ws + WS_MOD); } while (0)
#define RUN(k) ((k) >= lo && (k) < hi)
#define SEAM(k) do { if ((k) + 1 < hi) xcd_barrier(bar); } while (0)
    LAS unsigned char* ring = F.lds;
    const float* mod; int bx;

    if (RUN(0)) { PHASE_BEGIN(); if (EN_P0) for (int rep_ = 0; rep_ < REP_P0; ++rep_) { p0_prologue(F); __syncthreads(); } SEAM(0); }


#if DBG_CHECK == 2
#define CHECK_E2(l, li)
#define CHECK_PREP(l, li)
#define CHECK_UP(l, li)
#define CHECK_ATT(l, li) { check_attn(F, 32 + (l), 0, 2048); check_attn(F, 36 + (l), 1, 2048); __syncthreads(); }
#define CHECK_OUT(l, li)
#define CHECK_NA(l, li, nc)
#elif DBG_CHECK
#define CHECK_E2(l, li) { check_gemm(F, 16 + (l), (const bf16_t*)(F.ws + WS_H), 1024, F.in[9] + (size_t)(li) * 1024 * 1440, 1024, 1440, (const bf16_t*)(F.ws + R_P), AB_INP, 1.f, MROWS, 4096); }
#define CHECK_PREP(l, li) { check_prep(F, 20 + (l), li, 2048); }
#define CHECK_UP(l, li) { check_gemm(F, 24 + (l), (const bf16_t*)(F.ws + R_CQN), 384, F.in[12] + (size_t)(li) * 384 * 768, 384, 768, (const bf16_t*)(F.ws + R_QA), 768, SC_A, MROWS, 4096); \
                          check_gemm(F, 28 + (l), (const bf16_t*)(F.ws + R_CKVN), 256, F.in[14] + (size_t)(li) * 256 * 1024, 256, 1024, (const bf16_t*)(F.ws + R_KVA), 1024, 1.f, MROWS, 4096); }
#define CHECK_ATT(l, li) { check_attn(F, 32 + (l), 0, 2048); check_attn(F, 36 + (l), 1, 2048); __syncthreads(); }
#define CHECK_OUT(l, li) { if ((l) == 0) check_out0(F, 40, 4096); }
#define CHECK_NA(l, li, nc) { check_na(F, 44 + (l), li, nc, 4096); __syncthreads(); }
#else
#define CHECK_E2(l, li)
#define CHECK_PREP(l, li)
#define CHECK_UP(l, li)
#define CHECK_ATT(l, li)
#define CHECK_OUT(l, li)
#define CHECK_NA(l, li, nc)
#endif
#define LAYER_BODY(LL) { constexpr int l = (LL); \
        const int pb = 1 + l * PH_PER_LAYER, li = l >> 1; \
        if (RUN(pb)) { PHASE_BEGIN(); if (EN_NORM) mix_norm_phase(F, l); SEAM(pb); } \
        if ((l & 1) == 0) { \
            if (RUN(pb + 1)) { PHASE_BEGIN(); \
                pg8::Gemm g{(const bf16_t*)(F.ws + WS_H), (const bf16_t*)(F.ws + WS_WIN) + (size_t)li * AB_INP * 1024, 1024, 1024}; \
                pg8::StaticOrder S; S.init(MROWS / 256, AB_INP / 256, F.G, bx); \
                EpiStore E{(bf16_t*)(F.ws + R_P), AB_INP}; \
                if (EN_GEMM & 1) { pg8::gemm_phase<EpiStore, pg8::StaticOrder, true>(ring, g, S, E, F.tid); if (REP_IN >= 2) pg8::gemm_phase<EpiStore, pg8::StaticOrder, true>(ring, g, S, E, F.tid); if (REP_IN >= 3) pg8::gemm_phase<EpiStore, pg8::StaticOrder, true>(ring, g, S, E, F.tid); } \
                SEAM(pb + 1); CHECK_E2(l, li) \
            } \
            if (RUN(pb + 2)) { PHASE_BEGIN(); if (EN_PREP) for (int rep_ = 0; rep_ < REP_PREP; ++rep_) ab_prep_phase(F, li); SEAM(pb + 2); CHECK_PREP(l, li) } \
            if (RUN(pb + 3)) { PHASE_BEGIN(); \
                { pg8::Gemm g{(const bf16_t*)(F.ws + R_CQN), (const bf16_t*)(F.ws + WS_WQUP) + (size_t)li * 768 * 384, QLORA, QLORA}; \
                  pg8::StaticOrder S; S.init(MROWS / 256, 3, F.G, bx); \
                  EpiStore E{(bf16_t*)(F.ws + R_QA), 768}; \
                  if (EN_GEMM & 2) { pg8::gemm_phase<EpiStore, pg8::StaticOrder, true>(ring, g, S, E, F.tid); if (REP_UP >= 2) pg8::gemm_phase<EpiStore, pg8::StaticOrder, true>(ring, g, S, E, F.tid); } } \
                { pg8::Gemm g{(const bf16_t*)(F.ws + R_CKVN), (const bf16_t*)(F.ws + WS_WKVUP) + (size_t)li * 1024 * 256, KVLORA, KVLORA}; \
                  pg8::StaticOrder S; S.init(MROWS / 256, 4, F.G, (bx + 134) % F.G); \
                  EpiStore E{(bf16_t*)(F.ws + R_KVA), 1024}; \
                  if (EN_GEMM & 4) { pg8::gemm_phase<EpiStore, pg8::StaticOrder, true>(ring, g, S, E, F.tid); if (REP_UP >= 2) pg8::gemm_phase<EpiStore, pg8::StaticOrder, true>(ring, g, S, E, F.tid); } } \
                SEAM(pb + 3); CHECK_UP(l, li) \
            } \
            if (RUN(pb + 4)) { PHASE_BEGIN(); if (EN_ATT) for (int rep_ = 0; rep_ < REP_ATT; ++rep_) { attn_phase(F, li); if (rep_ + 1 < REP_ATT) __syncthreads(); } SEAM(pb + 4); CHECK_ATT(l, li) } \
            if (RUN(pb + 5)) { PHASE_BEGIN(); \
                pg8::Gemm g{(const bf16_t*)(F.ws + R_O), (const bf16_t*)(F.ws + WS_WOUT) + (size_t)li * 1024 * 1024, 1024, 1024}; \
                pg8::StaticOrder S; S.init(MROWS / 256, 4, F.G, bx); \
                EpiOut E{(float*)(F.ws + WS_X), mod + (size_t)l * 3 * 6144, l == 0 ? F.in[0] : (const float*)(F.ws + WS_X), l == 0 ? F.in[2] : (const float*)(F.ws + WS_X) + (size_t)NLAT * 1024}; \
                if (EN_GEMM & 8) pg8::gemm_phase<EpiOut, pg8::StaticOrder, true>(ring, g, S, E, F.tid); \
                SEAM(pb + 5); CHECK_OUT(l, li) \
            } \
        } else { \
            const bool last = (l == DEPTH - 1); \
            if (RUN(pb + 1)) { PHASE_BEGIN(); \
                pg8::Gemm g{(const bf16_t*)(F.ws + WS_H), (const bf16_t*)(F.ws + WS_NIN) + (size_t)li * 3072 * 1024, 1024, 1024}; \
                pg8::StaticOrder S; S.init(MROWS / 256, 12, F.G, bx); \
                EpiNaIn E{(bf16_t*)(F.ws + R_QK), (bf16_t*)(F.ws + R_VT), (bf16_t*)(F.ws + R_VTC)}; \
                if (EN_GEMM & 16) { pg8::gemm_phase<EpiNaIn, pg8::StaticOrder, true>(ring, g, S, E, F.tid); if (REP_IN >= 2) pg8::gemm_phase<EpiNaIn, pg8::StaticOrder, true>(ring, g, S, E, F.tid); if (REP_IN >= 3) pg8::gemm_phase<EpiNaIn, pg8::StaticOrder, true>(ring, g, S, E, F.tid); } \
                SEAM(pb + 1); \
            } \
            if (RUN(pb + 4)) { PHASE_BEGIN(); if (EN_NA) for (int rep_ = 0; rep_ < REP_NA; ++rep_) { na::na_phase(F, li, !last); if (rep_ + 1 < REP_NA) __syncthreads(); } SEAM(pb + 4); CHECK_NA(l, li, !last) } \
            if (RUN(pb + 5)) { PHASE_BEGIN(); \
                pg8::Gemm g{(const bf16_t*)(F.ws + R_ON), (const bf16_t*)(F.ws + WS_NOUT) + (size_t)li * 1024 * 1024, 1024, 1024}; \
                pg8::StaticOrder S; S.init((last ? NLAT : MROWS) / 256, 4, F.G, bx); \
                EpiOut E{(float*)(F.ws + WS_X), mod + (size_t)l * 3 * 6144, (const float*)(F.ws + WS_X), (const float*)(F.ws + WS_X) + (size_t)NLAT * 1024}; \
                if (EN_GEMM & 32) pg8::gemm_phase<EpiOut, pg8::StaticOrder, true>(ring, g, S, E, F.tid); \
                SEAM(pb + 5); \
            } \
        } \
        if (RUN(pb + 6)) { PHASE_BEGIN(); if (EN_ROUTE) ffn_norm_route_phase(F, l); SEAM(pb + 6); } \
                if (RUN(pb + 8)) { PHASE_BEGIN(); \
            moe_tile_map(F, l); \
            if (DBG_SEL == 0 && l == 0 && blockIdx.x == 0 && F.tid == 0) F.ctl[CW_DBG + 0] = __builtin_bit_cast(unsigned, 0.001f * (float)*(const LAS int*)(F.lds + MOE_NT_OFF)); \
            pg8::Gemm g{(const bf16_t*)(F.ws + WS_H), (const bf16_t*)(F.ws + WS_MOEW + (size_t)l * MOEW_LAYER), 1024, 1024}; \
            pg8::MoeGatherOrder S; S.tile_e = (const LAS int*)(F.lds + TILE_E_OFF); S.nT = *(const LAS int*)(F.lds + MOE_NT_OFF); S.G = F.G; S.c = bx; S.estride = (size_t)1024 * 1024; \
            S.lcnt = (const LAS int*)(F.lds + CNTL_OFF); S.lbase = S.lcnt + 32; S.list = (const u32x2*)(F.ws + WS_LIST); \
            EpiMoe1 E{(bf16_t*)(F.ws + R_ACT)}; \
            if (EN_GEMM & 64) { pg8::gemm_phase<EpiMoe1, pg8::MoeGatherOrder, true>(ring, g, S, E, F.tid); if (REP_MOE >= 2) pg8::gemm_phase<EpiMoe1, pg8::MoeGatherOrder, true>(ring, g, S, E, F.tid); if (REP_MOE >= 3) pg8::gemm_phase<EpiMoe1, pg8::MoeGatherOrder, true>(ring, g, S, E, F.tid); } \
            SEAM(pb + 8); if (DBG_SEL == 2 && l == 0) dbg_mean_abs(F, (const bf16_t*)(F.ws + R_ACT), 65536, 512, 512, 2); \
        } \
        if (RUN(pb + 9)) { PHASE_BEGIN(); \
            moe_tile_map(F, l); \
            pg8::Gemm g{(const bf16_t*)(F.ws + R_ACT), (const bf16_t*)(F.ws + WS_MOEW + (size_t)l * MOEW_LAYER + MOEW_DN), 512, 512}; \
            pg8::MoeOrder S{(const LAS int*)(F.lds + TILE_E_OFF), *(const LAS int*)(F.lds + MOE_NT_OFF), F.G, bx, (size_t)1024 * 512}; \
            EpiMoe2 E{(bf16_t*)(F.ws + R_Y), (const LAS int*)(F.lds + TILE_E_OFF), (const LAS int*)(F.lds + CNTL_OFF), (const LAS int*)(F.lds + CNTL_OFF) + 32, (const u32x2*)(F.ws + WS_LIST)}; if (DBG_SEL == 4 && l == 0) dbg_ri(F, 4); if (DBG_SEL == 6 && l == 0) dbg_listw(F, 6); if (DBG_SEL == 5 && l == 0) dbg_mean_abs(F, (const bf16_t*)(F.ws + WS_MOEW + MOEW_DN), 32768, 512, 512, 5); \
            if (EN_GEMM & 128) { pg8::gemm_phase<EpiMoe2, pg8::MoeOrder, true>(ring, g, S, E, F.tid); if (REP_MOE >= 2) pg8::gemm_phase<EpiMoe2, pg8::MoeOrder, true>(ring, g, S, E, F.tid); if (REP_MOE >= 3) pg8::gemm_phase<EpiMoe2, pg8::MoeOrder, true>(ring, g, S, E, F.tid); } \
            SEAM(pb + 9); if (DBG_SEL == 1 && l == 0) dbg_mean_abs(F, (const bf16_t*)(F.ws + R_Y), 65536, 1024, 1024, 1); \
        } \
    }
    LAYER_BODY(0)
    LAYER_BODY(1)
    LAYER_BODY(2)
    LAYER_BODY(3)
#undef LAYER_BODY
    if (RUN(NPH - 1)) { PHASE_BEGIN(); if (EN_FINAL) final_phase(F, args.out); }
#undef RUN
#undef SEAM
}

extern "C" void kernel_launch(void* const* d_in, const int* in_sizes, int n_in, void* d_out, int out_size, void* d_ws, size_t ws_size, hipStream_t stream) {
    static int grid = 0;
    if (grid == 0) {
        if (n_in != 27 || out_size != NLAT * DM || ws_size < WS_END) { fprintf(stderr, "kernel_launch: unexpected shapes: n_in %d out %d ws %zu (need %zu)\n", n_in, out_size, ws_size, (size_t)WS_END); grid = -1; return; }
        int dev = 0, cus = 0, per_cu = 0;
        if (hipGetDevice(&dev) != hipSuccess || hipDeviceGetAttribute(&cus, hipDeviceAttributeMultiprocessorCount, dev) != hipSuccess) { grid = -1; return; }
        if (hipFuncSetAttribute((const void*)fwd, hipFuncAttributeMaxDynamicSharedMemorySize, LDS_BYTES) != hipSuccess) { fprintf(stderr, "kernel_launch: hipFuncSetAttribute failed\n"); grid = -1; return; }
        if (hipOccupancyMaxActiveBlocksPerMultiprocessor(&per_cu, (const void*)fwd, NTHREADS, LDS_BYTES) != hipSuccess || per_cu < 1)
            fprintf(stderr, "kernel_launch: occupancy query reports %d workgroups per CU\n", per_cu);
        (void)hipGetLastError();
        grid = cus;
    }
    if (grid < 0) return;
    if (hipMemsetAsync((char*)d_ws + WS_CTL, 0, CTL_ZERO_BYTES, stream) != hipSuccess) return;
    Args a{};
    for (int i = 0; i < 27; ++i) a.in[i] = (const float*)d_in[i];
    a.out = (float*)d_out; a.ws = (unsigned char*)d_ws;
#if MK_PER_PHASE
    for (int p = 0; p < NPH; ++p) { a.ph_lo = p; a.ph_hi = p + 1; hipLaunchKernelGGL(fwd, dim3(grid), dim3(NTHREADS), LDS_BYTES, stream, a); }
#else
    a.ph_lo = 0; a.ph_hi = NPH;
    hipLaunchKernelGGL(fwd, dim3(grid), dim3(NTHREADS), LDS_BYTES, stream, a);
#endif
    const hipError_t le = hipPeekAtLastError();
    if (le != hipSuccess) fprintf(stderr, "kernel_launch: launch failed: %s\n", hipGetErrorName(le));
}
```

```cpp
#include <hip/hip_runtime.h>
#include <cstdio>
#include <cstdint>

#ifndef MK_PER_PHASE
#define MK_PER_PHASE 0
#endif


#ifndef EN_P0
#define EN_P0 1
#endif
#ifndef EN_NORM
#define EN_NORM 1
#endif
#ifndef EN_PREP
#define EN_PREP 1
#endif
#ifndef EN_ATT
#define EN_ATT 1
#endif
#ifndef EN_NA
#define EN_NA 1
#endif
#ifndef EN_ROUTE
#define EN_ROUTE 1
#endif
#ifndef EN_GATHER
#define EN_GATHER 1
#endif
#ifndef EN_FINAL
#define EN_FINAL 1
#endif
#ifndef EN_GEMM
#define EN_GEMM 255
#endif
#ifndef REP_PREP
#define REP_PREP 1
#endif
#ifndef REP_GATHER
#define REP_GATHER 1
#endif
#ifndef REP_UP
#define REP_UP 1
#endif
#ifndef REP_ATT
#define REP_ATT 1
#endif
#ifndef REP_NA
#define REP_NA 1
#endif
#ifndef REP_P0
#define REP_P0 1
#endif
#ifndef REP_MOE
#define REP_MOE 1
#endif
#ifndef REP_IN
#define REP_IN 1
#endif
#ifndef NOBAR_PROBE
#define NOBAR_PROBE 0
#endif
#ifndef EXP_PROBE
#define EXP_PROBE 0
#endif
#ifndef DBG_SEL
#define DBG_SEL -1
#endif
#ifndef W_CONST
#define W_CONST 0.f
#endif
#ifndef MOE_ALPHA
#define MOE_ALPHA 1.f
#endif
#define GAS __attribute__((address_space(1)))
#define LAS __attribute__((address_space(3)))
typedef unsigned short bf16_t;
typedef short bf16x8 __attribute__((ext_vector_type(8)));
typedef short s16x4 __attribute__((ext_vector_type(4)));
typedef float f32x4 __attribute__((ext_vector_type(4)));
typedef float f32x2 __attribute__((ext_vector_type(2)));
typedef float f32x16 __attribute__((ext_vector_type(16)));
typedef unsigned u32x4 __attribute__((ext_vector_type(4)));
typedef unsigned u32x2 __attribute__((ext_vector_type(2)));

constexpr int DM = 1024, SEQ = 16384, NLAT = 32768, CTXL = 256, NCTX = 512, MROWS = NLAT + NCTX;
constexpr int DEPTH = 4, GRIDW = 64, GRIDH = 256;
constexpr int AB_IN = 1440, AB_INP = 1536, QLORA = 384, KVLORA = 256;
constexpr int NEXP = 32, DEXP = 512;
constexpr float LOG2E = 1.4426950408889634f;
constexpr float SC_A = 0.10206207261596577f * LOG2E;
constexpr float SC_B = 0.125f * LOG2E;
constexpr float RMS_EPS = 1e-6f;
constexpr int NWAVES = 8, NTHREADS = 512;

constexpr size_t MiB = 1u << 20;
constexpr size_t WS_CTL = 0, CTL_ZERO_BYTES = 1 * MiB;
constexpr size_t WS_MOD = 1 * MiB;
constexpr size_t WS_ROPE = WS_MOD + 512 * 1024;
constexpr size_t WS_WIN = 2 * MiB;
constexpr size_t WS_WQUP = 8 * MiB;
constexpr size_t WS_WKVUP = 10 * MiB;
constexpr size_t WS_WOUT = 11 * MiB;
constexpr size_t WS_NIN = 15 * MiB;
constexpr size_t WS_NOUT = 27 * MiB;
constexpr size_t WS_LIST = 31 * MiB;
constexpr size_t WS_X = 41 * MiB;
constexpr size_t WS_H = 171 * MiB;
constexpr size_t WS_R = 236 * MiB;
constexpr size_t R_P = WS_R;
constexpr size_t R_CQN = R_P + 98 * MiB;
constexpr size_t R_CKVN = R_CQN + 25 * MiB;
constexpr size_t R_QA = R_CKVN + 17 * MiB;
constexpr size_t R_KVA = R_QA + 49 * MiB;
constexpr size_t R_KR = R_KVA + 65 * MiB;
constexpr size_t R_QB = R_KR + 3 * MiB;
constexpr size_t R_KB = R_QB + 33 * MiB;
constexpr size_t R_VB = R_KB + 9 * MiB;
constexpr size_t R_O = R_P;
constexpr size_t R_EVEN_END = R_VB + 9 * MiB;
constexpr size_t R_QK = WS_R;
constexpr size_t R_VT = R_QK + 130 * MiB;
constexpr size_t R_VTC = R_VT + 64 * MiB;
constexpr size_t R_ON = R_VTC + 1 * MiB;
constexpr size_t R_ODD_END = R_ON + 65 * MiB;
constexpr int MOE_MAXT = 292;
constexpr size_t R_XB = WS_R;
constexpr size_t R_ACT = R_XB + 146 * MiB;
constexpr size_t R_RI = R_ACT + 73 * MiB;
constexpr size_t R_Y = R_RI + 1 * MiB;
constexpr size_t R_MOE_END = R_Y + 130 * MiB;
constexpr size_t WS_MOEW = 606 * MiB;
constexpr size_t MOEW_LAYER = 96 * MiB, MOEW_DN = 64 * MiB;
constexpr size_t WS_END = WS_MOEW + 4 * MOEW_LAYER;
static_assert(R_EVEN_END <= WS_MOEW && R_ODD_END <= WS_MOEW && R_MOE_END <= WS_MOEW, "overlay region");
static_assert(WS_END <= 1024 * MiB, "workspace");

constexpr int CW_BAR = 4096;
constexpr int CW_DBG = 8192;
constexpr int CW_CNT = 16384;
static_assert((CW_CNT + 4 * 32 * 64) * 4 <= (int)CTL_ZERO_BYTES, "ctl");

constexpr int RING_BYTES = 131072;
constexpr int TAB_LD = 1028;
constexpr int LDS_TAB = 36 * TAB_LD * 4;
constexpr int MISC_OFF = LDS_TAB;
constexpr int TILE_E_OFF = MISC_OFF + 64;
constexpr int MOE_NT_OFF = TILE_E_OFF + 1280;
constexpr int CNTL_OFF = MOE_NT_OFF + 16;
constexpr int REC_OFF = CNTL_OFF + 256;
constexpr int LDS_BYTES = REC_OFF + 3584;
static_assert(LDS_BYTES <= 163840, "LDS");

#define RLX_AGENT __ATOMIC_RELAXED, __HIP_MEMORY_SCOPE_AGENT
#define LDS_WAIT() asm volatile("s_waitcnt lgkmcnt(0)" ::: "memory")
#define VM_WAIT() asm volatile("s_waitcnt vmcnt(0)" ::: "memory")
#define SBAR() __builtin_amdgcn_sched_barrier(0)

__device__ __forceinline__ unsigned cvt_pk_bf16(float lo, float hi) { unsigned r; asm volatile("v_cvt_pk_bf16_f32 %0, %1, %2" : "=v"(r) : "v"(lo), "v"(hi)); return r; }
__device__ __forceinline__ float u2f(unsigned u) { return __builtin_bit_cast(float, u); }
__device__ __forceinline__ float bf16lo(unsigned w) { return __builtin_bit_cast(float, w << 16); }
__device__ __forceinline__ float bf16hi(unsigned w) { return __builtin_bit_cast(float, w & 0xffff0000u); }
__device__ __forceinline__ float wave_sum(float v) {
    v += __builtin_bit_cast(float, __builtin_amdgcn_update_dpp(0, __builtin_bit_cast(int, v), 0xB1, 0xF, 0xF, true));
    v += __builtin_bit_cast(float, __builtin_amdgcn_update_dpp(0, __builtin_bit_cast(int, v), 0x4E, 0xF, 0xF, true));
    v += __builtin_bit_cast(float, __builtin_amdgcn_update_dpp(0, __builtin_bit_cast(int, v), 0x141, 0xF, 0xF, true));
    v += __builtin_bit_cast(float, __builtin_amdgcn_update_dpp(0, __builtin_bit_cast(int, v), 0x140, 0xF, 0xF, true));
    { auto rr = __builtin_amdgcn_permlane16_swap(__float_as_uint(v), __float_as_uint(v), false, false); v = __uint_as_float(rr[0]) + __uint_as_float(rr[1]); }
    { auto rr = __builtin_amdgcn_permlane32_swap(__float_as_uint(v), __float_as_uint(v), false, false); v = __uint_as_float(rr[0]) + __uint_as_float(rr[1]); }
    return v;
}
__device__ __forceinline__ float wave_sum2(float a, float b) {
    float v; { auto rr = __builtin_amdgcn_permlane32_swap(__float_as_uint(a), __float_as_uint(b), false, false); v = __uint_as_float(rr[0]) + __uint_as_float(rr[1]); }
    v += __builtin_bit_cast(float, __builtin_amdgcn_update_dpp(0, __builtin_bit_cast(int, v), 0xB1, 0xF, 0xF, true));
    v += __builtin_bit_cast(float, __builtin_amdgcn_update_dpp(0, __builtin_bit_cast(int, v), 0x4E, 0xF, 0xF, true));
    v += __builtin_bit_cast(float, __builtin_amdgcn_update_dpp(0, __builtin_bit_cast(int, v), 0x141, 0xF, 0xF, true));
    v += __builtin_bit_cast(float, __builtin_amdgcn_update_dpp(0, __builtin_bit_cast(int, v), 0x140, 0xF, 0xF, true));
    { auto rr = __builtin_amdgcn_permlane16_swap(__float_as_uint(v), __float_as_uint(v), false, false); v = __uint_as_float(rr[0]) + __uint_as_float(rr[1]); }
    return v;
}
__device__ __forceinline__ int row_class(int m) { return m < SEQ ? 0 : (m < NLAT ? 1 : 2); }

namespace pg8 {
constexpr int BM = 256, BK = 64, HALF = 128, HTB = HALF * BK * 2, STAGE_BYTES = 8 * HTB, NXCD = 8, WGM = 8;
__host__ __device__ __forceinline__ int lds_byte(int r, int c) { const int st = (r >> 4) * 2 + (c >> 5), rr = r & 15, cc = c & 31, ob = rr * 64 + cc * 2; return st * 1024 + (ob ^ (((ob >> 9) & 1) << 5)); }
__host__ __device__ __forceinline__ void stage_rc(int b, int& R, int& C) { const int st = b / 1024, sb = b % 1024, swz = sb ^ (((sb >> 9) & 1) << 5); R = (st >> 1) * 16 + swz / 64; C = (st & 1) * 32 + (swz % 64) / 2; }
__host__ __device__ __forceinline__ int perm32(int rho) { const int n = rho >> 4, i = rho & 15; return 8 * (i >> 2) + 4 * n + (i & 3); }

struct Unit { int pm, pn; };
struct Gemm { const bf16_t* A; const bf16_t* Bt; int lda, K; };

struct StaticOrder {
    static constexpr bool GATHER = false;
    int nM, nN, nwg, G, c;
    __device__ void init(int nM_, int nN_, int G_, int c_) { nM = nM_; nN = nN_; nwg = nM * nN; G = G_; c = c_; }
    __device__ bool next(int i, Unit& u) const {
        const long L = (long)i * G + c; if (L >= nwg) return false;
        int wgid = (int)L; { const int q = nwg / NXCD, r = nwg % NXCD, xcd = wgid % NXCD, off = wgid / NXCD; wgid = (xcd < r ? xcd * (q + 1) : r * (q + 1) + (xcd - r) * q) + off; }
        const int nig = WGM * nN, gid = wgid / nig, fm = gid * WGM, gsz = (nM - fm) < WGM ? (nM - fm) : WGM;
        u.pm = fm + ((wgid % nig) % gsz); u.pn = (wgid % nig) / gsz; return true;
    }
    __device__ __forceinline__ size_t boff(const Unit&) const { return 0; }
};
struct MoeOrder {
    static constexpr bool GATHER = false;
    const LAS int* tile_e; int nT, G, c; size_t estride;
    __device__ bool next(int i, Unit& u) const { const int L = i * G + c; u.pm = L >> 2; u.pn = L & 3; return u.pm < nT; }
    __device__ __forceinline__ size_t boff(const Unit& u) const { return (size_t)tile_e[u.pm] * estride; }
};
struct MoeGatherOrder : MoeOrder {
    static constexpr bool GATHER = true;
    const LAS int* lcnt; const LAS int* lbase; const u32x2* list;
    __device__ __forceinline__ unsigned rowoff(int r, int C, int lda) const { const int e = tile_e[r >> 8], j = r - lbase[e];
        unsigned tok = 0u; if (j < lcnt[e]) tok = list[(size_t)e * MROWS + j].x >> 1; return (tok * (unsigned)lda + (unsigned)C) * 2u; }
};

template <class Epi, class Sched, bool ALIGN_EPI = false>
__device__ __forceinline__ void gemm_phase(LAS unsigned char* lds, const Gemm g, const Sched& S, const Epi& E, const int tid) {
    const int wid = __builtin_amdgcn_readfirstlane(tid >> 6), lane = tid & 63, wr = wid >> 2, wc = wid & 3, fr = lane & 15, fq = lane >> 4;
    const int K = g.K, nt = K / BK;
    constexpr bool GA = Sched::GATHER;
    unsigned voffA[2], voffB[2]; int sR[2], sC[2];
#pragma unroll
    for (int i = 0; i < 2; ++i) { int R, C; stage_rc(tid * 16 + i * 8192, R, C); const int Rb = (R & ~31) + perm32(R & 31); sR[i] = R; sC[i] = C;
        voffA[i] = (unsigned)(R * g.lda + C) * 2u; voffB[i] = (unsigned)(Rb * K + C) * 2u; }
    unsigned ra[2][2], rn[2][2];
    const size_t kstep = (size_t)(BK * 2);
    const size_t hstepA = (size_t)HALF * g.lda * 2, hstepB = (size_t)HALF * K * 2;
    const size_t tstepA = 2 * hstepA, tstepB = 2 * hstepB;
    const unsigned ldsw = (unsigned)wid * 1024u;
    const int aoff = lds_byte(wr * 64 + fr, fq * 8), boff = lds_byte(wc * 32 + fr, fq * 8);
#define PG8_SA(b, h) (((b) * 2 + (h)) * HTB)
#define PG8_SB(b, h) ((4 + (b) * 2 + (h)) * HTB)
#define PG8_STAGE(bufoff, gbase, voff) do { _Pragma("unroll") for (int _i = 0; _i < 2; ++_i) \
        __builtin_amdgcn_global_load_lds((const unsigned*)((const char*)(gbase) + (voff)[_i]), (LAS unsigned*)(lds + (bufoff) + ldsw + _i * 8192), 16, 0, 0); } while (0)
#define PG8_ROWS(dst, u) do { if constexpr (GA) { _Pragma("unroll") for (int _h = 0; _h < 2; ++_h) _Pragma("unroll") for (int _i = 0; _i < 2; ++_i) dst[_h][_i] = S.rowoff((u).pm * 256 + _h * 128 + sR[_i], sC[_i], g.lda); } } while (0)
#define PG8_STAGE_A(bufoff, gbase, R, h) do { if constexpr (GA) { _Pragma("unroll") for (int _i = 0; _i < 2; ++_i) \
        __builtin_amdgcn_global_load_lds((const unsigned*)((const char*)(gbase) + (R)[h][_i]), (LAS unsigned*)(lds + (bufoff) + ldsw + _i * 8192), 16, 0, 0); } \
        else PG8_STAGE(bufoff, (gbase) + (h) * hstepA, voffA); } while (0)
#define PG8_LDA(dst, b, h) do { _Pragma("unroll") for (int m = 0; m < 4; ++m) _Pragma("unroll") for (int k = 0; k < 2; ++k) dst[m][k] = *(const LAS bf16x8*)(lds + PG8_SA(b, h) + aoff + m * 2048 + k * 1024); } while (0)
#define PG8_LDB(dst, b, h) do { _Pragma("unroll") for (int n = 0; n < 2; ++n) _Pragma("unroll") for (int k = 0; k < 2; ++k) dst[n][k] = *(const LAS bf16x8*)(lds + PG8_SB(b, h) + boff + n * 2048 + k * 1024); } while (0)
#define PG8_MMA(ai, bj, At, Bt) do { __builtin_amdgcn_s_setprio(1); _Pragma("unroll") for (int m = 0; m < 4; ++m) _Pragma("unroll") for (int n = 0; n < 2; ++n) _Pragma("unroll") for (int k = 0; k < 2; ++k) \
        acc[ai][bj][m][n] = __builtin_amdgcn_mfma_f32_16x16x32_bf16(Bt[n][k], At[m][k], acc[ai][bj][m][n], 0, 0, 0); __builtin_amdgcn_s_setprio(0); } while (0)
#define PG8_WAIT_V(n) asm volatile("s_waitcnt vmcnt(" #n ")" ::: "memory")
#define PG8_WAIT_L(n) asm volatile("s_waitcnt lgkmcnt(" #n ")" ::: "memory")
#define PG8_BAR __builtin_amdgcn_s_barrier()
#define PG8_SCHED __builtin_amdgcn_sched_barrier(0)
    Unit cur, nxt; int ui = 0;
    if (!S.next(0, cur)) return;
    f32x4 acc[2][2][4][2];
#pragma unroll
    for (int a = 0; a < 2; ++a)
#pragma unroll
        for (int b = 0; b < 2; ++b)
#pragma unroll
            for (int m = 0; m < 4; ++m)
#pragma unroll
                for (int n = 0; n < 2; ++n) acc[a][b][m][n] = (f32x4){0.f, 0.f, 0.f, 0.f};
    bf16x8 At[4][2], B0[2][2], B1[2][2];
    const char* cA = (const char*)g.A + (GA ? (size_t)0 : (size_t)cur.pm * tstepA); const char* cB = (const char*)g.Bt + S.boff(cur) * 2 + (size_t)cur.pn * tstepB;
    PG8_ROWS(ra, cur);
    PG8_STAGE(PG8_SB(0, 0), cB, voffB); PG8_STAGE(PG8_SB(0, 1), cB + hstepB, voffB); PG8_STAGE_A(PG8_SA(0, 0), cA, ra, 0); PG8_STAGE_A(PG8_SA(0, 1), cA, ra, 1);
    if (wr == 1) PG8_BAR;
    PG8_WAIT_V(2); PG8_BAR;
    PG8_STAGE(PG8_SB(1, 0), cB + kstep, voffB); PG8_STAGE_A(PG8_SA(1, 0), cA + kstep, ra, 0); PG8_STAGE(PG8_SB(1, 1), cB + hstepB + kstep, voffB);
    PG8_WAIT_V(6); PG8_BAR;
    for (;;) {
        const bool has_next = S.next(ui + 1, nxt);
        if constexpr (GA) { if (has_next) PG8_ROWS(rn, nxt); else { _Pragma("unroll") for (int _h = 0; _h < 2; ++_h) _Pragma("unroll") for (int _i = 0; _i < 2; ++_i) rn[_h][_i] = ra[_h][_i]; } }
        const char* nA = (has_next && !GA) ? (const char*)g.A + (size_t)nxt.pm * tstepA : cA; const char* nB = has_next ? (const char*)g.Bt + S.boff(nxt) * 2 + (size_t)nxt.pn * tstepB : cB;
        for (int t = 0; t < nt; t += 2) {
            const bool last = (t == nt - 2);
            const char* a1 = cA + (size_t)(t + 1) * kstep;
            const char* a2 = last ? nA : cA + (size_t)(t + 2) * kstep; const char* b2 = last ? nB : cB + (size_t)(t + 2) * kstep;
            const char* a3 = a2 + kstep; const char* b3 = b2 + kstep;
            unsigned rs[2][2];
            if constexpr (GA) { _Pragma("unroll") for (int _h = 0; _h < 2; ++_h) _Pragma("unroll") for (int _i = 0; _i < 2; ++_i) rs[_h][_i] = last ? rn[_h][_i] : ra[_h][_i]; }
            PG8_LDB(B0, 0, 0); PG8_LDB(B1, 0, 1); PG8_SCHED; PG8_LDA(At, 0, 0); PG8_STAGE_A(PG8_SA(1, 1), a1, ra, 1);
            PG8_WAIT_V(8); PG8_WAIT_L(0); PG8_BAR; PG8_MMA(0, 0, At, B0); PG8_MMA(0, 1, At, B1); PG8_BAR; PG8_SCHED;
            PG8_LDA(At, 0, 1); PG8_STAGE(PG8_SB(0, 0), b2, voffB); PG8_STAGE(PG8_SB(0, 1), b2 + hstepB, voffB); PG8_STAGE_A(PG8_SA(0, 0), a2, rs, 0);
            PG8_WAIT_V(8); PG8_WAIT_L(0); PG8_BAR; PG8_MMA(1, 0, At, B0); PG8_MMA(1, 1, At, B1); PG8_BAR; PG8_SCHED;
            PG8_LDB(B0, 1, 0); PG8_LDB(B1, 1, 1); PG8_SCHED; PG8_LDA(At, 1, 0); PG8_STAGE_A(PG8_SA(0, 1), a2, rs, 1);
            PG8_WAIT_V(8); PG8_WAIT_L(0); PG8_BAR; PG8_MMA(0, 0, At, B0); PG8_MMA(0, 1, At, B1); PG8_BAR; PG8_SCHED;
            PG8_LDA(At, 1, 1); PG8_STAGE(PG8_SB(1, 0), b3, voffB); PG8_STAGE(PG8_SB(1, 1), b3 + hstepB, voffB); PG8_STAGE_A(PG8_SA(1, 0), a3, rs, 0);
            PG8_WAIT_V(8); PG8_WAIT_L(0); PG8_BAR; PG8_MMA(1, 0, At, B0); PG8_MMA(1, 1, At, B1); PG8_BAR; PG8_SCHED;
        }
        if constexpr (ALIGN_EPI) { if (wr == 0) PG8_BAR; }
        E(acc, cur, wr, wc, fr, fq);
        if (!has_next) break;
#pragma unroll
        for (int a = 0; a < 2; ++a)
#pragma unroll
            for (int b = 0; b < 2; ++b)
#pragma unroll
                for (int m = 0; m < 4; ++m)
#pragma unroll
                    for (int n = 0; n < 2; ++n) acc[a][b][m][n] = (f32x4){0.f, 0.f, 0.f, 0.f};
        cur = nxt; cA = nA; cB = nB; ++ui;
        if constexpr (GA) { _Pragma("unroll") for (int _h = 0; _h < 2; ++_h) _Pragma("unroll") for (int _i = 0; _i < 2; ++_i) ra[_h][_i] = rn[_h][_i]; }
        if constexpr (ALIGN_EPI) { if (wr == 1) PG8_BAR; }
    }
    PG8_WAIT_V(0);
    if constexpr (!ALIGN_EPI) { if (wr == 0) PG8_BAR; }
    PG8_BAR;
#undef PG8_SA
#undef PG8_SB
#undef PG8_STAGE
#undef PG8_LDA
#undef PG8_ROWS
#undef PG8_STAGE_A
#undef PG8_LDB
#undef PG8_MMA
#undef PG8_WAIT_V
#undef PG8_WAIT_L
#undef PG8_BAR
#undef PG8_SCHED
}
}

#define XB_TMO      128
#define XB_XCNT(j)  (256  + 64 * (j))
#define XB_XSUB(j)  (1280 + 64 * (j))
#define XB_XGEN(j)  (2304 + 64 * (j))
#define XB_TOP      3328
#define XB_TOPGEN   3392
#define XCD_BAR_WORDS 3456
#define XB_SPIN_CAP (1u << 18)

__device__ __forceinline__ unsigned xb_ld(unsigned* p)              { return __hip_atomic_load(p, __ATOMIC_RELAXED, __HIP_MEMORY_SCOPE_AGENT); }
__device__ __forceinline__ unsigned xb_add(unsigned* p, unsigned v) { return __hip_atomic_fetch_add(p, v, __ATOMIC_RELAXED, __HIP_MEMORY_SCOPE_AGENT); }
__device__ __forceinline__ unsigned xb_xcc_id() { return (unsigned)__builtin_amdgcn_s_getreg((3 << 11) | 20) & 0xFu; }
#define XB_SPIN(cond, bar) do { unsigned _sp = 0; while (cond) { __builtin_amdgcn_s_sleep(1); \
    if ((++_sp & 255u) == 0u) { if (xb_ld(&(bar)[XB_TMO])) break; if (_sp > XB_SPIN_CAP) { atomicAdd(&(bar)[XB_TMO], 1u); break; } } } } while (0)

struct XcdBarrier {
    unsigned* bar; unsigned x;
    volatile LAS unsigned* st;
};
__device__ __forceinline__ XcdBarrier xcd_barrier_post(unsigned* bar, volatile LAS unsigned* st) {
    XcdBarrier b; b.bar = bar; b.x = xb_xcc_id(); b.st = st;
    if (threadIdx.x == 0) (void)xb_add(&bar[XB_XCNT(b.x)], 1u);
    return b;
}
__device__ __forceinline__ void xcd_barrier_complete(unsigned* bar, unsigned x, unsigned& nloc, unsigned& nx) {
    const unsigned G = gridDim.x * gridDim.y * gridDim.z;
    unsigned sum, cnt, mine, sp = 0u;
    for (;;) {
        sum = 0u; cnt = 0u; mine = 0u;
#pragma unroll
        for (unsigned j = 0; j < 16; ++j) { const unsigned c = xb_ld(&bar[XB_XCNT(j)]); sum += c; cnt += (c > 0u) ? 1u : 0u; mine = (j == x) ? c : mine; }
        if (sum == G) break;
        __builtin_amdgcn_s_sleep(1);
        if ((++sp & 255u) == 0u) { if (xb_ld(&bar[XB_TMO])) break; if (sp > XB_SPIN_CAP) { atomicAdd(&bar[XB_TMO], 1u); break; } }
    }
    nloc = mine > 0u ? mine : 1u; nx = cnt > 0u ? cnt : 1u;
}
__device__ __forceinline__ void xcd_barrier(const XcdBarrier& b) {
    asm volatile("s_waitcnt vmcnt(0)" ::: "memory");
    __syncthreads();
    if (threadIdx.x == 0) {
        unsigned* bar = b.bar;
        __builtin_amdgcn_s_waitcnt(0);
        unsigned nloc = b.st[0], nx = b.st[1];
        if (nloc == 0u) { xcd_barrier_complete(bar, b.x, nloc, nx); b.st[0] = nloc; b.st[1] = nx; }
        const unsigned old = xb_add(&bar[XB_XSUB(b.x)], 1u);
        const unsigned gen = old / nloc;
        if (old + 1u == (gen + 1u) * nloc) {
            __builtin_amdgcn_fence(__ATOMIC_RELEASE, "agent");
            asm volatile("s_waitcnt vmcnt(0)" ::: "memory");
            const unsigned og = xb_add(&bar[XB_TOP], 1u);
            const unsigned tg = og / nx;
            if (og + 1u == (tg + 1u) * nx) xb_add(&bar[XB_TOPGEN], 1u);
            else XB_SPIN(xb_ld(&bar[XB_TOPGEN]) == tg, bar);
            __builtin_amdgcn_fence(__ATOMIC_ACQUIRE, "agent");
            xb_add(&bar[XB_XGEN(b.x)], 1u);
            asm volatile("s_waitcnt vmcnt(0)" ::: "memory");
        } else {
            XB_SPIN(xb_ld(&bar[XB_XGEN(b.x)]) == gen, bar);
            __builtin_amdgcn_fence(__ATOMIC_ACQUIRE, "agent");
            asm volatile("s_waitcnt vmcnt(0)" ::: "memory");
        }
    }
    __syncthreads();
}

struct Args { const float* in[27]; float* out; unsigned char* ws; int ph_lo, ph_hi; };
struct Frame {
    LAS unsigned char* lds;
    unsigned char* ws;
    unsigned* ctl;
    const float* const* in;
    int tid, lane, wave, vcu, G, gw, NGW;
};

__device__ __forceinline__ void p0_transpose_item(const float* W, int K, int N, bf16_t* WT, int mode, LAS unsigned* scr, int item, int lane, float scale = 1.f) {
    const int nblk = (N + 63) / 64, kb = item / nblk, nb = item % nblk, k0 = 64 * kb, n0 = 64 * nb;
    const int drow0 = mode == 0 ? n0 : ((n0 >> 7) * 256 + (n0 & 127) + (mode == 2 ? 128 : 0));
    const int r = lane >> 4, n4 = lane & 15; const bool okc = n0 + 4 * n4 < N;
    f32x4 la[8], lb[8];
#pragma unroll
    for (int st = 0; st < 8; ++st) { const float* p = W + (size_t)(k0 + st * 8 + 2 * r) * N + n0 + 4 * n4;
        la[st] = okc ? __builtin_nontemporal_load((const f32x4*)p) : (f32x4){0.f, 0.f, 0.f, 0.f}; lb[st] = okc ? __builtin_nontemporal_load((const f32x4*)(p + N)) : (f32x4){0.f, 0.f, 0.f, 0.f}; }
#pragma unroll
    for (int st = 0; st < 8; ++st)
#pragma unroll
        for (int q = 0; q < 4; ++q) scr[(4 * n4 + q) * 33 + st * 4 + r] = cvt_pk_bf16(la[st][q] * scale, lb[st][q] * scale);
    LDS_WAIT(); asm volatile("" ::: "memory");
    const int c = lane & 7;
#pragma unroll
    for (int st = 0; st < 8; ++st) { const int n = st * 8 + (lane >> 3); const LAS unsigned* sp = scr + n * 33 + 4 * c;
        const u32x4 o = {sp[0], sp[1], sp[2], sp[3]};
        if (n0 + n < N) *(u32x4*)(WT + (size_t)(drow0 + n) * K + k0 + 8 * c) = o; }
    LDS_WAIT(); asm volatile("" ::: "memory");
}
__device__ __forceinline__ float silu_f(float x) { return x / (1.f + __expf(-x)); }

__device__ __forceinline__ void p0_prologue(Frame& F) {
    {
        LAS float* sv = (LAS float*)F.lds;
        LAS float* red = (LAS float*)(F.lds + 12288);
        const float* c = F.in[1]; const float* cc = F.in[3];
        for (int i = F.tid; i < 3072; i += NTHREADS) { const float x = i < 2048 ? c[i] : cc[i - 2048]; sv[i] = silu_f(x); }
        __syncthreads();
        const float* wada = F.in[4]; const float* bada = F.in[5]; float* mod = (float*)(F.ws + WS_MOD);
        for (int it = F.vcu; it < 4 * 96; it += F.G) {
            const int l = it / 96, n = (it % 96) * 64 + F.lane;
            const float* wp = wada + ((size_t)l * 1024 + F.wave * 128) * 6144 + n;
            float a0 = 0.f, a1 = 0.f, a2 = 0.f;
#pragma unroll 16
            for (int k = 0; k < 128; ++k) { const float w = wp[(size_t)k * 6144]; const int kk = F.wave * 128 + k; a0 += sv[kk] * w; a1 += sv[1024 + kk] * w; a2 += sv[2048 + kk] * w; }
            red[(F.wave * 3 + 0) * 64 + F.lane] = a0; red[(F.wave * 3 + 1) * 64 + F.lane] = a1; red[(F.wave * 3 + 2) * 64 + F.lane] = a2;
            __syncthreads();
            if (F.wave < 3) { float s = bada[l * 6144 + n];
#pragma unroll
                for (int w = 0; w < 8; ++w) s += red[(w * 3 + F.wave) * 64 + F.lane];
                mod[(size_t)(l * 3 + F.wave) * 6144 + n] = s; }
            __syncthreads();
        }
    }
    {
        f32x2* rope = (f32x2*)(F.ws + WS_ROPE);
        for (int e = F.vcu * NTHREADS + F.tid; e < 7680; e += F.G * NTHREADS) {
            int pos, i, n;
            if (e < 2048) { pos = e >> 3; i = e & 7; n = 8; } else if (e < 2560) { pos = (e - 2048) >> 3; i = e & 7; n = 8; }
            else if (e < 6656) { pos = (e - 2560) >> 4; i = (e - 2560) & 15; n = 16; } else { pos = (e - 6656) >> 4; i = (e - 6656) & 15; n = 16; }
            const float inv = powf(10000.f, -(float)i / (float)n);
            const float ang = (float)pos * inv; float s, co; sincosf(ang, &s, &co);
            rope[e] = (f32x2){co, s};
        }
    }
    {
        bf16_t* winT = (bf16_t*)(F.ws + WS_WIN);
        for (int e = F.vcu * NTHREADS + F.tid; e < 2 * 96 * 128; e += F.G * NTHREADS) { const int i = e / (96 * 128), r = (e / 128) % 96, c8 = e % 128;
            *(u32x4*)(winT + ((size_t)i * AB_INP + AB_IN + r) * 1024 + c8 * 8) = (u32x4){0u, 0u, 0u, 0u}; }
    }
    {
        LAS unsigned* scr = (LAS unsigned*)(F.lds + F.wave * 16384);
        constexpr int I_WIN = 16 * 23, I_QUP = 6 * 12, I_KVUP = 4 * 16, I_OUT = 16 * 16, I_NIN = 16 * 48, I_NOUT = 16 * 16;
        constexpr int I_SMALL = I_WIN + I_QUP + I_KVUP + I_OUT + I_NIN + I_NOUT;
        constexpr int NITEMS = 2 * I_SMALL + 128 * 384;
        for (int it = F.gw; it < NITEMS; it += F.NGW) {
            if (it < 2 * I_SMALL) {
                const int i = it / I_SMALL; int r = it % I_SMALL;
                if (r < I_WIN) { p0_transpose_item(F.in[9] + (size_t)i * 1024 * 1440, 1024, 1440, (bf16_t*)(F.ws + WS_WIN) + (size_t)i * AB_INP * 1024, 0, scr, r, F.lane); continue; } r -= I_WIN;
                if (r < I_QUP) { p0_transpose_item(F.in[12] + (size_t)i * 384 * 768, 384, 768, (bf16_t*)(F.ws + WS_WQUP) + (size_t)i * 768 * 384, 0, scr, r, F.lane, SC_A); continue; } r -= I_QUP;
                if (r < I_KVUP) { p0_transpose_item(F.in[14] + (size_t)i * 256 * 1024, 256, 1024, (bf16_t*)(F.ws + WS_WKVUP) + (size_t)i * 1024 * 256, 0, scr, r, F.lane); continue; } r -= I_KVUP;
                if (r < I_OUT) { p0_transpose_item(F.in[10] + (size_t)i * 1024 * 1024, 1024, 1024, (bf16_t*)(F.ws + WS_WOUT) + (size_t)i * 1024 * 1024, 0, scr, r, F.lane); continue; } r -= I_OUT;
                if (r < I_NIN) { p0_transpose_item(F.in[17] + (size_t)i * 1024 * 3072, 1024, 3072, (bf16_t*)(F.ws + WS_NIN) + (size_t)i * 3072 * 1024, 0, scr, r, F.lane); continue; } r -= I_NIN;
                p0_transpose_item(F.in[18] + (size_t)i * 1024 * 1024, 1024, 1024, (bf16_t*)(F.ws + WS_NOUT) + (size_t)i * 1024 * 1024, 0, scr, r, F.lane);
            } else {
                const int r = it - 2 * I_SMALL, le = r / 384, q = r % 384, kind = q >> 7, sub = q & 127, l = le >> 5, e = le & 31;
                bf16_t* gu = (bf16_t*)(F.ws + WS_MOEW + (size_t)l * MOEW_LAYER) + (size_t)e * 1024 * 1024;
                bf16_t* dn = (bf16_t*)(F.ws + WS_MOEW + (size_t)l * MOEW_LAYER + MOEW_DN) + (size_t)e * 1024 * 512;
                if (kind == 0) p0_transpose_item(F.in[24] + (size_t)le * 1024 * 512, 1024, 512, gu, 1, scr, sub, F.lane);
                else if (kind == 1) p0_transpose_item(F.in[25] + (size_t)le * 1024 * 512, 1024, 512, gu, 2, scr, sub, F.lane);
                else p0_transpose_item(F.in[26] + (size_t)le * 512 * 1024, 512, 1024, dn, 0, scr, sub, F.lane);
            }
        }
    }
}

__device__ __forceinline__ void store_bf16_row(bf16_t* orow, int lane, const f32x4 (&h)[4]) {
#pragma unroll
    for (int j = 0; j < 4; ++j) { u32x2 w; w.x = cvt_pk_bf16(h[j].x, h[j].y); w.y = cvt_pk_bf16(h[j].z, h[j].w); *(u32x2*)(orow + 256 * j + 4 * lane) = w; }
}
__device__ __forceinline__ void combine_row(f32x4 (&x)[4], const bf16_t* y0, const float* g2, int lane) {
#pragma unroll
    for (int j = 0; j < 4; ++j) {
        const u32x2 a = *(const u32x2*)(y0 + 256 * j + 4 * lane), b = *(const u32x2*)(y0 + 1024 + 256 * j + 4 * lane);
        const f32x4 g = *(const f32x4*)(g2 + 256 * j + 4 * lane) * MOE_ALPHA;
        x[j].x += g.x * (bf16lo(a.x) + bf16lo(b.x)); x[j].y += g.y * (bf16hi(a.x) + bf16hi(b.x));
        x[j].z += g.z * (bf16lo(a.y) + bf16lo(b.y)); x[j].w += g.w * (bf16hi(a.y) + bf16hi(b.y));
    }
}
__device__ __forceinline__ float row_rs(const f32x4 (&x)[4]) {
    float s = 0.f;
#pragma unroll
    for (int j = 0; j < 4; ++j) s += (x[j].x * x[j].x + x[j].y * x[j].y) + (x[j].z * x[j].z + x[j].w * x[j].w);
    return rsqrtf(wave_sum(s) * (1.f / 1024.f) + RMS_EPS);
}
__device__ __forceinline__ void modulate_row(const f32x4 (&x)[4], f32x4 (&h)[4], float rs, const float* gain, const float* sh, const float* sc, int lane) {
#pragma unroll
    for (int j = 0; j < 4; ++j) {
        const f32x4 g = *(const f32x4*)(gain + 256 * j + 4 * lane), s1 = *(const f32x4*)(sc + 256 * j + 4 * lane), s0 = *(const f32x4*)(sh + 256 * j + 4 * lane);
        h[j] = (x[j] * rs) * g * (s1 + 1.f) + s0;
    }
}

struct RowVec { f32x4 a[4], b[4], g[4]; };
__device__ __forceinline__ void load_rowvec(RowVec& V, const float* gain, const float* sh, const float* sc, const float* g2, int lane) {
#pragma unroll
    for (int j = 0; j < 4; ++j) { const int c = 256 * j + 4 * lane;
        const f32x4 g = *(const f32x4*)(gain + c), s1 = *(const f32x4*)(sc + c); V.a[j] = g * (s1 + 1.f); V.b[j] = *(const f32x4*)(sh + c);
        V.g[j] = g2 ? *(const f32x4*)(g2 + c) * MOE_ALPHA : (f32x4){0.f, 0.f, 0.f, 0.f}; }
}
struct RowRaw { f32x4 x[4]; u32x2 xb[4], y0[4], y1[4]; };
__device__ __forceinline__ void load_rowraw(RowRaw& R, const float* xrow, const bf16_t* yrow, int lane) {
#pragma unroll
    for (int j = 0; j < 4; ++j) R.x[j] = *(const f32x4*)(xrow + 256 * j + 4 * lane);
    if (yrow) {
#pragma unroll
        for (int j = 0; j < 4; ++j) { R.y0[j] = *(const u32x2*)(yrow + 256 * j + 4 * lane); R.y1[j] = *(const u32x2*)(yrow + 1024 + 256 * j + 4 * lane); } }
}
__device__ __forceinline__ void load_rowraw_b(RowRaw& R, const bf16_t* xrow, const bf16_t* yrow, int lane) {
#pragma unroll
    for (int j = 0; j < 4; ++j) R.xb[j] = *(const u32x2*)(xrow + 256 * j + 4 * lane);
    if (yrow) {
#pragma unroll
        for (int j = 0; j < 4; ++j) { R.y0[j] = *(const u32x2*)(yrow + 256 * j + 4 * lane); R.y1[j] = *(const u32x2*)(yrow + 1024 + 256 * j + 4 * lane); } }
}
__device__ __forceinline__ void unpack_x(RowRaw& R) {
#pragma unroll
    for (int j = 0; j < 4; ++j) { const u32x2 t = R.xb[j]; R.x[j] = (f32x4){bf16lo(t.x), bf16hi(t.x), bf16lo(t.y), bf16hi(t.y)}; }
}
__device__ __forceinline__ void combine_raw(RowRaw& R, const RowVec& V) {
#pragma unroll
    for (int j = 0; j < 4; ++j) { const u32x2 a = R.y0[j], b = R.y1[j];
        R.x[j].x += V.g[j].x * (bf16lo(a.x) + bf16lo(b.x)); R.x[j].y += V.g[j].y * (bf16hi(a.x) + bf16hi(b.x));
        R.x[j].z += V.g[j].z * (bf16lo(a.y) + bf16lo(b.y)); R.x[j].w += V.g[j].w * (bf16hi(a.y) + bf16hi(b.y)); }
}
__device__ __forceinline__ int chunk_lo(int gw, int M, int NGW) { return (int)(((long)gw * M) / NGW); }

__device__ __forceinline__ void mix_norm_phase(Frame& F, int l) {
    bf16_t* X = (bf16_t*)(F.ws + WS_X); bf16_t* H = (bf16_t*)(F.ws + WS_H);
    const float* mod = (const float*)(F.ws + WS_MOD); const bf16_t* Y = (const bf16_t*)(F.ws + R_Y);
    const float* gain = F.in[6] + l * 1024;
    const int r0 = chunk_lo(F.gw, MROWS, F.NGW), r1 = chunk_lo(F.gw + 1, MROWS, F.NGW);
    RowVec V; RowRaw cur, nxt; int vcur = -1;
#define SRC(m) ((m) < NLAT ? F.in[0] + (size_t)(m) * 1024 : F.in[2] + (size_t)((m) - NLAT) * 1024)
#define LOADROW(R, m) do { if (l == 0) load_rowraw(R, SRC(m), nullptr, F.lane); else load_rowraw_b(R, X + (size_t)(m) * 1024, Y + (size_t)(m) * 2048, F.lane); } while (0)
    if (r0 < r1) LOADROW(nxt, r0);
    for (int m = r0; m < r1; ++m) {
        cur = nxt;
        if (m + 1 < r1) LOADROW(nxt, m + 1);
        const int v = row_class(m);
        if (v != vcur) { vcur = v; const float* mv = mod + (size_t)(l * 3 + v) * 6144;
            load_rowvec(V, gain, mv, mv + 1024, l > 0 ? mod + ((size_t)((l - 1) * 3 + v) * 6 + 5) * 1024 : nullptr, F.lane); }
        if (l > 0) {
            unpack_x(cur); combine_raw(cur, V);
            store_bf16_row(X + (size_t)m * 1024, F.lane, cur.x); }
        const float rs = row_rs(cur.x);
        f32x4 h[4];
#pragma unroll
        for (int j = 0; j < 4; ++j) h[j] = (cur.x[j] * rs) * V.a[j] + V.b[j];
        store_bf16_row(H + (size_t)m * 1024, F.lane, h);
    }
#undef SRC
#undef LOADROW
}
__device__ __forceinline__ void final_phase(Frame& F, float* out) {
    const bf16_t* X = (const bf16_t*)(F.ws + WS_X); const float* mod = (const float*)(F.ws + WS_MOD); const bf16_t* Y = (const bf16_t*)(F.ws + R_Y);
    const float* gain = F.in[8];
    const int r0 = chunk_lo(F.gw, NLAT, F.NGW), r1 = chunk_lo(F.gw + 1, NLAT, F.NGW);
    RowVec V; RowRaw cur, nxt; int vcur = -1;
    if (r0 < r1) load_rowraw_b(nxt, X + (size_t)r0 * 1024, Y + (size_t)r0 * 2048, F.lane);
    for (int m = r0; m < r1; ++m) {
        cur = nxt;
        if (m + 1 < r1) load_rowraw_b(nxt, X + (size_t)(m + 1) * 1024, Y + (size_t)(m + 1) * 2048, F.lane);
        const int v = row_class(m);
        if (v != vcur) { vcur = v; const float* mv = mod + (size_t)(3 * 3 + v) * 6144; load_rowvec(V, gain, mv, mv + 1024, mv + 5 * 1024, F.lane); }
        unpack_x(cur); combine_raw(cur, V);
        float rs = row_rs(cur.x);
        if (DBG_SEL >= 0 && DBG_SEL < 100) rs *= 1.f + (DBG_SEL >= 16 ? 10.f : 1.f) * fminf(u2f(__hip_atomic_load(F.ctl + CW_DBG + DBG_SEL, RLX_AGENT)), 0.3f);
        if (DBG_SEL == 101) { float code = 0.f;
            for (int g = 0; g < 8; ++g) { float e = 0.f; for (int q = 0; q < 4; ++q) e = fmaxf(e, u2f(__hip_atomic_load(F.ctl + CW_DBG + 16 + 4 * g + q, RLX_AGENT))); if (e > 0.05f) code += 0.1f * (float)(1 << g); }
            rs *= 1.f + code; }
#pragma unroll
        for (int j = 0; j < 4; ++j) { const f32x4 g = *(const f32x4*)(gain + 256 * j + 4 * F.lane); *(f32x4*)(out + (size_t)m * 1024 + 256 * j + 4 * F.lane) = (cur.x[j] * rs) * g; }
    }
}

__device__ __forceinline__ void ffn_norm_route_phase(Frame& F, int l) {
    const int M = (l == DEPTH - 1) ? NLAT : MROWS;
    const bf16_t* X = (const bf16_t*)(F.ws + WS_X); bf16_t* H = (bf16_t*)(F.ws + WS_H);
    const float* mod = (const float*)(F.ws + WS_MOD);
    const float* gain = F.in[7] + l * 1024;
    LAS float* tab = (LAS float*)F.lds;
    LAS int* lcnt = (LAS int*)(F.lds + CNTL_OFF); LAS int* lbase = lcnt + 32;
    LAS int* rec = (LAS int*)(F.lds + REC_OFF);
    {
        const float* wrg = F.in[20] + (size_t)l * 4096; const float* wre = F.in[22] + (size_t)l * 32768;
        for (int i = F.tid; i < 4096; i += NTHREADS) tab[(i & 3) * TAB_LD + (i >> 2)] = wrg[i];
        for (int i = F.tid; i < 32768; i += NTHREADS) tab[(4 + (i & 31)) * TAB_LD + (i >> 5)] = wre[i];
        if (F.tid < 32) lcnt[F.tid] = 0;
    }
    __syncthreads();
    const float* brg = F.in[21] + l * 4; const float* bre = F.in[23] + l * 32;
    const int r0 = 2 * chunk_lo(F.gw, M >> 1, F.NGW), r1 = 2 * chunk_lo(F.gw + 1, M >> 1, F.NGW);
    RowVec V; RowRaw curA, curB, nxtA, nxtB; int vcur = -1;
    if (r0 < r1) { load_rowraw_b(nxtA, X + (size_t)r0 * 1024, nullptr, F.lane); load_rowraw_b(nxtB, X + (size_t)(r0 + 1) * 1024, nullptr, F.lane); }
    float keep[36];
#pragma unroll
    for (int o = 0; o < 36; ++o) keep[o] = 0.f;
    int pit = 0;
    for (int m = r0; m < r1; m += 2, ++pit) {
        curA = nxtA; curB = nxtB;
        if (m + 2 < r1) { load_rowraw_b(nxtA, X + (size_t)(m + 2) * 1024, nullptr, F.lane); load_rowraw_b(nxtB, X + (size_t)(m + 3) * 1024, nullptr, F.lane); }
        unpack_x(curA); unpack_x(curB);
        const int v = row_class(m);
        if (v != vcur) { vcur = v; const float* mv = mod + (size_t)(l * 3 + v) * 6144; load_rowvec(V, gain, mv + 3 * 1024, mv + 4 * 1024, nullptr, F.lane); }
        const float rsA = row_rs(curA.x), rsB = row_rs(curB.x);
        f32x4 hA[4], hB[4];
#pragma unroll
        for (int j = 0; j < 4; ++j) { hA[j] = (curA.x[j] * rsA) * V.a[j] + V.b[j]; hB[j] = (curB.x[j] * rsB) * V.a[j] + V.b[j]; }
        store_bf16_row(H + (size_t)m * 1024, F.lane, hA);
        store_bf16_row(H + (size_t)(m + 1) * 1024, F.lane, hB);
#pragma unroll
        for (int o = 0; o < 36; ++o) {
            f32x2 a2 = {0.f, 0.f}, b2 = {0.f, 0.f};
#pragma unroll
            for (int j = 0; j < 4; ++j) { const f32x4 w = *(const LAS f32x4*)(tab + o * TAB_LD + 256 * j + 4 * F.lane);
                a2 = __builtin_elementwise_fma((f32x2){hA[j].x, hA[j].y}, (f32x2){w.x, w.y}, a2); a2 = __builtin_elementwise_fma((f32x2){hA[j].z, hA[j].w}, (f32x2){w.z, w.w}, a2);
                b2 = __builtin_elementwise_fma((f32x2){hB[j].x, hB[j].y}, (f32x2){w.x, w.y}, b2); b2 = __builtin_elementwise_fma((f32x2){hB[j].z, hB[j].w}, (f32x2){w.z, w.w}, b2); }
            const float tot = wave_sum2(a2.x + a2.y, b2.x + b2.y);
            keep[o] = ((F.lane & 31) == pit) ? tot : keep[o];
        }
    }
    if ((F.lane & 31) < ((r1 - r0) >> 1)) {
        float g0 = keep[0] + brg[0], g1 = keep[1] + brg[1], g2 = keep[2] + brg[2], g3 = keep[3] + brg[3];
        int gs = 0; float gm = g0;
        if (g1 > gm) { gm = g1; gs = 1; } if (g2 > gm) { gm = g2; gs = 2; } if (g3 > gm) { gm = g3; gs = 3; }
        const float pg = 1.f / (__expf(g0 - gm) + __expf(g1 - gm) + __expf(g2 - gm) + __expf(g3 - gm));
        float se[8];
#pragma unroll
        for (int j = 0; j < 8; ++j) { const float a0 = keep[4 + j] + bre[j], a1 = keep[12 + j] + bre[8 + j], a2 = keep[20 + j] + bre[16 + j], a3 = keep[28 + j] + bre[24 + j];
            se[j] = gs == 0 ? a0 : (gs == 1 ? a1 : (gs == 2 ? a2 : a3)); }
        int i0 = 0; float m0 = se[0];
#pragma unroll
        for (int j = 1; j < 8; ++j) if (se[j] > m0) { m0 = se[j]; i0 = j; }
        int i1 = -1; float m1 = -3.0e38f;
#pragma unroll
        for (int j = 0; j < 8; ++j) if (j != i0 && se[j] > m1) { m1 = se[j]; i1 = j; }
        const float e1 = __expf(m1 - m0), w0 = pg / (1.f + e1), w1 = pg * e1 / (1.f + e1);
        const int ea = gs * 8 + i0, eb = gs * 8 + i1;
        const int lra = atomicAdd((int*)(lcnt + ea), 1), lrb = atomicAdd((int*)(lcnt + eb), 1);
        LAS int* r = rec + (((2 * (F.lane & 31) + (F.lane >> 5)) * 8 + F.wave) * 2) * 3;
        r[0] = ea; r[1] = lra; r[2] = __builtin_bit_cast(int, W_CONST > 0.f ? W_CONST : w0);
        r[3] = eb; r[4] = lrb; r[5] = __builtin_bit_cast(int, W_CONST > 0.f ? W_CONST : w1);
    }
    __syncthreads();
    if (F.tid < 32) lbase[F.tid] = (int)__hip_atomic_fetch_add(F.ctl + CW_CNT + (l * 32 + F.tid) * 64, (unsigned)lcnt[F.tid], RLX_AGENT);
    __syncthreads();
    u32x2* list = (u32x2*)(F.ws + WS_LIST);
    if (F.lane < 2 * (r1 - r0)) { const int it = F.lane >> 1, k = F.lane & 1;
        const LAS int* r = rec + ((it * 8 + F.wave) * 2 + k) * 3; const int e = r[0], pos = lbase[e] + r[1];
        list[(size_t)e * MROWS + pos] = (u32x2){(unsigned)(2 * (r0 + it) + k), (unsigned)r[2]}; }
}

__device__ __forceinline__ void moe_tile_map(Frame& F, int l) {
    LAS int* tile_e = (LAS int*)(F.lds + TILE_E_OFF); LAS int* nt = (LAS int*)(F.lds + MOE_NT_OFF);
    LAS int* lcnt = (LAS int*)(F.lds + CNTL_OFF); LAS int* lbase = lcnt + 32;
    __syncthreads();
    if (F.tid < 32) lcnt[F.tid] = (int)__hip_atomic_load(F.ctl + CW_CNT + (l * 32 + F.tid) * 64, RLX_AGENT);
    __syncthreads();
    if (F.tid == 0) {
        int t0 = 0;
        for (int e = 0; e < 32; ++e) { const int c = lcnt[e], n = (c + 255) >> 8; lbase[e] = t0 * 256; for (int t = 0; t < n && t0 + t < 320; ++t) tile_e[t0 + t] = e; t0 += n; }
        nt[0] = t0 < MOE_MAXT ? t0 : MOE_MAXT;
    }
    __syncthreads();
}
__device__ __forceinline__ void moe_gather_phase(Frame& F, int l) {
    moe_tile_map(F, l);
    const LAS int* tile_e = (const LAS int*)(F.lds + TILE_E_OFF); const int nT = *(const LAS int*)(F.lds + MOE_NT_OFF);
    const LAS int* lcnt = (const LAS int*)(F.lds + CNTL_OFF); const LAS int* lbase = lcnt + 32;
    const bf16_t* H = (const bf16_t*)(F.ws + WS_H); bf16_t* XB = (bf16_t*)(F.ws + R_XB); u32x2* RI = (u32x2*)(F.ws + R_RI);
    const u32x2* list = (const u32x2*)(F.ws + WS_LIST);
    const int nrows = nT * 256;
    for (int rb = F.gw * 4; rb < nrows; rb += F.NGW * 4) {
        u32x2 ri[4]; u32x4 a[4], b[4];
#pragma unroll
        for (int q = 0; q < 4; ++q) { const int r = rb + q; const int e = tile_e[r >> 8], j = r - lbase[e];
            ri[q] = (u32x2){0xffffffffu, 0u};
            if (j < lcnt[e]) ri[q] = list[(size_t)e * MROWS + j]; }
#pragma unroll
        for (int q = 0; q < 4; ++q) { a[q] = (u32x4){0u, 0u, 0u, 0u}; b[q] = a[q];
            if (ri[q].x != 0xffffffffu) { const bf16_t* src = H + (size_t)(ri[q].x >> 1) * 1024; a[q] = *(const u32x4*)(src + F.lane * 8); b[q] = *(const u32x4*)(src + 512 + F.lane * 8); } }
#pragma unroll
        for (int q = 0; q < 4; ++q) { const int r = rb + q;
            *(u32x4*)(XB + (size_t)r * 1024 + F.lane * 8) = a[q]; *(u32x4*)(XB + (size_t)r * 1024 + 512 + F.lane * 8) = b[q];
            if (F.lane == 0) RI[r] = ri[q]; }
    }
}

using pg8::Unit;
__device__ __forceinline__ u32x4 pack8(const f32x4 v0, const f32x4 v1) { u32x4 w; w.x = cvt_pk_bf16(v0[0], v0[1]); w.y = cvt_pk_bf16(v0[2], v0[3]); w.z = cvt_pk_bf16(v1[0], v1[1]); w.w = cvt_pk_bf16(v1[2], v1[3]); return w; }

struct EpiStore {
    bf16_t* O; int ldc;
    __device__ __forceinline__ void operator()(const f32x4 (&acc)[2][2][4][2], const Unit& u, int wr, int wc, int fr, int fq) const {
        const int row0 = u.pm * 256 + wr * 64 + fr, col0 = u.pn * 256 + wc * 32 + 8 * fq;
#pragma unroll
        for (int ai = 0; ai < 2; ++ai)
#pragma unroll
            for (int m = 0; m < 4; ++m) { bf16_t* rowp = O + (size_t)(row0 + ai * 128 + m * 16) * ldc + col0;
#pragma unroll
                for (int bj = 0; bj < 2; ++bj) *(u32x4*)(rowp + bj * 128) = pack8(acc[ai][bj][m][0], acc[ai][bj][m][1]); }
    }
};
template <bool F32SRC>
struct EpiOut {
    bf16_t* X; const float* modl;
    const float* Xs; const float* Xc;
    __device__ __forceinline__ void operator()(const f32x4 (&acc)[2][2][4][2], const Unit& u, int wr, int wc, int fr, int fq) const {
        const int row0 = u.pm * 256 + wr * 64 + fr, col0 = u.pn * 256 + wc * 32 + 8 * fq;
        const int v = u.pm < 64 ? 0 : (u.pm < 128 ? 1 : 2);
        const float* g1 = modl + (size_t)v * 6144 + 2 * 1024 + col0;
        f32x4 g[2][2];
#pragma unroll
        for (int bj = 0; bj < 2; ++bj) { g[bj][0] = *(const f32x4*)(g1 + bj * 128); g[bj][1] = *(const f32x4*)(g1 + bj * 128 + 4); }
#pragma unroll
        for (int ai = 0; ai < 2; ++ai)
#pragma unroll
            for (int m = 0; m < 4; ++m) { const int row = row0 + ai * 128 + m * 16; bf16_t* rowp = X + (size_t)row * 1024 + col0;
#pragma unroll
                for (int bj = 0; bj < 2; ++bj) {
                    f32x4 a, b;
                    if (F32SRC) { const f32x4* q = (const f32x4*)((u.pm < 128 ? Xs + (size_t)row * 1024 : Xc + (size_t)(row - NLAT) * 1024) + col0 + bj * 128); a = q[0]; b = q[1]; }
                    else { const u32x4 t = *(const u32x4*)(rowp + bj * 128);
                        a = (f32x4){bf16lo(t.x), bf16hi(t.x), bf16lo(t.y), bf16hi(t.y)}; b = (f32x4){bf16lo(t.z), bf16hi(t.z), bf16lo(t.w), bf16hi(t.w)}; }
                    a = a + g[bj][0] * acc[ai][bj][m][0]; b = b + g[bj][1] * acc[ai][bj][m][1];
                    u32x4 w; w.x = cvt_pk_bf16(a.x, a.y); w.y = cvt_pk_bf16(a.z, a.w); w.z = cvt_pk_bf16(b.x, b.y); w.w = cvt_pk_bf16(b.z, b.w);
                    *(u32x4*)(rowp + bj * 128) = w; } }
    }
};
struct EpiNaIn {
    bf16_t* QK; bf16_t* Vt; bf16_t* Vtc;
    __device__ __forceinline__ void operator()(const f32x4 (&acc)[2][2][4][2], const Unit& u, int wr, int wc, int fr, int fq) const {
        const int row0 = u.pm * 256 + wr * 64 + fr, col0 = u.pn * 256 + wc * 32 + 8 * fq;
        if (u.pn < 8) {
            const float sc = u.pn < 4 ? SC_B : 1.f;
#pragma unroll
            for (int ai = 0; ai < 2; ++ai)
#pragma unroll
                for (int m = 0; m < 4; ++m) { bf16_t* rowp = QK + (size_t)(row0 + ai * 128 + m * 16) * 2048 + col0;
#pragma unroll
                    for (int bj = 0; bj < 2; ++bj) *(u32x4*)(rowp + bj * 128) = pack8(acc[ai][bj][m][0] * sc, acc[ai][bj][m][1] * sc); }
        } else {
#pragma unroll
            for (int ai = 0; ai < 2; ++ai)
#pragma unroll
                for (int m = 0; m < 4; ++m) { const int row = row0 + ai * 128 + m * 16;
                    bf16_t* base; size_t ld;
                    if (row < NLAT) { base = Vt + (size_t)(row >> 14) * 1024 * SEQ + (row & (SEQ - 1)); ld = SEQ; }
                    else { const int rc = row - NLAT; base = Vtc + (size_t)(rc >> 8) * 1024 * CTXL + (rc & 255); ld = CTXL; }
#pragma unroll
                    for (int bj = 0; bj < 2; ++bj) { const int hc = col0 + bj * 128 - 2048;
                        const u32x4 w = pack8(acc[ai][bj][m][0], acc[ai][bj][m][1]);
                        bf16_t* p = base + (size_t)hc * ld;
                        p[0] = (bf16_t)(w.x & 0xffff); p[ld] = (bf16_t)(w.x >> 16); p[2 * ld] = (bf16_t)(w.y & 0xffff); p[3 * ld] = (bf16_t)(w.y >> 16);
                        p[4 * ld] = (bf16_t)(w.z & 0xffff); p[5 * ld] = (bf16_t)(w.z >> 16); p[6 * ld] = (bf16_t)(w.w & 0xffff); p[7 * ld] = (bf16_t)(w.w >> 16); } }
        }
    }
};
struct EpiMoe1 {
    bf16_t* ACT;
    __device__ __forceinline__ void operator()(const f32x4 (&acc)[2][2][4][2], const Unit& u, int wr, int wc, int fr, int fq) const {
        const int row0 = u.pm * 256 + wr * 64 + fr, col0 = u.pn * 128 + wc * 32 + 8 * fq;
#pragma unroll
        for (int ai = 0; ai < 2; ++ai)
#pragma unroll
            for (int m = 0; m < 4; ++m) { f32x4 o[2];
#pragma unroll
                for (int n = 0; n < 2; ++n)
#pragma unroll
                    for (int i = 0; i < 4; ++i) { const float g = acc[ai][0][m][n][i], up = acc[ai][1][m][n][i];
                        o[n][i] = g * __builtin_amdgcn_rcpf(1.f + __builtin_amdgcn_exp2f(-g * LOG2E)) * up; }
                *(u32x4*)(ACT + (size_t)(row0 + ai * 128 + m * 16) * 512 + col0) = pack8(o[0], o[1]); }
    }
};
struct EpiMoe2 {
    bf16_t* Y; const LAS int* tile_e; const LAS int* lcnt; const LAS int* lbase; const u32x2* list;
    __device__ __forceinline__ void operator()(const f32x4 (&acc)[2][2][4][2], const Unit& u, int wr, int wc, int fr, int fq) const {
        const int row0 = u.pm * 256 + wr * 64 + fr, col0 = u.pn * 256 + wc * 32 + 8 * fq;
        const int e = tile_e[u.pm], j0 = row0 - lbase[e], cnt = lcnt[e];
#pragma unroll
        for (int ai = 0; ai < 2; ++ai)
#pragma unroll
            for (int m = 0; m < 4; ++m) { const int j = j0 + ai * 128 + m * 16;
                if (j < cnt) { const u32x2 ri = list[(size_t)e * MROWS + j]; const float w = u2f(ri.y); bf16_t* rowp = Y + (size_t)ri.x * 1024 + col0;
#pragma unroll
                    for (int bj = 0; bj < 2; ++bj) *(u32x4*)(rowp + bj * 128) = pack8(acc[ai][bj][m][0] * w, acc[ai][bj][m][1] * w); } }
    }
};

__device__ __forceinline__ void ab_prep_phase(Frame& F, int li) {
    const bf16_t* P = (const bf16_t*)(F.ws + R_P);
    bf16_t* CQN = (bf16_t*)(F.ws + R_CQN); bf16_t* CKVN = (bf16_t*)(F.ws + R_CKVN); bf16_t* KR = (bf16_t*)(F.ws + R_KR);
    bf16_t* QB = (bf16_t*)(F.ws + R_QB); bf16_t* KB = (bf16_t*)(F.ws + R_KB); bf16_t* VB = (bf16_t*)(F.ws + R_VB);
    const f32x2* rope = (const f32x2*)(F.ws + WS_ROPE);
    const float* qn = F.in[11] + li * QLORA; const float* kvn = F.in[13] + li * KVLORA; const float* gqn = F.in[15] + li * 64; const float* gkn = F.in[16] + li * 64;
    const int l = F.lane;
    for (int m = F.gw; m < MROWS; m += F.NGW) {
        const bf16_t* p = P + (size_t)m * AB_INP;
        const bool lat = m < NLAT; const int t = m & (SEQ - 1), gr = t >> 6, gc = t & 63;
        const unsigned* pc = (const unsigned*)(p + 6 * l); const unsigned c0 = pc[0], c1 = pc[1], c2 = pc[2];
        const u32x2 kv = *(const u32x2*)(p + 384 + 4 * l);
        const unsigned krw = *(const unsigned*)(p + 640 + 2 * (l & 15));
        const u32x4 gq = *(const u32x4*)(p + 672 + 8 * l);
        const unsigned gkw = *(const unsigned*)(p + 1184 + 2 * l), gvw = *(const unsigned*)(p + 1312 + 2 * l);
        { float x[6] = {bf16lo(c0), bf16hi(c0), bf16lo(c1), bf16hi(c1), bf16lo(c2), bf16hi(c2)};
          float ss = 0.f;
#pragma unroll
          for (int i = 0; i < 6; ++i) ss += x[i] * x[i];
          const float rs = rsqrtf(wave_sum(ss) * (1.f / 384.f) + RMS_EPS);
          unsigned* o = (unsigned*)(CQN + (size_t)m * QLORA + 6 * l);
#pragma unroll
          for (int i = 0; i < 3; ++i) o[i] = cvt_pk_bf16(x[2 * i] * rs * qn[6 * l + 2 * i], x[2 * i + 1] * rs * qn[6 * l + 2 * i + 1]); }
        { float x[4] = {bf16lo(kv.x), bf16hi(kv.x), bf16lo(kv.y), bf16hi(kv.y)};
          const float ss = (x[0] * x[0] + x[1] * x[1]) + (x[2] * x[2] + x[3] * x[3]);
          const float rs = rsqrtf(wave_sum(ss) * (1.f / 256.f) + RMS_EPS);
          const f32x4 g = *(const f32x4*)(kvn + 4 * l);
          u32x2 w; w.x = cvt_pk_bf16(x[0] * rs * g.x, x[1] * rs * g.y); w.y = cvt_pk_bf16(x[2] * rs * g.z, x[3] * rs * g.w);
          *(u32x2*)(CKVN + (size_t)m * KVLORA + 4 * l) = w; }
        if (l < 16) { float x1 = bf16lo(krw), x2 = bf16hi(krw);
            if (lat) { const f32x2 cs = (l < 8) ? rope[gr * 8 + l] : rope[2048 + gc * 8 + (l - 8)]; const float a = x1 * cs.x - x2 * cs.y, b = x1 * cs.y + x2 * cs.x; x1 = a; x2 = b; }
            *(unsigned*)(KR + (size_t)m * 32 + 2 * l) = cvt_pk_bf16(x1, x2); }
        { float x[8] = {bf16lo(gq.x), bf16hi(gq.x), bf16lo(gq.y), bf16hi(gq.y), bf16lo(gq.z), bf16hi(gq.z), bf16lo(gq.w), bf16hi(gq.w)};
          float ss = 0.f;
#pragma unroll
          for (int i = 0; i < 8; ++i) ss += x[i] * x[i];
          ss += __shfl_xor(ss, 1); ss += __shfl_xor(ss, 2); ss += __shfl_xor(ss, 4);
          const float rs = rsqrtf(ss * (1.f / 64.f) + RMS_EPS);
          const int d0 = (l & 7) * 8;
          const f32x4 g0 = *(const f32x4*)(gqn + d0), g1 = *(const f32x4*)(gqn + d0 + 4);
          x[0] *= rs * g0.x; x[1] *= rs * g0.y; x[2] *= rs * g0.z; x[3] *= rs * g0.w; x[4] *= rs * g1.x; x[5] *= rs * g1.y; x[6] *= rs * g1.z; x[7] *= rs * g1.w;
          if (lat) { const int p0 = (l & 7) * 4; const f32x2* tp = (p0 < 16) ? rope + 2560 + gr * 16 + p0 : rope + 6656 + gc * 16 + (p0 - 16);
              const f32x4 cs0 = *(const f32x4*)tp, cs1 = *(const f32x4*)(tp + 2);
              float a;
              a = x[0] * cs0[0] - x[1] * cs0[1]; x[1] = x[0] * cs0[1] + x[1] * cs0[0]; x[0] = a;
              a = x[2] * cs0[2] - x[3] * cs0[3]; x[3] = x[2] * cs0[3] + x[3] * cs0[2]; x[2] = a;
              a = x[4] * cs1[0] - x[5] * cs1[1]; x[5] = x[4] * cs1[1] + x[5] * cs1[0]; x[4] = a;
              a = x[6] * cs1[2] - x[7] * cs1[3]; x[7] = x[6] * cs1[3] + x[7] * cs1[2]; x[6] = a; }
          u32x4 w; w.x = cvt_pk_bf16(x[0] * SC_B, x[1] * SC_B); w.y = cvt_pk_bf16(x[2] * SC_B, x[3] * SC_B); w.z = cvt_pk_bf16(x[4] * SC_B, x[5] * SC_B); w.w = cvt_pk_bf16(x[6] * SC_B, x[7] * SC_B);
          *(u32x4*)(QB + (size_t)m * 512 + 8 * l) = w; }
        { float x1 = bf16lo(gkw), x2 = bf16hi(gkw);
          float ss = x1 * x1 + x2 * x2;
          ss += __shfl_xor(ss, 1); ss += __shfl_xor(ss, 2); ss += __shfl_xor(ss, 4); ss += __shfl_xor(ss, 8); ss += __shfl_xor(ss, 16);
          const float rs = rsqrtf(ss * (1.f / 64.f) + RMS_EPS);
          const int pi = l & 31;
          x1 *= rs * gkn[2 * pi]; x2 *= rs * gkn[2 * pi + 1];
          if (lat) { const f32x2 cs = (pi < 16) ? rope[2560 + gr * 16 + pi] : rope[6656 + gc * 16 + (pi - 16)]; const float a = x1 * cs.x - x2 * cs.y, b = x1 * cs.y + x2 * cs.x; x1 = a; x2 = b; }
          *(unsigned*)(KB + (size_t)m * 128 + 2 * l) = cvt_pk_bf16(x1, x2);
          *(unsigned*)(VB + (size_t)m * 128 + 2 * l) = gvw; }
    }
}

namespace att {
constexpr int B_KN = 0, B_KR = 8192, B_V = 12288, BUF = 20480;
constexpr float THR2 = 8.f * LOG2E;
__device__ __forceinline__ int crow(int r, int hi) { return (r & 3) + 8 * (r >> 2) + 4 * hi; }
__device__ __forceinline__ int swz64(int row, int ch) { return row * 128 + ((ch ^ ((row >> 1) & 7)) << 4); }
__device__ __forceinline__ int swz32(int row, int ch) { return row * 64 + ((ch ^ ((row >> 2) & 3)) << 4); }
__device__ __forceinline__ int v_st(int k, int c) { const int kk = k;     return ((kk >> 3) * 2 + (c >> 5)) * 512 + ((kk & 7) * 32 + (c & 31)) * 2; }
__device__ __forceinline__ int v_rd_base(int lane) { return ((lane & 3) << 3) | (((lane >> 2) & 3) << 6) | (((lane >> 4) & 1) << 5) | (((lane >> 5) & 1) << 8); }
constexpr int v_rd_off(int d0, int ks, int half) { return d0 * 512 + ks * 2048 + half * 1024; }
template <int OFF> __device__ __forceinline__ s16x4 tr_read(unsigned vb) {
    s16x4 r; asm volatile("ds_read_b64_tr_b16 %0, %1 offset:%2" : "=&v"(r) : "v"(vb), "i"(OFF) : "memory"); return r;
}
__device__ __forceinline__ float psm_max(const f32x16& p0, const f32x16& p1) {
    float pmax = p0[0];
#pragma unroll
    for (int r = 1; r < 16; ++r) pmax = fmaxf(pmax, p0[r]);
#pragma unroll
    for (int r = 0; r < 16; ++r) pmax = fmaxf(pmax, p1[r]);
    { auto rr = __builtin_amdgcn_permlane32_swap(__float_as_uint(pmax), __float_as_uint(pmax), false, false);
      pmax = fmaxf(__uint_as_float(rr[0]), __uint_as_float(rr[1])); }
    return pmax;
}
template <bool FIRST> __device__ __forceinline__ void psm_apply(f32x16& p0, f32x16& p1, float pmax, float& m_reg, f32x16& negm, float& alpha) {
    alpha = 1.f;
    if (FIRST || !__builtin_expect(__all(pmax <= THR2), 1)) {
        const float delta = FIRST ? pmax : fmaxf(pmax, 0.f);
        if (!FIRST) alpha = __builtin_amdgcn_exp2f(-delta);
        m_reg += delta;
#pragma unroll
        for (int r = 0; r < 16; ++r) { p0[r] -= delta; p1[r] -= delta; negm[r] = -m_reg; }
    }
#pragma unroll
    for (int r = 0; r < 16; ++r) p0[r] = EXP_PROBE ? fmaf(p0[r], 0.001f, 1.f) : __builtin_amdgcn_exp2f(p0[r]);
}
template <bool FIRST> __device__ __forceinline__ void partialSM(f32x16& p0, f32x16& p1, float& m_reg, f32x16& negm, float& alpha) {
    const float pmax = psm_max(p0, p1); psm_apply<FIRST>(p0, p1, pmax, m_reg, negm, alpha);
}
#define ATT_PK4(P, BASE, OUT) do { unsigned a0 = cvt_pk_bf16(P[BASE + 0], P[BASE + 1]), a1 = cvt_pk_bf16(P[BASE + 2], P[BASE + 3]);   \
    unsigned b0 = cvt_pk_bf16(P[BASE + 4], P[BASE + 5]), b1 = cvt_pk_bf16(P[BASE + 6], P[BASE + 7]);                              \
    auto r0 = __builtin_amdgcn_permlane32_swap(a0, b0, false, false); auto r1 = __builtin_amdgcn_permlane32_swap(a1, b1, false, false); \
    u32x4 w = {r0[0], r1[0], r0[1], r1[1]}; OUT = __builtin_bit_cast(bf16x8, w); } while (0)
#define ATT_PKN(P, BASE, OUT) do { u32x4 w = {cvt_pk_bf16(P[BASE + 0], P[BASE + 1]), cvt_pk_bf16(P[BASE + 2], P[BASE + 3]), cvt_pk_bf16(P[BASE + 4], P[BASE + 5]), cvt_pk_bf16(P[BASE + 6], P[BASE + 7])}; \
    OUT = __builtin_bit_cast(bf16x8, w); } while (0)
__device__ __forceinline__ void finishSM(f32x16& p0, f32x16& p1, float alpha, float& l_reg, bf16x8& pa0, bf16x8& pa1, bf16x8& pa2, bf16x8& pa3) {
#pragma unroll
    for (int r = 0; r < 16; ++r) p1[r] = EXP_PROBE ? fmaf(p1[r], 0.001f, 1.f) : __builtin_amdgcn_exp2f(p1[r]);
    float ps = 0.f;
#pragma unroll
    for (int r = 0; r < 16; ++r) ps += p0[r];
#pragma unroll
    for (int r = 0; r < 16; ++r) ps += p1[r];
    { auto rr = __builtin_amdgcn_permlane32_swap(__float_as_uint(ps), __float_as_uint(ps), false, false);
      ps = __uint_as_float(rr[0]) + __uint_as_float(rr[1]); }
    l_reg = l_reg * alpha + ps;
    ATT_PKN(p0, 0, pa0); ATT_PKN(p0, 8, pa1); ATT_PKN(p1, 0, pa2); ATT_PKN(p1, 8, pa3);
}
template <int DQK> __device__ __forceinline__ void qkt(f32x16& p0, f32x16& p1, const LAS char* buf, const bf16x8* qr, int r32, int hi, const f32x16& negm) {
#pragma unroll
    for (int d0 = 0; d0 < 4; ++d0) { const int ch = d0 * 2 + hi;
        const bf16x8 b0 = *(const LAS bf16x8*)(buf + B_KN + swz64(r32, ch));
        const bf16x8 b1 = *(const LAS bf16x8*)(buf + B_KN + swz64(32 + r32, ch));
        p0 = __builtin_amdgcn_mfma_f32_32x32x16_bf16(b0, qr[d0], d0 == 0 ? negm : p0, 0, 0, 0);
        p1 = __builtin_amdgcn_mfma_f32_32x32x16_bf16(b1, qr[d0], d0 == 0 ? negm : p1, 0, 0, 0); }
    if constexpr (DQK == 96) {
#pragma unroll
        for (int d0 = 0; d0 < 2; ++d0) { const int ch = d0 * 2 + hi;
            const bf16x8 b0 = *(const LAS bf16x8*)(buf + B_KR + swz32(r32, ch));
            const bf16x8 b1 = *(const LAS bf16x8*)(buf + B_KR + swz32(32 + r32, ch));
            p0 = __builtin_amdgcn_mfma_f32_32x32x16_bf16(b0, qr[4 + d0], p0, 0, 0, 0);
            p1 = __builtin_amdgcn_mfma_f32_32x32x16_bf16(b1, qr[4 + d0], p1, 0, 0, 0); }
    }
}
template <int D0> __device__ __forceinline__ void pv_one(f32x16& od, unsigned vb, bf16x8 pa0, bf16x8 pa1, bf16x8 pa2, bf16x8 pa3) {
    const s16x4 l0 = tr_read<v_rd_off(D0, 0, 0)>(vb), h0 = tr_read<v_rd_off(D0, 0, 1)>(vb), l1 = tr_read<v_rd_off(D0, 1, 0)>(vb), h1 = tr_read<v_rd_off(D0, 1, 1)>(vb);
    const s16x4 l2 = tr_read<v_rd_off(D0, 2, 0)>(vb), h2 = tr_read<v_rd_off(D0, 2, 1)>(vb), l3 = tr_read<v_rd_off(D0, 3, 0)>(vb), h3 = tr_read<v_rd_off(D0, 3, 1)>(vb);
    asm volatile("s_waitcnt lgkmcnt(0)" ::: "memory"); SBAR();
#define ATT_PK(L, H) (bf16x8){L[0], L[1], L[2], L[3], H[0], H[1], H[2], H[3]}
    od = __builtin_amdgcn_mfma_f32_32x32x16_bf16(ATT_PK(l0, h0), pa0, od, 0, 0, 0);
    od = __builtin_amdgcn_mfma_f32_32x32x16_bf16(ATT_PK(l1, h1), pa1, od, 0, 0, 0);
    od = __builtin_amdgcn_mfma_f32_32x32x16_bf16(ATT_PK(l2, h2), pa2, od, 0, 0, 0);
    od = __builtin_amdgcn_mfma_f32_32x32x16_bf16(ATT_PK(l3, h3), pa3, od, 0, 0, 0);
#undef ATT_PK
}

#define ATT_PK(L, H) (bf16x8){L[0], L[1], L[2], L[3], H[0], H[1], H[2], H[3]}
template <bool FIXM> __device__ __forceinline__ void pv_psm(f32x16& o0, f32x16& o1, unsigned vb, bf16x8 pa0, bf16x8 pa1, bf16x8 pa2, bf16x8 pa3,
                                       f32x16& p0, f32x16& p1, float& m_reg, f32x16& negm, float& alpha) {
    { const s16x4 l0 = tr_read<v_rd_off(0, 0, 0)>(vb), h0 = tr_read<v_rd_off(0, 0, 1)>(vb), l1 = tr_read<v_rd_off(0, 1, 0)>(vb), h1 = tr_read<v_rd_off(0, 1, 1)>(vb);
      const s16x4 l2 = tr_read<v_rd_off(0, 2, 0)>(vb), h2 = tr_read<v_rd_off(0, 2, 1)>(vb), l3 = tr_read<v_rd_off(0, 3, 0)>(vb), h3 = tr_read<v_rd_off(0, 3, 1)>(vb);
      float pmax = 0.f; SBAR(); if (!FIXM) pmax = psm_max(p0, p1); else { _Pragma("unroll") for (int r = 0; r < 8; ++r) p0[r] = __builtin_amdgcn_exp2f(p0[r]); } SBAR();
      asm volatile("s_waitcnt lgkmcnt(0)" ::: "memory"); SBAR();
      o0 = __builtin_amdgcn_mfma_f32_32x32x16_bf16(ATT_PK(l0, h0), pa0, o0, 0, 0, 0);
      o0 = __builtin_amdgcn_mfma_f32_32x32x16_bf16(ATT_PK(l1, h1), pa1, o0, 0, 0, 0);
      o0 = __builtin_amdgcn_mfma_f32_32x32x16_bf16(ATT_PK(l2, h2), pa2, o0, 0, 0, 0);
      o0 = __builtin_amdgcn_mfma_f32_32x32x16_bf16(ATT_PK(l3, h3), pa3, o0, 0, 0, 0);
      SBAR();
      const s16x4 m0 = tr_read<v_rd_off(1, 0, 0)>(vb), n0 = tr_read<v_rd_off(1, 0, 1)>(vb), m1 = tr_read<v_rd_off(1, 1, 0)>(vb), n1 = tr_read<v_rd_off(1, 1, 1)>(vb);
      const s16x4 m2 = tr_read<v_rd_off(1, 2, 0)>(vb), n2 = tr_read<v_rd_off(1, 2, 1)>(vb), m3 = tr_read<v_rd_off(1, 3, 0)>(vb), n3 = tr_read<v_rd_off(1, 3, 1)>(vb);
      SBAR(); if (!FIXM) psm_apply<false>(p0, p1, pmax, m_reg, negm, alpha); else { alpha = 1.f; _Pragma("unroll") for (int r = 8; r < 16; ++r) p0[r] = __builtin_amdgcn_exp2f(p0[r]); } SBAR();
      asm volatile("s_waitcnt lgkmcnt(0)" ::: "memory"); SBAR();
      o1 = __builtin_amdgcn_mfma_f32_32x32x16_bf16(ATT_PK(m0, n0), pa0, o1, 0, 0, 0);
      o1 = __builtin_amdgcn_mfma_f32_32x32x16_bf16(ATT_PK(m1, n1), pa1, o1, 0, 0, 0);
      o1 = __builtin_amdgcn_mfma_f32_32x32x16_bf16(ATT_PK(m2, n2), pa2, o1, 0, 0, 0);
      o1 = __builtin_amdgcn_mfma_f32_32x32x16_bf16(ATT_PK(m3, n3), pa3, o1, 0, 0, 0); }
}
#undef ATT_PK
template <int DQK, bool FIXM>
__device__ __forceinline__ void attn_unit(const bf16_t* __restrict__ Qp, int ldq, const bf16_t* __restrict__ Knp, int ldk, const bf16_t* __restrict__ Krp,
                                          const bf16_t* __restrict__ Vp, int ldv, bf16_t* __restrict__ Op, int lat0, int nlt, int ctx0, int NT, LAS char* lds, const int tid, const f32x2* rope, int qtok0, float mfix) {
    constexpr int NQ = DQK / 16;
    const int wid = tid >> 6, lane = tid & 63, r32 = lane & 31, hi = lane >> 5;
    float m_reg = 0.f, l_reg = 0.f; f32x16 o0 = {}, o1 = {}, negm = {}; bf16x8 qr[NQ];
    if (FIXM) { _Pragma("unroll") for (int r = 0; r < 16; ++r) negm[r] = -mfix; }
    const bf16_t* Qw = Qp + (size_t)(wid * 32 + r32) * ldq + hi * 8;
#pragma unroll
    for (int d0 = 0; d0 < NQ; ++d0) qr[d0] = *(const bf16x8*)(Qw + d0 * 16);
    if constexpr (DQK == 96) { if (qtok0 >= 0) {
        const int t = qtok0 + wid * 32 + r32, gr = t >> 6, gc = t & 63;
#pragma unroll
        for (int e = 0; e < 2; ++e) { const f32x2* tp = (e == 0) ? rope + gr * 8 + hi * 4 : rope + 2048 + gc * 8 + hi * 4;
            const f32x4 cs0 = *(const f32x4*)tp, cs1 = *(const f32x4*)(tp + 2);
            const u32x4 w = __builtin_bit_cast(u32x4, qr[4 + e]); u32x4 o;
            { const float x1 = bf16lo(w.x), x2 = bf16hi(w.x); o.x = cvt_pk_bf16(x1 * cs0[0] - x2 * cs0[1], x1 * cs0[1] + x2 * cs0[0]); }
            { const float x1 = bf16lo(w.y), x2 = bf16hi(w.y); o.y = cvt_pk_bf16(x1 * cs0[2] - x2 * cs0[3], x1 * cs0[3] + x2 * cs0[2]); }
            { const float x1 = bf16lo(w.z), x2 = bf16hi(w.z); o.z = cvt_pk_bf16(x1 * cs1[0] - x2 * cs1[1], x1 * cs1[1] + x2 * cs1[0]); }
            { const float x1 = bf16lo(w.w), x2 = bf16hi(w.w); o.w = cvt_pk_bf16(x1 * cs1[2] - x2 * cs1[3], x1 * cs1[3] + x2 * cs1[2]); }
            qr[4 + e] = __builtin_bit_cast(bf16x8, o); } } }
    const int sr = tid >> 3, c8 = tid & 7, sr2 = (tid >> 2) & 63, c4 = tid & 3;
    const bool krw = (DQK == 96) && (tid < 256);
    const int kn_st = B_KN + swz64(sr, c8), v_stw = B_V + v_st(sr, c8 * 8), kr_st = B_KR + swz32(sr2, c4);
    const unsigned vb0 = (unsigned)(uintptr_t)lds + B_V + v_rd_base(lane);
    bf16x8 skn[2], sv[2], skr[2];
#define KROW(j) ((j) < nlt ? lat0 + 64 * (j) : ctx0 + 64 * ((j) - nlt))
#define SLOAD(i, j) do { const int _row = KROW(j); skn[i] = *(const bf16x8*)(Knp + (size_t)(_row + sr) * ldk + c8 * 8); sv[i] = *(const bf16x8*)(Vp + (size_t)(_row + sr) * ldv + c8 * 8); \
        if (krw) skr[i] = *(const bf16x8*)(Krp + (size_t)(_row + sr2) * 32 + c4 * 8); } while (0)
#define SWRITE(b, i) do { *(LAS bf16x8*)(lds + (b) * BUF + kn_st) = skn[i]; *(LAS bf16x8*)(lds + (b) * BUF + v_stw) = sv[i]; if (krw) *(LAS bf16x8*)(lds + (b) * BUF + kr_st) = skr[i]; } while (0)
#define SWRITEO(boff, i) do { *(LAS bf16x8*)(lds + (boff) + kn_st) = skn[i]; *(LAS bf16x8*)(lds + (boff) + v_stw) = sv[i]; if (krw) *(LAS bf16x8*)(lds + (boff) + kr_st) = skr[i]; } while (0)
#define PVO(boff) do { pv_one<0>(o0, vb0 + (boff), pa0, pa1, pa2, pa3); pv_one<1>(o1, vb0 + (boff), pa0, pa1, pa2, pa3); } while (0)
#define SWAIT() asm volatile("s_waitcnt vmcnt(2)" ::: "memory")
#define RESC(a) do { if (__any((a) < 1.f)) { _Pragma("unroll") for (int r = 0; r < 16; ++r) { o0[r] *= (a); o1[r] *= (a); } } } while (0)
#define PV(bufi) do { pv_one<0>(o0, vb0 + (bufi) * BUF, pa0, pa1, pa2, pa3); pv_one<1>(o1, vb0 + (bufi) * BUF, pa0, pa1, pa2, pa3); } while (0)
    f32x16 pA0, pA1, pB0, pB1; float alA, alB; bf16x8 pa0, pa1, pa2, pa3;
    int bV = 0, bK = BUF, bW = 2 * BUF;
#define ROT() do { const int _t = bV; bV = bK; bK = bW; bW = _t; } while (0)
    __syncthreads();
    SLOAD(0, 0); asm volatile("s_waitcnt vmcnt(0)" ::: "memory"); SWRITE(0, 0);
    SLOAD(1, 1); if (2 < NT) SLOAD(0, 2);
    __syncthreads();
    qkt<DQK>(pA0, pA1, lds, qr, r32, hi, negm);
    if (FIXM) { alA = 1.f; _Pragma("unroll") for (int r = 0; r < 16; ++r) pA0[r] = __builtin_amdgcn_exp2f(pA0[r]); } else partialSM<true>(pA0, pA1, m_reg, negm, alA);
    SWAIT(); SWRITEO(BUF, 1);
    for (int j = 1; j + 1 < NT; j += 2) {
        if (!NOBAR_PROBE) __syncthreads();
        SBAR(); qkt<DQK>(pB0, pB1, lds + bK, qr, r32, hi, negm);
        finishSM(pA0, pA1, alA, l_reg, pa0, pa1, pa2, pa3); SBAR();
        SLOAD(1, j + 2); SBAR();
        if constexpr (FIXM) pv_psm<true>(o0, o1, vb0 + bV, pa0, pa1, pa2, pa3, pB0, pB1, m_reg, negm, alB); else { PVO(bV); partialSM<false>(pB0, pB1, m_reg, negm, alB); }
        SWAIT(); SWRITEO(bW, 0);
        if (!FIXM) RESC(alB); ROT();
        if (!NOBAR_PROBE) __syncthreads();
        SBAR(); qkt<DQK>(pA0, pA1, lds + bK, qr, r32, hi, negm);
        finishSM(pB0, pB1, alB, l_reg, pa0, pa1, pa2, pa3); SBAR();
        if (j + 3 < NT) SLOAD(0, j + 3); SBAR();
        if constexpr (FIXM) pv_psm<true>(o0, o1, vb0 + bV, pa0, pa1, pa2, pa3, pA0, pA1, m_reg, negm, alA); else { PVO(bV); partialSM<false>(pA0, pA1, m_reg, negm, alA); }
        SWAIT(); SWRITEO(bW, 1);
        if (!FIXM) RESC(alA); ROT();
    }
    __syncthreads();
    SBAR(); qkt<DQK>(pB0, pB1, lds + bK, qr, r32, hi, negm);
    finishSM(pA0, pA1, alA, l_reg, pa0, pa1, pa2, pa3); SBAR();
    if constexpr (FIXM) pv_psm<true>(o0, o1, vb0 + bV, pa0, pa1, pa2, pa3, pB0, pB1, m_reg, negm, alB); else { PVO(bV); partialSM<false>(pB0, pB1, m_reg, negm, alB); }
    if (!FIXM) RESC(alB);
    finishSM(pB0, pB1, alB, l_reg, pa0, pa1, pa2, pa3); SBAR();
    PVO(bK);
#undef ROT
    const float inv = __builtin_amdgcn_rcpf(l_reg);
    bf16_t* Ow = Op + (size_t)(wid * 32 + r32) * 1024 + 4 * hi;
#pragma unroll
    for (int g = 0; g < 4; ++g) {
        u32x2 w0, w1;
        w0.x = cvt_pk_bf16(o0[4 * g] * inv, o0[4 * g + 1] * inv); w0.y = cvt_pk_bf16(o0[4 * g + 2] * inv, o0[4 * g + 3] * inv);
        w1.x = cvt_pk_bf16(o1[4 * g] * inv, o1[4 * g + 1] * inv); w1.y = cvt_pk_bf16(o1[4 * g + 2] * inv, o1[4 * g + 3] * inv);
        *(u32x2*)(Ow + 8 * g) = w0; *(u32x2*)(Ow + 32 + 8 * g) = w1;
    }
#undef KROW
#undef SLOAD
#undef SWRITE
#undef SWAIT
#undef SWRITEO
#undef PVO
#undef RESC
#undef PV
}
}

__device__ __forceinline__ void attn_phase(Frame& F, int li) {
    const bf16_t* QA = (const bf16_t*)(F.ws + R_QA); const bf16_t* KVA = (const bf16_t*)(F.ws + R_KVA); const bf16_t* KR = (const bf16_t*)(F.ws + R_KR);
    const bf16_t* QB = (const bf16_t*)(F.ws + R_QB); const bf16_t* KB = (const bf16_t*)(F.ws + R_KB); const bf16_t* VB = (const bf16_t*)(F.ws + R_VB);
    bf16_t* O = (bf16_t*)(F.ws + R_O);
    LAS char* lds = (LAS char*)F.lds;
    float mfixB; { float gq = 0.f, gk = 0.f; const float* a = F.in[15] + li * 64; const float* b = F.in[16] + li * 64;
        for (int i = 0; i < 64; ++i) { gq = fmaxf(gq, fabsf(a[i])); gk = fmaxf(gk, fabsf(b[i])); } mfixB = 64.f * gq * gk * SC_B * 1.02f; }
    constexpr int NU = 2048 + 32;
    for (int u = F.vcu; u < NU; u += F.G) {
        if (u < 1024 || (u >= 2048 && u < 2064)) {
            const bool isctx = u >= 2048; const int uu = isctx ? u - 2048 : u;
            const int b = isctx ? (uu >> 3) : (uu >> 9), h = isctx ? (uu & 7) : ((uu >> 6) & 7), qb = uu & 63;
            const int q0 = isctx ? NLAT + b * CTXL : b * SEQ + qb * 256;
            att::attn_unit<96, false>(QA + (size_t)q0 * 768 + h * 96, 768, KVA + h * 128, 1024, KR, KVA + h * 128 + 64, 1024, O + (size_t)q0 * 1024 + h * 64,
                               b * SEQ, isctx ? 0 : 256, NLAT + b * CTXL, isctx ? 4 : 260, lds, F.tid, (const f32x2*)(F.ws + WS_ROPE), isctx ? -1 : qb * 256, 0.f);
        } else {
            const bool isctx = u >= 2064; const int uu = isctx ? u - 2064 : u - 1024;
            const int b = isctx ? (uu >> 3) : (uu >> 9), h = isctx ? (uu & 7) : ((uu >> 6) & 7), qb = uu & 63, kvh = h >> 2;
            const int q0 = isctx ? NLAT + b * CTXL : b * SEQ + qb * 256;
            att::attn_unit<64, true>(QB + (size_t)q0 * 512 + h * 64, 512, KB + kvh * 64, 128, nullptr, VB + kvh * 64, 128, O + (size_t)q0 * 1024 + 512 + h * 64,
                               b * SEQ, isctx ? 0 : 256, NLAT + b * CTXL, isctx ? 4 : 260, lds, F.tid, nullptr, -1, mfixB);
        }
    }
}

namespace na {
constexpr int TABH = 528;
constexpr int L_KC = 0, L_VC = 32768, VC_LD = 528, L_TAB = L_VC + 64 * VC_LD, L_END = L_TAB + TABH * 4;
struct Tile { bf16x8 kf[4]; bf16x8 vf[2][2]; };
__device__ __forceinline__ void load_tile(Tile& T, const bf16_t* kbase, const bf16_t* vbase, size_t vld, int r32, int hi) {
#pragma unroll
    for (int d0 = 0; d0 < 4; ++d0) T.kf[d0] = *(const bf16x8*)(kbase + (size_t)r32 * 2048 + d0 * 16 + hi * 8);
#pragma unroll
    for (int dv = 0; dv < 2; ++dv)
#pragma unroll
        for (int ks = 0; ks < 2; ++ks) T.vf[dv][ks] = *(const bf16x8*)(vbase + (size_t)(32 * dv + r32) * vld + 16 * ks + 8 * hi);
}
__device__ __forceinline__ void load_tile_lds(Tile& T, const LAS char* lds, int t, int r32, int hi) {
#pragma unroll
    for (int d0 = 0; d0 < 4; ++d0) T.kf[d0] = *(const LAS bf16x8*)(lds + L_KC + att::swz64(32 * t + r32, d0 * 2 + hi));
#pragma unroll
    for (int dv = 0; dv < 2; ++dv)
#pragma unroll
        for (int ks = 0; ks < 2; ++ks) T.vf[dv][ks] = *(const LAS bf16x8*)(lds + L_VC + (32 * dv + r32) * VC_LD + (32 * t + 16 * ks + 8 * hi) * 2);
}
constexpr int L_WST = L_END, WST_K = 0, WST_V = 4096, WST_VLD = 80, WST_BYTES = 4096 + 64 * 80;
struct RawTile { bf16x8 k[4], v[4]; };
__device__ __forceinline__ void load_raw(RawTile& T, const bf16_t* kbase, const bf16_t* vbase, int lane) {
#pragma unroll
    for (int i = 0; i < 4; ++i) { T.k[i] = *(const bf16x8*)(kbase + (size_t)(i * 8 + (lane >> 3)) * 2048 + (lane & 7) * 8);
                                  T.v[i] = *(const bf16x8*)(vbase + (size_t)(i * 16 + (lane >> 2)) * SEQ + (lane & 3) * 8); }
}
__device__ __forceinline__ void stage_raw(const RawTile& T, LAS char* w, int lane) {
#pragma unroll
    for (int i = 0; i < 4; ++i) { *(LAS bf16x8*)(w + WST_K + att::swz64(i * 8 + (lane >> 3), lane & 7)) = T.k[i];
                                  *(LAS bf16x8*)(w + WST_V + (i * 16 + (lane >> 2)) * WST_VLD + (lane & 3) * 16) = T.v[i]; }
}
__device__ __forceinline__ void load_tile_wst(Tile& T, const LAS char* w, int r32, int hi) {
#pragma unroll
    for (int d0 = 0; d0 < 4; ++d0) T.kf[d0] = *(const LAS bf16x8*)(w + WST_K + att::swz64(r32, d0 * 2 + hi));
#pragma unroll
    for (int dv = 0; dv < 2; ++dv)
#pragma unroll
        for (int ks = 0; ks < 2; ++ks) T.vf[dv][ks] = *(const LAS bf16x8*)(w + WST_V + (32 * dv + r32) * WST_VLD + (16 * ks + 8 * hi) * 2);
}
template <bool NBR> __device__ __forceinline__ void tile_step(const Tile& cur, const bf16x8 (&qr)[4], float& m_reg, float& l_reg, f32x16& o0, f32x16& o1,
                                                              bool vr, int dlt, const LAS float* tr, int hi) {
    f32x16 p = {};
#pragma unroll
    for (int d0 = 0; d0 < 4; ++d0) p = __builtin_amdgcn_mfma_f32_32x32x16_bf16(cur.kf[d0], qr[d0], p, 0, 0, 0);
    if (NBR) {
#pragma unroll
        for (int r = 0; r < 16; ++r) { const int kcl = (r & 3) + 8 * (r >> 2) + 4 * hi;
            const bool ok = vr && (kcl >= dlt) && (kcl < dlt + 16);
            p[r] = ok ? p[r] + tr[(r & 3) + 8 * (r >> 2)] : -3.0e38f; }
    }
    float pmax = p[0];
#pragma unroll
    for (int r = 1; r < 16; ++r) pmax = fmaxf(pmax, p[r]);
    { auto rr = __builtin_amdgcn_permlane32_swap(__float_as_uint(pmax), __float_as_uint(pmax), false, false);
      pmax = fmaxf(__uint_as_float(rr[0]), __uint_as_float(rr[1])); }
    if (!__all(pmax - m_reg <= att::THR2)) {
        const float mn = fmaxf(m_reg, pmax), alpha = __builtin_amdgcn_exp2f(m_reg - mn); m_reg = mn; l_reg *= alpha;
#pragma unroll
        for (int r = 0; r < 16; ++r) { o0[r] *= alpha; o1[r] *= alpha; }
    }
    float ps = 0.f;
#pragma unroll
    for (int r = 0; r < 16; ++r) { p[r] = __builtin_amdgcn_exp2f(p[r] - m_reg); ps += p[r]; }
    { auto rr = __builtin_amdgcn_permlane32_swap(__float_as_uint(ps), __float_as_uint(ps), false, false);
      ps = __uint_as_float(rr[0]) + __uint_as_float(rr[1]); }
    l_reg += ps;
    bf16x8 pa0, pa1;
    ATT_PK4(p, 0, pa0); ATT_PK4(p, 8, pa1);
    o0 = __builtin_amdgcn_mfma_f32_32x32x16_bf16(cur.vf[0][0], pa0, o0, 0, 0, 0);
    o0 = __builtin_amdgcn_mfma_f32_32x32x16_bf16(cur.vf[0][1], pa1, o0, 0, 0, 0);
    o1 = __builtin_amdgcn_mfma_f32_32x32x16_bf16(cur.vf[1][0], pa0, o1, 0, 0, 0);
    o1 = __builtin_amdgcn_mfma_f32_32x32x16_bf16(cur.vf[1][1], pa1, o1, 0, 0, 0);
}
__device__ __forceinline__ void store_o(bf16_t* Ow, const f32x16& o0, const f32x16& o1, float inv) {
#pragma unroll
    for (int g = 0; g < 4; ++g) {
        u32x2 w0, w1;
        w0.x = cvt_pk_bf16(o0[4 * g] * inv, o0[4 * g + 1] * inv); w0.y = cvt_pk_bf16(o0[4 * g + 2] * inv, o0[4 * g + 3] * inv);
        w1.x = cvt_pk_bf16(o1[4 * g] * inv, o1[4 * g + 1] * inv); w1.y = cvt_pk_bf16(o1[4 * g + 2] * inv, o1[4 * g + 3] * inv);
        *(u32x2*)(Ow + 8 * g) = w0; *(u32x2*)(Ow + 32 + 8 * g) = w1;
    }
}
__device__ __forceinline__ void na_phase(Frame& F, int li, bool need_ctx) {
    const bf16_t* QK = (const bf16_t*)(F.ws + R_QK); const bf16_t* Vt = (const bf16_t*)(F.ws + R_VT); const bf16_t* Vtc = (const bf16_t*)(F.ws + R_VTC);
    bf16_t* ON = (bf16_t*)(F.ws + R_ON);
    LAS char* lds = (LAS char*)F.lds; LAS float* tab = (LAS float*)(lds + L_TAB);
    const int r32 = F.lane & 31, hi = F.lane >> 5;
    for (int bi = F.vcu; bi < 256; bi += F.G) {
        const int bh = bi >> 3, b = bh >> 4, h = bh & 15, sub = bi & 7;
        __syncthreads();
        { const float* rpb = F.in[19] + ((size_t)li * 16 + h) * 465;
          for (int i = F.tid; i < TABH; i += NTHREADS) { const int j = i - 16; tab[i] = (j >= 0 && j < 465) ? rpb[j] * LOG2E : 0.f; }
          const bf16_t* ksrc = QK + (size_t)(NLAT + b * CTXL) * 2048 + 1024 + h * 64; const bf16_t* vsrc = Vtc + (size_t)(b * 16 + h) * 64 * CTXL;
#pragma unroll
          for (int i = 0; i < 4; ++i) { const int c = F.tid + NTHREADS * i;
              *(LAS bf16x8*)(lds + L_KC + att::swz64(c >> 3, c & 7)) = *(const bf16x8*)(ksrc + (size_t)(c >> 3) * 2048 + (c & 7) * 8);
              *(LAS bf16x8*)(lds + L_VC + (c >> 5) * VC_LD + (c & 31) * 16) = *(const bf16x8*)(vsrc + (size_t)(c >> 5) * CTXL + (c & 31) * 8); } }
        __syncthreads();
        for (int pi = F.wave; pi < 64; pi += NWAVES) {
            const int patch = sub * 64 + pi, R = 2 * (patch >> 2), C = 16 * (patch & 3);
            const int qrow = R + (r32 >> 4), qcol = C + (r32 & 15), mq = b * SEQ + qrow * 64 + qcol;
            const int krow_lo = min(max(R - 4, 0), 248), krow_hi = min(max(R - 3, 0), 248) + 7, nn = krow_hi - krow_lo + 1, kc0 = min(max(C - 8, 0), 32);
            const int rsq = min(max(qrow - 4, 0), 248), dlt = min(max(qcol - 8, 0), 48) - kc0;
            const LAS float* tb = tab + 16 + (kc0 - qcol + 15);
            bf16x8 qr[4];
#pragma unroll
            for (int d0 = 0; d0 < 4; ++d0) qr[d0] = *(const bf16x8*)(QK + (size_t)mq * 2048 + h * 64 + d0 * 16 + hi * 8);
            const bf16_t* kn_base = QK + (size_t)(b * SEQ + krow_lo * 64 + kc0) * 2048 + 1024 + h * 64;
            const bf16_t* vn_base = Vt + (size_t)(b * 16 + h) * 64 * SEQ + krow_lo * 64 + kc0;
            float m_reg = -1e30f, l_reg = 0.f; f32x16 o0 = {}, o1 = {};
            Tile cur; RawTile nb;
            LAS char* wst = lds + L_WST + F.wave * WST_BYTES;
            load_raw(nb, kn_base, vn_base, F.lane);
#pragma unroll 2
            for (int t = 0; t < 8; ++t) { load_tile_lds(cur, lds, t, r32, hi); tile_step<false>(cur, qr, m_reg, l_reg, o0, o1, false, 0, tb, hi); }
            for (int t = 0; t < nn; ++t) {
                stage_raw(nb, wst, F.lane);
                if (t + 1 < nn) load_raw(nb, kn_base + (size_t)(t + 1) * 64 * 2048, vn_base + (t + 1) * 64, F.lane);
                load_tile_wst(cur, wst, r32, hi);
                const int kr = krow_lo + t; const bool vr = (kr >= rsq) && (kr < rsq + 8); const int rt = min(max(kr - qrow + 7, 0), 14);
                tile_step<true>(cur, qr, m_reg, l_reg, o0, o1, vr, dlt, tb + rt * 31 + 4 * hi, hi);
            }
            store_o(ON + (size_t)mq * 1024 + h * 64 + 4 * hi, o0, o1, __builtin_amdgcn_rcpf(l_reg));
        }
    }
    if (need_ctx) {
        for (int it = F.gw; it < 2 * 16 * 8; it += F.NGW) {
            const int bh = it >> 3, b = bh >> 4, h = bh & 15, mq = NLAT + b * CTXL + (it & 7) * 32 + r32;
            bf16x8 qr[4];
#pragma unroll
            for (int d0 = 0; d0 < 4; ++d0) qr[d0] = *(const bf16x8*)(QK + (size_t)mq * 2048 + h * 64 + d0 * 16 + hi * 8);
            const bf16_t* kc_base = QK + (size_t)(NLAT + b * CTXL) * 2048 + 1024 + h * 64; const bf16_t* vc_base = Vtc + (size_t)(b * 16 + h) * 64 * CTXL;
            float m_reg = -1e30f, l_reg = 0.f; f32x16 o0 = {}, o1 = {};
            Tile cur, nxt;
            load_tile(cur, kc_base, vc_base, CTXL, r32, hi);
            for (int t = 0; t < 8; ++t) {
                if (t + 1 < 8) load_tile(nxt, kc_base + (size_t)(t + 1) * 32 * 2048, vc_base + (t + 1) * 32, CTXL, r32, hi);
                tile_step<false>(cur, qr, m_reg, l_reg, o0, o1, false, 0, tab, hi);
                cur = nxt;
            }
            store_o(ON + (size_t)mq * 1024 + h * 64 + 4 * hi, o0, o1, __builtin_amdgcn_rcpf(l_reg));
        }
    }
}
}


__device__ __forceinline__ void dbg_mean_abs(Frame& F, const bf16_t* p, int nrows, int ld, int ncols, int slot) {
    float s = 0.f;
    for (int r = F.gw; r < nrows; r += F.NGW)
        for (int c = F.lane * 8; c < ncols; c += 512) { const u32x4 w = *(const u32x4*)(p + (size_t)r * ld + c);
            s += fabsf(bf16lo(w.x)) + fabsf(bf16hi(w.x)) + fabsf(bf16lo(w.y)) + fabsf(bf16hi(w.y)) + fabsf(bf16lo(w.z)) + fabsf(bf16hi(w.z)) + fabsf(bf16lo(w.w)) + fabsf(bf16hi(w.w)); }
    s = wave_sum(s);
    if (F.lane == 0) atomicAdd((float*)(F.ctl + CW_DBG + slot), s / ((float)nrows * (float)ncols));
}

__device__ __forceinline__ void dbg_ri(Frame& F, int slot) {
    const u32x2* RI = (const u32x2*)(F.ws + R_RI); float s = 0.f;
    for (int r = F.gw * 64 + F.lane; r < 65536; r += F.NGW * 64) { const u32x2 ri = RI[r]; if (ri.x != 0xffffffffu) s += 0.5f + u2f(ri.y); }
    s = wave_sum(s);
    if (F.lane == 0) atomicAdd((float*)(F.ctl + CW_DBG + slot), s / 65536.f);
}

__device__ __forceinline__ void dbg_listw(Frame& F, int slot) {
    const u32x2* listw = (const u32x2*)(F.ws + WS_LIST); float s = 0.f;
    for (int e = 0; e < 32; ++e) { const int c = (int)__hip_atomic_load(F.ctl + CW_CNT + e * 64, RLX_AGENT);
        for (int j = F.gw * 64 + F.lane; j < c; j += F.NGW * 64) s += u2f(listw[(size_t)e * MROWS + j].y); }
    s = wave_sum(s);
    if (F.lane == 0) atomicAdd((float*)(F.ctl + CW_DBG + slot), s / 66560.f);
}

#ifndef DBG_CHECK
#define DBG_CHECK 0
#endif
#if DBG_CHECK
__device__ __forceinline__ unsigned hash_u(unsigned x) { x ^= x >> 16; x *= 0x7feb352du; x ^= x >> 15; x *= 0x846ca68bu; x ^= x >> 16; return x; }
__device__ __forceinline__ float bf2f(bf16_t v) { return u2f((unsigned)v << 16); }
__device__ __forceinline__ void dbg_max(Frame& F, int slot, float err) { if (F.lane == 0) atomicMax(F.ctl + CW_DBG + slot, __builtin_bit_cast(unsigned, err)); }
__device__ __forceinline__ void rope_ref(float& x1, float& x2, int i, int n, int gr, int gc) {
    const int ii = i < n ? i : i - n; const float inv = powf(10000.f, -(float)ii / (float)n), ang = (float)(i < n ? gr : gc) * inv;
    float sn, cs; sincosf(ang, &sn, &cs); const float a = x1 * cs - x2 * sn, b = x1 * sn + x2 * cs; x1 = a; x2 = b;
}
__device__ __forceinline__ void check_gemm(Frame& F, int slot, const bf16_t* A, int lda, const float* W, int K, int N, const bf16_t* C, int ldc, float scale, int M, int ns) {
    float worst = 0.f;
    for (int i = F.gw; i < ns; i += F.NGW) { const unsigned hsh = hash_u(i * 2654435761u + slot); const int row = hsh % (unsigned)M, col = (hsh >> 8) % (unsigned)N;
        float a = 0.f; for (int k = F.lane; k < K; k += 64) a += bf2f(A[(size_t)row * lda + k]) * W[(size_t)k * N + col];
        const float ref = wave_sum(a) * scale, got = bf2f(C[(size_t)row * ldc + col]); worst = fmaxf(worst, fabsf(got - ref) / (0.1f + fabsf(ref))); }
    dbg_max(F, slot, worst);
}
__device__ __forceinline__ void check_out0(Frame& F, int slot, int ns) {
    const float* X = (const float*)(F.ws + WS_X); const bf16_t* O = (const bf16_t*)(F.ws + R_O); const float* W = F.in[10]; const float* mod = (const float*)(F.ws + WS_MOD);
    float worst = 0.f;
    for (int i = F.gw; i < ns; i += F.NGW) { const unsigned hsh = hash_u(i * 2654435761u + slot); const int row = hsh % (unsigned)MROWS, col = (hsh >> 8) & 1023;
        float a = 0.f; for (int k = F.lane; k < 1024; k += 64) a += bf2f(O[(size_t)row * 1024 + k]) * W[(size_t)k * 1024 + col];
        const float xin = row < NLAT ? F.in[0][(size_t)row * 1024 + col] : F.in[2][(size_t)(row - NLAT) * 1024 + col];
        const float g1 = mod[(size_t)row_class(row) * 6144 + 2 * 1024 + col];
        const float ref = xin + g1 * wave_sum(a), got = X[(size_t)row * 1024 + col]; worst = fmaxf(worst, fabsf(got - ref) / (0.1f + fabsf(ref))); }
    dbg_max(F, slot, worst);
}
__device__ __forceinline__ void check_prep(Frame& F, int slot, int li, int ns) {
    const bf16_t* P = (const bf16_t*)(F.ws + R_P);
    const bf16_t* CQN = (const bf16_t*)(F.ws + R_CQN); const bf16_t* CKVN = (const bf16_t*)(F.ws + R_CKVN); const bf16_t* KR = (const bf16_t*)(F.ws + R_KR);
    const bf16_t* QB = (const bf16_t*)(F.ws + R_QB); const bf16_t* KB = (const bf16_t*)(F.ws + R_KB); const bf16_t* VB = (const bf16_t*)(F.ws + R_VB);
    const float* qn = F.in[11] + li * QLORA; const float* kvn = F.in[13] + li * KVLORA; const float* gqn = F.in[15] + li * 64; const float* gkn = F.in[16] + li * 64;
    float worst = 0.f;
#define CHK(got, ref) worst = fmaxf(worst, fabsf(bf2f(got) - (ref)) / (0.1f + fabsf(ref)))
    for (int i = F.gw; i < ns; i += F.NGW) { const unsigned hsh = hash_u(i * 2654435761u + slot); const int m = (i & 7) == 7 ? NLAT + hsh % NCTX : hsh % NLAT;
        const bf16_t* p = P + (size_t)m * AB_INP; const bool lat = m < NLAT; const int t = m & (SEQ - 1), gr = t >> 6, gc = t & 63;
        float s = 0.f; for (int c = F.lane; c < 384; c += 64) { const float v = bf2f(p[c]); s += v * v; }
        const float rq = rsqrtf(wave_sum(s) / 384.f + RMS_EPS);
        for (int c = F.lane; c < 384; c += 64) CHK(CQN[(size_t)m * 384 + c], bf2f(p[c]) * rq * qn[c]);
        s = 0.f; for (int c = F.lane; c < 256; c += 64) { const float v = bf2f(p[384 + c]); s += v * v; }
        const float rk = rsqrtf(wave_sum(s) / 256.f + RMS_EPS);
        for (int c = F.lane; c < 256; c += 64) CHK(CKVN[(size_t)m * 256 + c], bf2f(p[384 + c]) * rk * kvn[c]);
        if (F.lane < 16) { float x1 = bf2f(p[640 + 2 * F.lane]), x2 = bf2f(p[641 + 2 * F.lane]); if (lat) rope_ref(x1, x2, F.lane, 8, gr, gc);
            CHK(KR[(size_t)m * 32 + 2 * F.lane], x1); CHK(KR[(size_t)m * 32 + 2 * F.lane + 1], x2); }
        for (int pr = F.lane; pr < 256; pr += 64) { const int h = pr >> 5, i2 = pr & 31; float ss = 0.f;
            for (int d = 0; d < 64; ++d) { const float v = bf2f(p[672 + h * 64 + d]); ss += v * v; }
            const float r = rsqrtf(ss / 64.f + RMS_EPS);
            float x1 = bf2f(p[672 + h * 64 + 2 * i2]) * r * gqn[2 * i2], x2 = bf2f(p[672 + h * 64 + 2 * i2 + 1]) * r * gqn[2 * i2 + 1]; if (lat) rope_ref(x1, x2, i2, 16, gr, gc);
            CHK(QB[(size_t)m * 512 + h * 64 + 2 * i2], x1 * SC_B); CHK(QB[(size_t)m * 512 + h * 64 + 2 * i2 + 1], x2 * SC_B); }
        { const int h = F.lane >> 5, i2 = F.lane & 31; float ss = 0.f;
            for (int d = 0; d < 64; ++d) { const float v = bf2f(p[1184 + h * 64 + d]); ss += v * v; }
            const float r = rsqrtf(ss / 64.f + RMS_EPS);
            float x1 = bf2f(p[1184 + h * 64 + 2 * i2]) * r * gkn[2 * i2], x2 = bf2f(p[1184 + h * 64 + 2 * i2 + 1]) * r * gkn[2 * i2 + 1]; if (lat) rope_ref(x1, x2, i2, 16, gr, gc);
            CHK(KB[(size_t)m * 128 + h * 64 + 2 * i2], x1); CHK(KB[(size_t)m * 128 + h * 64 + 2 * i2 + 1], x2);
            CHK(VB[(size_t)m * 128 + 2 * F.lane], bf2f(p[1312 + 2 * F.lane])); CHK(VB[(size_t)m * 128 + 2 * F.lane + 1], bf2f(p[1313 + 2 * F.lane])); }
    }
#undef CHK
    dbg_max(F, slot, worst);
}
__device__ __forceinline__ void check_attn(Frame& F, int slot, int type, int ns) {
    const bf16_t* QA = (const bf16_t*)(F.ws + R_QA); const bf16_t* KVA = (const bf16_t*)(F.ws + R_KVA); const bf16_t* KR = (const bf16_t*)(F.ws + R_KR);
    const bf16_t* QB = (const bf16_t*)(F.ws + R_QB); const bf16_t* KB = (const bf16_t*)(F.ws + R_KB); const bf16_t* VB = (const bf16_t*)(F.ws + R_VB);
    const bf16_t* O = (const bf16_t*)(F.ws + R_O);
    LAS float* qs = (LAS float*)(F.lds + F.wave * 512);
    float worst = 0.f;
    for (int i = F.gw; i < ns; i += F.NGW) { const unsigned hsh = hash_u(i * 2654435761u + slot); const bool qctx = (i & 7) == 7;
        const int b = hsh & 1, h = (hsh >> 1) & 7, tq = qctx ? (hsh >> 4) % CTXL : (hsh >> 4) % SEQ, mq = qctx ? NLAT + b * CTXL + tq : b * SEQ + tq;
        const int DQ = type == 0 ? 96 : 64;
        for (int d = F.lane; d < DQ; d += 64) qs[d] = type == 0 ? bf2f(QA[(size_t)mq * 768 + h * 96 + d]) : bf2f(QB[(size_t)mq * 512 + h * 64 + d]);
        LDS_WAIT();
        if (type == 0 && !qctx && F.lane < 16) { float x1 = qs[64 + 2 * F.lane], x2 = qs[65 + 2 * F.lane]; rope_ref(x1, x2, F.lane, 8, tq >> 6, tq & 63); qs[64 + 2 * F.lane] = x1; qs[65 + 2 * F.lane] = x2; }
        LDS_WAIT();
        const int nk = qctx ? CTXL : SEQ + CTXL;
        float mx = -3.0e38f, emax = 0.f, rmax = 0.f;
        for (int pass = 0; pass < 5; ++pass) {
            float l = 0.f, o[16];
#pragma unroll
            for (int d = 0; d < 16; ++d) o[d] = 0.f;
            const int dv0 = (pass - 1) * 16;
            for (int j = F.lane; j < nk; j += 64) { const int kr = (qctx || j >= SEQ) ? NLAT + b * CTXL + (qctx ? j : j - SEQ) : b * SEQ + j;
                float sc = 0.f;
                if (type == 0) { const bf16_t* kp = KVA + (size_t)kr * 1024 + h * 128; const bf16_t* rp = KR + (size_t)kr * 32;
                    for (int d = 0; d < 64; ++d) sc += qs[d] * bf2f(kp[d]); for (int d = 0; d < 32; ++d) sc += qs[64 + d] * bf2f(rp[d]); }
                else { const bf16_t* kp = KB + (size_t)kr * 128 + (h >> 2) * 64; for (int d = 0; d < 64; ++d) sc += qs[d] * bf2f(kp[d]); }
                if (pass == 0) mx = fmaxf(mx, sc);
                else { const float pw = exp2f(sc - mx); l += pw; const bf16_t* vp = (type == 0 ? KVA + (size_t)kr * 1024 + h * 128 + 64 : VB + (size_t)kr * 128 + (h >> 2) * 64) + dv0;
#pragma unroll
                    for (int d = 0; d < 16; ++d) o[d] += pw * bf2f(vp[d]); } }
            if (pass == 0) { for (int s2 = 1; s2 < 64; s2 <<= 1) mx = fmaxf(mx, __shfl_xor(mx, s2)); }
            else { l = wave_sum(l);
#pragma unroll
                for (int d = 0; d < 16; ++d) { const float ref = wave_sum(o[d]) / l, got = bf2f(O[(size_t)mq * 1024 + (type == 0 ? 0 : 512) + h * 64 + dv0 + d]); emax = fmaxf(emax, fabsf(got - ref)); rmax = fmaxf(rmax, fabsf(ref)); } }
        }
        worst = fmaxf(worst, emax / (rmax + 1e-9f));
    }
    dbg_max(F, slot, worst);
}
__device__ __forceinline__ void check_na(Frame& F, int slot, int li, bool need_ctx, int ns) {
    const bf16_t* QK = (const bf16_t*)(F.ws + R_QK); const bf16_t* Vt = (const bf16_t*)(F.ws + R_VT); const bf16_t* Vtc = (const bf16_t*)(F.ws + R_VTC); const bf16_t* ON = (const bf16_t*)(F.ws + R_ON);
    const float* rpb = F.in[19] + (size_t)li * 16 * 465;
    LAS float* qs = (LAS float*)(F.lds + F.wave * 512);
    float worst = 0.f;
    for (int i = F.gw; i < ns; i += F.NGW) { const unsigned hsh = hash_u(i * 2654435761u + slot); const bool qctx = need_ctx && (i & 7) == 7;
        const int b = hsh & 1, h = (hsh >> 1) & 15; int tq = qctx ? (hsh >> 5) % CTXL : (hsh >> 5) % SEQ;
        if (!qctx && (i & 7) == 1) tq = ((hsh >> 5) & 7) * 64 + ((hsh >> 9) & 63) + ((hsh >> 20) & 1) * (SEQ - 512);
        const int mq = qctx ? NLAT + b * CTXL + tq : b * SEQ + tq, r = tq >> 6, c = tq & 63;
        if (F.lane < 64) qs[F.lane] = bf2f(QK[(size_t)mq * 2048 + h * 64 + F.lane]);
        LDS_WAIT();
        const int rs = min(max(r - 4, 0), GRIDH - 8), cs = min(max(c - 8, 0), GRIDW - 16);
        const int nk = qctx ? CTXL : 128 + CTXL;
        float mx = -3.0e38f;
        for (int pass = 0; pass < 2; ++pass) {
            float l = 0.f, o[64];
#pragma unroll
            for (int d = 0; d < 64; ++d) o[d] = 0.f;
            for (int j = F.lane; j < nk; j += 64) { const bool nb = !qctx && j < 128;
                const int kr_ = rs + (j >> 4), kc_ = cs + (j & 15);
                const int krow = nb ? b * SEQ + kr_ * 64 + kc_ : NLAT + b * CTXL + (qctx ? j : j - 128);
                const bf16_t* kp = QK + (size_t)krow * 2048 + 1024 + h * 64; float sc = 0.f;
                for (int d = 0; d < 64; ++d) sc += qs[d] * bf2f(kp[d]);
                if (nb) sc += rpb[h * 465 + (kr_ - r + 7) * 31 + (kc_ - c + 15)] * LOG2E;
                if (pass == 0) mx = fmaxf(mx, sc);
                else { const float pw = exp2f(sc - mx); l += pw;
#pragma unroll
                    for (int d = 0; d < 64; ++d) o[d] += pw * (nb ? bf2f(Vt[((size_t)(b * 16 + h) * 64 + d) * SEQ + kr_ * 64 + kc_]) : bf2f(Vtc[((size_t)(b * 16 + h) * 64 + d) * CTXL + (qctx ? j : j - 128)])); } }
            if (pass == 0) { for (int s2 = 1; s2 < 64; s2 <<= 1) mx = fmaxf(mx, __shfl_xor(mx, s2)); }
            else { l = wave_sum(l); float emax = 0.f, rmax = 0.f;
#pragma unroll
                for (int d = 0; d < 64; ++d) { const float ref = wave_sum(o[d]) / l, got = bf2f(ON[(size_t)mq * 1024 + h * 64 + d]); emax = fmaxf(emax, fabsf(got - ref)); rmax = fmaxf(rmax, fabsf(ref)); }
                worst = fmaxf(worst, emax / (rmax + 1e-9f)); } }
    }
    dbg_max(F, slot, worst);
}
#endif

constexpr int PH_PER_LAYER = 12, NPH = 2 + DEPTH * PH_PER_LAYER;
__global__ void __launch_bounds__(NTHREADS, 2) fwd(Args args) {
    extern __shared__ __attribute__((aligned(16))) unsigned char lds_raw[];
    Frame F;
    F.lds = (LAS unsigned char*)lds_raw; F.ws = args.ws; F.ctl = (unsigned*)(args.ws + WS_CTL); F.in = args.in;
    F.tid = threadIdx.x; F.lane = F.tid & 63; F.wave = __builtin_amdgcn_readfirstlane(F.tid >> 6);
    F.G = gridDim.x; { const int bx = blockIdx.x; F.vcu = (F.G % 8 == 0) ? (bx % 8) * (F.G / 8) + bx / 8 : bx; }
    F.gw = F.vcu * NWAVES + F.wave; F.NGW = F.G * NWAVES;
    volatile LAS unsigned* MISC = (volatile LAS unsigned*)(F.lds + MISC_OFF);
    if (F.tid < 16) MISC[F.tid] = 0u;
    __syncthreads();
    const int lo = args.ph_lo, hi = args.ph_hi;
    XcdBarrier bar; bar.bar = F.ctl + CW_BAR; bar.x = 0; bar.st = MISC;
    if (hi - lo > 1) bar = xcd_barrier_post(F.ctl + CW_BAR, MISC);
#define OPAQUE_V(x) asm volatile("" : "+v"(x))
#define OPAQUE_S(x) asm volatile("" : "+s"(x))
#define PHASE_BEGIN() do { GAS unsigned char* _ws = (GAS unsigned char*)args.ws; OPAQUE_S(_ws); F.ws = (unsigned char*)_ws; F.ctl = (unsigned*)(F.ws + WS_CTL); int _t = threadIdx.x; OPAQUE_V(_t); F.tid = _t; F.lane = _t & 63; \
    F.wave = __builtin_amdgcn_readfirstlane(_t >> 6); int _bx = blockIdx.x; OPAQUE_S(_bx); bx = _bx; F.vcu = (F.G % 8 == 0) ? (_bx % 8) * (F.G / 8) + _bx / 8 : _bx; F.gw = F.vcu * NWAVES + F.wave; \
    mod = (const float*)(F.ws + WS_MOD); } while (0)
#define RUN(k) ((k) >= lo && (k) < hi)
#define SEAM(k) do { if ((k) + 1 < hi) xcd_barrier(bar); } while (0)
    LAS unsigned char* ring = F.lds;
    const float* mod; int bx;

    if (RUN(0)) { PHASE_BEGIN(); if (EN_P0) for (int rep_ = 0; rep_ < REP_P0; ++rep_) { p0_prologue(F); __syncthreads(); } SEAM(0); }


#if DBG_CHECK == 2
#define CHECK_E2(l, li)
#define CHECK_PREP(l, li)
#define CHECK_UP(l, li)
#define CHECK_ATT(l, li) { check_attn(F, 32 + (l), 0, 2048); check_attn(F, 36 + (l), 1, 2048); __syncthreads(); }
#define CHECK_OUT(l, li)
#define CHECK_NA(l, li, nc)
#elif DBG_CHECK
#define CHECK_E2(l, li) { check_gemm(F, 16 + (l), (const bf16_t*)(F.ws + WS_H), 1024, F.in[9] + (size_t)(li) * 1024 * 1440, 1024, 1440, (const bf16_t*)(F.ws + R_P), AB_INP, 1.f, MROWS, 4096); }
#define CHECK_PREP(l, li) { check_prep(F, 20 + (l), li, 2048); }
#define CHECK_UP(l, li) { check_gemm(F, 24 + (l), (const bf16_t*)(F.ws + R_CQN), 384, F.in[12] + (size_t)(li) * 384 * 768, 384, 768, (const bf16_t*)(F.ws + R_QA), 768, SC_A, MROWS, 4096); \
                          check_gemm(F, 28 + (l), (const bf16_t*)(F.ws + R_CKVN), 256, F.in[14] + (size_t)(li) * 256 * 1024, 256, 1024, (const bf16_t*)(F.ws + R_KVA), 1024, 1.f, MROWS, 4096); }
#define CHECK_ATT(l, li) { check_attn(F, 32 + (l), 0, 2048); check_attn(F, 36 + (l), 1, 2048); __syncthreads(); }
#define CHECK_OUT(l, li) { if ((l) == 0) check_out0(F, 40, 4096); }
#define CHECK_NA(l, li, nc) { check_na(F, 44 + (l), li, nc, 4096); __syncthreads(); }
#else
#define CHECK_E2(l, li)
#define CHECK_PREP(l, li)
#define CHECK_UP(l, li)
#define CHECK_ATT(l, li)
#define CHECK_OUT(l, li)
#define CHECK_NA(l, li, nc)
#endif
#define LAYER_BODY(LL) { constexpr int l = (LL); \
        const int pb = 1 + l * PH_PER_LAYER, li = l >> 1; \
        if (RUN(pb)) { PHASE_BEGIN(); if (EN_NORM) mix_norm_phase(F, l); SEAM(pb); } \
        if ((l & 1) == 0) { \
            if (RUN(pb + 1)) { PHASE_BEGIN(); \
                pg8::Gemm g{(const bf16_t*)(F.ws + WS_H), (const bf16_t*)(F.ws + WS_WIN) + (size_t)li * AB_INP * 1024, 1024, 1024}; \
                pg8::StaticOrder S; S.init(MROWS / 256, AB_INP / 256, F.G, bx); \
                EpiStore E{(bf16_t*)(F.ws + R_P), AB_INP}; \
                if (EN_GEMM & 1) { pg8::gemm_phase<EpiStore, pg8::StaticOrder, true>(ring, g, S, E, F.tid); if (REP_IN >= 2) pg8::gemm_phase<EpiStore, pg8::StaticOrder, true>(ring, g, S, E, F.tid); if (REP_IN >= 3) pg8::gemm_phase<EpiStore, pg8::StaticOrder, true>(ring, g, S, E, F.tid); } \
                SEAM(pb + 1); CHECK_E2(l, li) \
            } \
            if (RUN(pb + 2)) { PHASE_BEGIN(); if (EN_PREP) for (int rep_ = 0; rep_ < REP_PREP; ++rep_) ab_prep_phase(F, li); SEAM(pb + 2); CHECK_PREP(l, li) } \
            if (RUN(pb + 3)) { PHASE_BEGIN(); \
                { pg8::Gemm g{(const bf16_t*)(F.ws + R_CQN), (const bf16_t*)(F.ws + WS_WQUP) + (size_t)li * 768 * 384, QLORA, QLORA}; \
                  pg8::StaticOrder S; S.init(MROWS / 256, 3, F.G, bx); \
                  EpiStore E{(bf16_t*)(F.ws + R_QA), 768}; \
                  if (EN_GEMM & 2) { pg8::gemm_phase<EpiStore, pg8::StaticOrder, true>(ring, g, S, E, F.tid); if (REP_UP >= 2) pg8::gemm_phase<EpiStore, pg8::StaticOrder, true>(ring, g, S, E, F.tid); } } \
                { pg8::Gemm g{(const bf16_t*)(F.ws + R_CKVN), (const bf16_t*)(F.ws + WS_WKVUP) + (size_t)li * 1024 * 256, KVLORA, KVLORA}; \
                  pg8::StaticOrder S; S.init(MROWS / 256, 4, F.G, (bx + 134) % F.G); \
                  EpiStore E{(bf16_t*)(F.ws + R_KVA), 1024}; \
                  if (EN_GEMM & 4) { pg8::gemm_phase<EpiStore, pg8::StaticOrder, true>(ring, g, S, E, F.tid); if (REP_UP >= 2) pg8::gemm_phase<EpiStore, pg8::StaticOrder, true>(ring, g, S, E, F.tid); } } \
                SEAM(pb + 3); CHECK_UP(l, li) \
            } \
            if (RUN(pb + 4)) { PHASE_BEGIN(); if (EN_ATT) for (int rep_ = 0; rep_ < REP_ATT; ++rep_) { attn_phase(F, li); if (rep_ + 1 < REP_ATT) __syncthreads(); } SEAM(pb + 4); CHECK_ATT(l, li) } \
            if (RUN(pb + 5)) { PHASE_BEGIN(); \
                pg8::Gemm g{(const bf16_t*)(F.ws + R_O), (const bf16_t*)(F.ws + WS_WOUT) + (size_t)li * 1024 * 1024, 1024, 1024}; \
                pg8::StaticOrder S; S.init(MROWS / 256, 4, F.G, bx); \
                EpiOut<(l == 0)> E{(bf16_t*)(F.ws + WS_X), mod + (size_t)l * 3 * 6144, F.in[0], F.in[2]}; \
                if (EN_GEMM & 8) pg8::gemm_phase<EpiOut<(l == 0)>, pg8::StaticOrder, true>(ring, g, S, E, F.tid); \
                SEAM(pb + 5); CHECK_OUT(l, li) \
            } \
        } else { \
            const bool last = (l == DEPTH - 1); \
            if (RUN(pb + 1)) { PHASE_BEGIN(); \
                pg8::Gemm g{(const bf16_t*)(F.ws + WS_H), (const bf16_t*)(F.ws + WS_NIN) + (size_t)li * 3072 * 1024, 1024, 1024}; \
                pg8::StaticOrder S; S.init(MROWS / 256, 12, F.G, bx); \
                EpiNaIn E{(bf16_t*)(F.ws + R_QK), (bf16_t*)(F.ws + R_VT), (bf16_t*)(F.ws + R_VTC)}; \
                if (EN_GEMM & 16) { pg8::gemm_phase<EpiNaIn, pg8::StaticOrder, true>(ring, g, S, E, F.tid); if (REP_IN >= 2) pg8::gemm_phase<EpiNaIn, pg8::StaticOrder, true>(ring, g, S, E, F.tid); if (REP_IN >= 3) pg8::gemm_phase<EpiNaIn, pg8::StaticOrder, true>(ring, g, S, E, F.tid); } \
                SEAM(pb + 1); \
            } \
            if (RUN(pb + 4)) { PHASE_BEGIN(); if (EN_NA) for (int rep_ = 0; rep_ < REP_NA; ++rep_) { na::na_phase(F, li, !last); if (rep_ + 1 < REP_NA) __syncthreads(); } SEAM(pb + 4); CHECK_NA(l, li, !last) } \
            if (RUN(pb + 5)) { PHASE_BEGIN(); \
                pg8::Gemm g{(const bf16_t*)(F.ws + R_ON), (const bf16_t*)(F.ws + WS_NOUT) + (size_t)li * 1024 * 1024, 1024, 1024}; \
                pg8::StaticOrder S; S.init((last ? NLAT : MROWS) / 256, 4, F.G, bx); \
                EpiOut<false> E{(bf16_t*)(F.ws + WS_X), mod + (size_t)l * 3 * 6144, F.in[0], F.in[2]}; \
                if (EN_GEMM & 32) pg8::gemm_phase<EpiOut<false>, pg8::StaticOrder, true>(ring, g, S, E, F.tid); \
                SEAM(pb + 5); \
            } \
        } \
        if (RUN(pb + 6)) { PHASE_BEGIN(); if (EN_ROUTE) ffn_norm_route_phase(F, l); SEAM(pb + 6); } \
                if (RUN(pb + 8)) { PHASE_BEGIN(); \
            moe_tile_map(F, l); \
            if (DBG_SEL == 0 && l == 0 && blockIdx.x == 0 && F.tid == 0) F.ctl[CW_DBG + 0] = __builtin_bit_cast(unsigned, 0.001f * (float)*(const LAS int*)(F.lds + MOE_NT_OFF)); \
            pg8::Gemm g{(const bf16_t*)(F.ws + WS_H), (const bf16_t*)(F.ws + WS_MOEW + (size_t)l * MOEW_LAYER), 1024, 1024}; \
            pg8::MoeGatherOrder S; S.tile_e = (const LAS int*)(F.lds + TILE_E_OFF); S.nT = *(const LAS int*)(F.lds + MOE_NT_OFF); S.G = F.G; S.c = bx; S.estride = (size_t)1024 * 1024; \
            S.lcnt = (const LAS int*)(F.lds + CNTL_OFF); S.lbase = S.lcnt + 32; S.list = (const u32x2*)(F.ws + WS_LIST); \
            EpiMoe1 E{(bf16_t*)(F.ws + R_ACT)}; \
            if (EN_GEMM & 64) { pg8::gemm_phase<EpiMoe1, pg8::MoeGatherOrder, true>(ring, g, S, E, F.tid); if (REP_MOE >= 2) pg8::gemm_phase<EpiMoe1, pg8::MoeGatherOrder, true>(ring, g, S, E, F.tid); if (REP_MOE >= 3) pg8::gemm_phase<EpiMoe1, pg8::MoeGatherOrder, true>(ring, g, S, E, F.tid); } \
            SEAM(pb + 8); if (DBG_SEL == 2 && l == 0) dbg_mean_abs(F, (const bf16_t*)(F.ws + R_ACT), 65536, 512, 512, 2); \
        } \
        if (RUN(pb + 9)) { PHASE_BEGIN(); \
            moe_tile_map(F, l); \
            pg8::Gemm g{(const bf16_t*)(F.ws + R_ACT), (const bf16_t*)(F.ws + WS_MOEW + (size_t)l * MOEW_LAYER + MOEW_DN), 512, 512}; \
            pg8::MoeOrder S{(const LAS int*)(F.lds + TILE_E_OFF), *(const LAS int*)(F.lds + MOE_NT_OFF), F.G, bx, (size_t)1024 * 512}; \
            EpiMoe2 E{(bf16_t*)(F.ws + R_Y), (const LAS int*)(F.lds + TILE_E_OFF), (const LAS int*)(F.lds + CNTL_OFF), (const LAS int*)(F.lds + CNTL_OFF) + 32, (const u32x2*)(F.ws + WS_LIST)}; if (DBG_SEL == 4 && l == 0) dbg_ri(F, 4); if (DBG_SEL == 6 && l == 0) dbg_listw(F, 6); if (DBG_SEL == 5 && l == 0) dbg_mean_abs(F, (const bf16_t*)(F.ws + WS_MOEW + MOEW_DN), 32768, 512, 512, 5); \
            if (EN_GEMM & 128) { pg8::gemm_phase<EpiMoe2, pg8::MoeOrder, true>(ring, g, S, E, F.tid); if (REP_MOE >= 2) pg8::gemm_phase<EpiMoe2, pg8::MoeOrder, true>(ring, g, S, E, F.tid); if (REP_MOE >= 3) pg8::gemm_phase<EpiMoe2, pg8::MoeOrder, true>(ring, g, S, E, F.tid); } \
            SEAM(pb + 9); if (DBG_SEL == 1 && l == 0) dbg_mean_abs(F, (const bf16_t*)(F.ws + R_Y), 65536, 1024, 1024, 1); \
        } \
    }
    LAYER_BODY(0)
    LAYER_BODY(1)
    LAYER_BODY(2)
    LAYER_BODY(3)
#undef LAYER_BODY
    if (RUN(NPH - 1)) { PHASE_BEGIN(); if (EN_FINAL) final_phase(F, args.out); }
#undef RUN
#undef SEAM
}

extern "C" void kernel_launch(void* const* d_in, const int* in_sizes, int n_in, void* d_out, int out_size, void* d_ws, size_t ws_size, hipStream_t stream) {
    static int grid = 0;
    if (grid == 0) {
        if (n_in != 27 || out_size != NLAT * DM || ws_size < WS_END) { fprintf(stderr, "kernel_launch: unexpected shapes: n_in %d out %d ws %zu (need %zu)\n", n_in, out_size, ws_size, (size_t)WS_END); grid = -1; return; }
        int dev = 0, cus = 0, per_cu = 0;
        if (hipGetDevice(&dev) != hipSuccess || hipDeviceGetAttribute(&cus, hipDeviceAttributeMultiprocessorCount, dev) != hipSuccess) { grid = -1; return; }
        if (hipFuncSetAttribute((const void*)fwd, hipFuncAttributeMaxDynamicSharedMemorySize, LDS_BYTES) != hipSuccess) { fprintf(stderr, "kernel_launch: hipFuncSetAttribute failed\n"); grid = -1; return; }
        if (hipOccupancyMaxActiveBlocksPerMultiprocessor(&per_cu, (const void*)fwd, NTHREADS, LDS_BYTES) != hipSuccess || per_cu < 1)
            fprintf(stderr, "kernel_launch: occupancy query reports %d workgroups per CU\n", per_cu);
        (void)hipGetLastError();
        grid = cus;
    }
    if (grid < 0) return;
    if (hipMemsetAsync((char*)d_ws + WS_CTL, 0, CTL_ZERO_BYTES, stream) != hipSuccess) return;
    Args a{};
    for (int i = 0; i < 27; ++i) a.in[i] = (const float*)d_in[i];
    a.out = (float*)d_out; a.ws = (unsigned char*)d_ws;
#if MK_PER_PHASE
    for (int p = 0; p < NPH; ++p) { a.ph_lo = p; a.ph_hi = p + 1; hipLaunchKernelGGL(fwd, dim3(grid), dim3(NTHREADS), LDS_BYTES, stream, a); }
#else
    a.ph_lo = 0; a.ph_hi = NPH;
    hipLaunchKernelGGL(fwd, dim3(grid), dim3(NTHREADS), LDS_BYTES, stream, a);
#endif
    const hipError_t le = hipPeekAtLastError();
    if (le != hipSuccess) fprintf(stderr, "kernel_launch: launch failed: %s\n", hipGetErrorName(le));
}
```
